# Optimizing an MI355X kernel written in HIP

```python
import jax, jax.numpy as jnp
from jax import lax
import numpy as np

D_MODEL = 1024
BATCH = 16
SEQ = 2048
DEPTH = 1

HEAD_DIM = 64
N_SLOTS = 8
DILATED_GROUPS = ((128, 1), (512, 4), (2048, 16))
N_ATTN_HEADS = N_SLOTS * len(DILATED_GROUPS)
ATTN_WIDTH = N_ATTN_HEADS * HEAD_DIM
ATTN_OUT_WIDTH = N_SLOTS * HEAD_DIM
LRU_WIDTH = D_MODEL
LRU_BLOCKS = 16
LRU_BLOCK_DIM = LRU_WIDTH // LRU_BLOCKS
CONV_WIDTH = 4
LRU_C = 8.0
N_BRANCHES = 2
IN_COLS = 3 * ATTN_WIDTH + 2 * LRU_WIDTH + N_BRANCHES * D_MODEL
IN_SPLITS = [ATTN_WIDTH, 2 * ATTN_WIDTH, 3 * ATTN_WIDTH,
             3 * ATTN_WIDTH + LRU_WIDTH, 3 * ATTN_WIDTH + 2 * LRU_WIDTH]
N_EXPERT_GROUPS = 4
EXPERTS_PER_GROUP = 8
N_EXPERTS = N_EXPERT_GROUPS * EXPERTS_PER_GROUP
TOP_K_INNER = 2
D_EXPERT = D_MODEL // 2
MOE_BLOCK = 128
EPS = 1e-6

kernel_name = "hybrid_dilated_attn_rglru_hmoe_adaln"


def rms_norm(x, g):
    xf = x.astype(jnp.float32)
    y = xf * lax.rsqrt(jnp.mean(xf * xf, axis=-1, keepdims=True) + EPS)
    return (y * g.astype(jnp.float32)).astype(x.dtype)


def dilated_window_group(q, k, v, window, dilation):
    b, s, h, dh = q.shape
    span = window // dilation
    n_sub = s // dilation
    n_blk = -(-n_sub // span)
    pad = n_blk * span - n_sub

    def to_blocks(t):
        t = t.reshape(b, n_sub, dilation, h, dh)
        t = jnp.pad(t, ((0, 0), (0, pad), (0, 0), (0, 0), (0, 0)))
        return t.reshape(b, n_blk, span, dilation, h, dh)

    def with_prev(t):
        prev = jnp.pad(t, ((0, 0), (1, 0), (0, 0), (0, 0), (0, 0), (0, 0)))[:, :-1]
        return jnp.concatenate([prev, t], axis=2)

    qb = to_blocks(q)
    kk = with_prev(to_blocks(k))
    vv = with_prev(to_blocks(v))
    scores = jnp.einsum('bnqphd,bnkphd->bnqphk', qb, kk,
                        preferred_element_type=jnp.float32) * (dh ** -0.5)
    qi = jnp.arange(span)[:, None]
    ki = jnp.arange(2 * span)[None, :]
    dist = span + qi - ki
    band = (dist >= 0) & (dist <= span)
    blk = jnp.arange(n_blk)[:, None, None]
    valid = band[None] & ((blk > 0) | (ki[None] >= span))
    scores = jnp.where(valid[None, :, :, None, None, :], scores, -jnp.inf)
    m = jnp.max(scores, axis=-1, keepdims=True)
    e = jnp.exp(scores - m)
    den = jnp.sum(e, axis=-1)
    num = jnp.einsum('bnqphk,bnkphd->bnqphd', e, vv.astype(jnp.float32))
    out = num / den[..., None]
    lse = m[..., 0] + jnp.log(den)
    out = out.reshape(b, n_blk * span, dilation, h, dh)[:, :n_sub].reshape(b, s, h, dh)
    lse = lse.reshape(b, n_blk * span, dilation, h)[:, :n_sub].reshape(b, s, h)
    return out, lse


def dilated_attention(q, k, v):
    outs, lses = [], []
    for g, (window, dilation) in enumerate(DILATED_GROUPS):
        sl = slice(g * N_SLOTS, (g + 1) * N_SLOTS)
        o, l = dilated_window_group(q[:, :, sl], k[:, :, sl], v[:, :, sl], window, dilation)
        outs.append(o)
        lses.append(l)
    out = jnp.stack(outs, axis=0)
    wts = jax.nn.softmax(jnp.stack(lses, axis=0), axis=0)
    return jnp.sum(wts[..., None] * out, axis=0)


def causal_depthwise_conv(x, w, b):
    c = x.shape[-1]
    y = lax.conv_general_dilated(x, w[:, None, :].astype(x.dtype), window_strides=(1,),
                                 padding=[(CONV_WIDTH - 1, 0)],
                                 dimension_numbers=('NWC', 'WIO', 'NWC'),
                                 feature_group_count=c)
    return y + b


def block_diag(x, w, b):
    xb = x.reshape(*x.shape[:-1], LRU_BLOCKS, LRU_BLOCK_DIM)
    y = jnp.einsum('bsni,nio->bsno', xb, w.astype(x.dtype))
    return y.reshape(x.shape) + b.astype(x.dtype)


def rg_lru(x, wx, bx, wa, ba, lam):
    xf = x.astype(jnp.float32)
    gate_i = jax.nn.sigmoid(block_diag(xf, wx, bx))
    gate_r = jax.nn.sigmoid(block_diag(xf, wa, ba))
    log_a = -LRU_C * gate_r * jax.nn.softplus(-lam.astype(jnp.float32))
    a = jnp.exp(log_a)
    mult = jnp.sqrt(-jnp.expm1(2.0 * log_a))
    b_in = mult * gate_i * xf

    def combine(left, right):
        a1, b1 = left
        a2, b2 = right
        return a1 * a2, a2 * b1 + b2

    _, h = lax.associative_scan(combine, (a, b_in), axis=1)
    return h.astype(x.dtype)


def expert_ffn_blocks(t, expert_id, weights, w1, w3, w2):
    n_tok, d = t.shape
    flat_e = expert_id.reshape(-1)
    flat_w = weights.reshape(-1)
    n_assign = flat_e.shape[0]
    order = jnp.argsort(flat_e)
    e_sorted = flat_e[order]
    tok_sorted = order // TOP_K_INNER
    sizes = jnp.bincount(flat_e, length=N_EXPERTS)
    starts = jnp.cumsum(sizes) - sizes
    padded = (sizes + MOE_BLOCK - 1) // MOE_BLOCK * MOE_BLOCK
    pad_ends = jnp.cumsum(padded)
    pad_starts = pad_ends - padded
    dest = pad_starts[e_sorted] + jnp.arange(n_assign) - starts[e_sorted]
    n_blocks = (n_assign + N_EXPERTS * (MOE_BLOCK - 1) + MOE_BLOCK - 1) // MOE_BLOCK
    xp = jnp.zeros((n_blocks * MOE_BLOCK, d), t.dtype).at[dest].set(t[tok_sorted])
    blk_e = jnp.minimum(jnp.searchsorted(pad_ends, jnp.arange(n_blocks) * MOE_BLOCK,
                                         side='right'), N_EXPERTS - 1)

    def run(args):
        xb, e = args
        hb = jax.nn.silu(xb @ w1[e]) * (xb @ w3[e])
        return hb @ w2[e]

    yp = lax.map(run, (xp.reshape(n_blocks, MOE_BLOCK, d), blk_e)).reshape(-1, d)
    ys = yp[dest] * flat_w[order][:, None].astype(yp.dtype)
    return jnp.zeros((n_tok, d), yp.dtype).at[tok_sorted].add(ys)


def hierarchical_moe(h, w_grp, b_grp, w_exp, b_exp, w1, w3, w2):
    b, s, d = h.shape
    t = h.reshape(b * s, d)
    grp_logits = (t @ w_grp + b_grp).astype(jnp.float32)
    grp_prob = jax.nn.softmax(grp_logits, axis=-1)
    grp_idx = jnp.argmax(grp_logits, axis=-1)
    grp_gate = jnp.take_along_axis(grp_prob, grp_idx[:, None], axis=-1)
    exp_logits = (t @ w_exp + b_exp).astype(jnp.float32).reshape(-1, N_EXPERT_GROUPS, EXPERTS_PER_GROUP)
    in_grp = jnp.take_along_axis(exp_logits, grp_idx[:, None, None], axis=1)[:, 0]
    top_val, top_idx = lax.top_k(in_grp, TOP_K_INNER)
    weights = grp_gate * jax.nn.softmax(top_val, axis=-1)
    expert_id = grp_idx[:, None].astype(jnp.int32) * EXPERTS_PER_GROUP + top_idx.astype(jnp.int32)
    out = expert_ffn_blocks(t, expert_id, weights, w1, w3, w2)
    return out.reshape(b, s, d)


def setup_inputs(seed: int = 0) -> dict:
    key = jax.random.key(seed)
    ks = jax.random.split(key, 25)
    f32 = jnp.float32
    L, D = DEPTH, D_MODEL

    def nrm(k, shape, scale):
        return jax.random.normal(k, shape, f32) * scale

    a0 = jax.random.uniform(ks[12], (L, LRU_WIDTH), f32, 0.9, 0.999)
    return {
        "x": nrm(ks[0], (BATCH, SEQ, D), 1.0),
        "c": nrm(ks[1], (BATCH, D), 1.0),
        "w_mod": nrm(ks[2], (L, D, 6 * D), 0.1 * D ** -0.5),
        "b_mod": nrm(ks[3], (L, 6 * D), 0.01),
        "norm1_g": 1.0 + nrm(ks[4], (L, D), 0.02),
        "w_in": nrm(ks[5], (L, D, IN_COLS), D ** -0.5),
        "conv_w": nrm(ks[6], (L, CONV_WIDTH, LRU_WIDTH), CONV_WIDTH ** -0.5),
        "conv_b": nrm(ks[7], (L, LRU_WIDTH), 0.01),
        "lru_wx": nrm(ks[8], (L, LRU_BLOCKS, LRU_BLOCK_DIM, LRU_BLOCK_DIM), LRU_BLOCK_DIM ** -0.5),
        "lru_bx": nrm(ks[9], (L, LRU_WIDTH), 0.01),
        "lru_wa": nrm(ks[10], (L, LRU_BLOCKS, LRU_BLOCK_DIM, LRU_BLOCK_DIM), LRU_BLOCK_DIM ** -0.5),
        "lru_ba": nrm(ks[11], (L, LRU_WIDTH), 0.01),
        "lru_lambda": jnp.log(a0) - jnp.log1p(-a0),
        "w_attn_o": nrm(ks[13], (L, ATTN_OUT_WIDTH, D), ATTN_OUT_WIDTH ** -0.5),
        "w_lru_o": nrm(ks[14], (L, LRU_WIDTH, D), LRU_WIDTH ** -0.5),
        "w_out": nrm(ks[15], (L, D, D), D ** -0.5),
        "norm2_g": 1.0 + nrm(ks[16], (L, D), 0.02),
        "w_grp": nrm(ks[17], (L, D, N_EXPERT_GROUPS), D ** -0.5),
        "b_grp": nrm(ks[18], (L, N_EXPERT_GROUPS), 0.01),
        "w_exp": nrm(ks[19], (L, D, N_EXPERTS), D ** -0.5),
        "b_exp": nrm(ks[20], (L, N_EXPERTS), 0.01),
        "w1": nrm(ks[21], (L, N_EXPERTS, D, D_EXPERT), D ** -0.5),
        "w3": nrm(ks[22], (L, N_EXPERTS, D, D_EXPERT), D ** -0.5),
        "w2": nrm(ks[23], (L, N_EXPERTS, D_EXPERT, D), D_EXPERT ** -0.5),
        "norm_f_g": 1.0 + nrm(ks[24], (D,), 0.02),
    }


def reference(x, c, w_mod, b_mod, norm1_g, w_in, conv_w, conv_b, lru_wx, lru_bx, lru_wa,
              lru_ba, lru_lambda, w_attn_o, w_lru_o, w_out, norm2_g, w_grp, b_grp, w_exp,
              b_exp, w1, w3, w2, norm_f_g):
    b, s, _ = x.shape
    c_act = jax.nn.silu(c)
    for l in range(DEPTH):
        mod = c_act @ w_mod[l] + b_mod[l]
        shift1, scale1, gate1, shift2, scale2, gate2 = jnp.split(mod[:, None, :], 6, axis=-1)

        h = rms_norm(x, norm1_g[l]) * (1.0 + scale1) + shift1
        proj = h @ w_in[l]
        q, k, v, xr, yr, gl = jnp.split(proj, IN_SPLITS, axis=-1)
        q = q.reshape(b, s, N_ATTN_HEADS, HEAD_DIM)
        k = k.reshape(b, s, N_ATTN_HEADS, HEAD_DIM)
        v = v.reshape(b, s, N_ATTN_HEADS, HEAD_DIM)
        attn = dilated_attention(q, k, v).reshape(b, s, ATTN_OUT_WIDTH).astype(x.dtype)

        xr = causal_depthwise_conv(xr, conv_w[l], conv_b[l])
        lru = rg_lru(xr, lru_wx[l], lru_bx[l], lru_wa[l], lru_ba[l], lru_lambda[l]) * jax.nn.gelu(yr)

        gates = jax.nn.sigmoid(gl.astype(jnp.float32)).astype(x.dtype)
        g_attn, g_lru = jnp.split(gates, N_BRANCHES, axis=-1)
        mixed = g_attn * (attn @ w_attn_o[l]) + g_lru * (lru @ w_lru_o[l])
        x = x + (1.0 + gate1) * (mixed @ w_out[l])

        h = rms_norm(x, norm2_g[l]) * (1.0 + scale2) + shift2
        x = x + (1.0 + gate2) * hierarchical_moe(h, w_grp[l], b_grp[l], w_exp[l], b_exp[l],
                                                 w1[l], w3[l], w2[l])
    return rms_norm(x, norm_f_g)
```

```cpp
#include <hip/hip_runtime.h>
#include <cstdio>
#include <cstdint>

#ifndef MK_N_LAUNCHES
#define MK_N_LAUNCHES 15
#endif
#ifndef MK_SIMPLE_GEMM
#define MK_SIMPLE_GEMM 0
#endif

#define GAS __attribute__((address_space(1)))
#define LAS __attribute__((address_space(3)))
typedef unsigned short bf16;
typedef unsigned v4u __attribute__((ext_vector_type(4)));
typedef unsigned v2u __attribute__((ext_vector_type(2)));
typedef float f32x4 __attribute__((ext_vector_type(4)));
typedef float f32x2 __attribute__((ext_vector_type(2)));
typedef short bf16x8 __attribute__((ext_vector_type(8)));
typedef GAS unsigned gu32;

constexpr int NB = 16, S = 2048, D = 1024, T = NB * S;
constexpr int HD = 64, NSLOT = 8, NHEAD = 24, AW = 1536, AOW = 512;
constexpr int IN_COLS = 8704, NE = 32, DE = 512, MAX_TILES = 288;
constexpr float EPS = 1e-6f;
constexpr int NWAVES = 8, NTHREADS = 512;

constexpr size_t MiB = 1u << 20, KiB = 1u << 10;
constexpr size_t WS_CTL = 0, CTL_ZERO_BYTES = 1 * MiB;
constexpr size_t WS_MOD = 128 * KiB;
constexpr size_t WS_TOKE = 1 * MiB, WS_TOKR = WS_TOKE + 256 * KiB, WS_TOKW = WS_TOKR + 256 * KiB, WS_TOKS = WS_TOKW + 256 * KiB;
constexpr size_t WS_WIN_T = 2 * MiB;
constexpr size_t WS_WAO_T = 19 * MiB, WS_WLO_T = 20 * MiB, WS_WOUT_T = 22 * MiB;
constexpr size_t WS_W13_T = 32 * MiB;
constexpr size_t WS_W2_T = 96 * MiB;
constexpr size_t WS_H = 128 * MiB;
constexpr size_t WS_R = 192 * MiB;
constexpr size_t WS_QKV = WS_R;
constexpr size_t WS_XR = WS_R, WS_YR = WS_R + 64 * MiB, WS_LRU = WS_R + 128 * MiB, WS_GA = WS_R + 192 * MiB, WS_GL = WS_R + 256 * MiB;
constexpr size_t WS_XP = WS_R, WS_HB = WS_R + 144 * MiB, WS_Y = WS_R;
constexpr size_t WS_END = 512 * MiB;
constexpr int CW_TMO = 0, CW_CNT = 1024, CW_BAR = 4096;

constexpr int RING_BYTES = 131072;
constexpr int LDSX_OFF = RING_BYTES;
constexpr int LDS_BYTES = 155648;
constexpr int MISC_OFF = LDS_BYTES - 256;

#define LDS_WAIT() asm volatile("s_waitcnt lgkmcnt(0)" ::: "memory")
#define VM_WAIT() asm volatile("s_waitcnt vmcnt(0)" ::: "memory")
#define RLX_AGENT __ATOMIC_RELAXED, __HIP_MEMORY_SCOPE_AGENT

__device__ __forceinline__ unsigned f2bf(float f) { unsigned u = __builtin_bit_cast(unsigned, f); return (u + 0x7fffu + ((u >> 16) & 1u)) >> 16; }
__device__ __forceinline__ unsigned pk2(float lo, float hi) { return f2bf(lo) | (f2bf(hi) << 16); }
__device__ __forceinline__ float bf_lo(unsigned u) { return __builtin_bit_cast(float, u << 16); }
__device__ __forceinline__ float bf_hi(unsigned u) { return __builtin_bit_cast(float, u & 0xffff0000u); }
__device__ __forceinline__ float bf2f(bf16 b) { return __builtin_bit_cast(float, ((unsigned)b) << 16); }
__device__ __forceinline__ float fast_rcp(float x) { return __builtin_amdgcn_rcpf(x); }
__device__ __forceinline__ float sigmoid_f(float x) { return fast_rcp(1.0f + __expf(-x)); }
__device__ __forceinline__ float gelu_tanh_f(float v) { const float u = 0.7978845608028654f * (v + 0.044715f * v * v * v); return v * fast_rcp(1.0f + __expf(-2.0f * u)); }
__device__ __forceinline__ float wave_sum(float v) {
#pragma unroll
    for (int o = 1; o < 64; o <<= 1) v += __shfl_xor(v, o);
    return v;
}

namespace pg8 {
#define PG8_LAS __attribute__((address_space(3)))
typedef unsigned short bf16_t;
constexpr int BM = 256, BK = 64, HALF = 128, HTB = HALF * BK * 2, STAGE_BYTES = 8 * HTB, NXCD = 8, WGM = 8;

__host__ __device__ __forceinline__ int lds_byte(int r, int c) { const int st = (r >> 4) * 2 + (c >> 5), rr = r & 15, cc = c & 31, ob = rr * 64 + cc * 2; return st * 1024 + (ob ^ (((ob >> 9) & 1) << 5)); }
__host__ __device__ __forceinline__ void stage_rc(int b, int& R, int& C) { const int st = b / 1024, sb = b % 1024, swz = sb ^ (((sb >> 9) & 1) << 5); R = (st >> 1) * 16 + swz / 64; C = (st & 1) * 32 + (swz % 64) / 2; }
__host__ __device__ __forceinline__ int perm32(int rho) { const int n = rho >> 4, i = rho & 15; return 8 * (i >> 2) + 4 * n + (i & 3); }

struct Unit { int pm, pn, e; };
struct Gemm { const bf16_t* A; const bf16_t* Bt; int M, N, K; size_t estride; };

struct StaticOrder {
    int nM, nN, nwg, G, c;
    __host__ __device__ void init(int M, int N, int G_, int c_) { nM = M / BM; nN = N / BM; nwg = nM * nN; G = G_; c = c_; }
    __host__ __device__ bool next(int i, Unit& u) const {
        const long L = (long)i * G + c; if (L >= nwg) return false;
        int wgid = (int)L; { const int q = nwg / NXCD, r = nwg % NXCD, xcd = wgid % NXCD, off = wgid / NXCD; wgid = (xcd < r ? xcd * (q + 1) : r * (q + 1) + (xcd - r) * q) + off; }
        const int nig = WGM * nN, gid = wgid / nig, fm = gid * WGM, gsz = (nM - fm) < WGM ? (nM - fm) : WGM;
        u.pm = fm + ((wgid % nig) % gsz); u.pn = (wgid % nig) / gsz; u.e = 0; return true;
    }
};
struct MoeOrder {
    int ntiles, G, vcu; const PG8_LAS int* tile_e;
    __device__ bool next(int i, Unit& u) const {
        const int L = i * G + vcu; if (L >= ntiles * 4) return false;
        u.pm = L >> 2; u.pn = L & 3; u.e = __builtin_amdgcn_readfirstlane(tile_e[u.pm]); return true;
    }
};

template <class Epi> __device__ __forceinline__ void run_epi(const Epi& E, const f32x4 (&acc)[2][2][4][2], const Unit& u, int wr, int wc, int fr, int fq) {
    const int row0 = u.pm * BM + wr * 64 + fr, col0 = u.pn * BM + wc * 32 + 8 * fq;
#pragma unroll
    for (int ai = 0; ai < 2; ++ai)
#pragma unroll
        for (int m = 0; m < 4; ++m)
#pragma unroll
            for (int bj = 0; bj < 2; ++bj) E.store8(row0 + ai * HALF + m * 16, col0 + bj * HALF, acc[ai][bj][m][0], acc[ai][bj][m][1]);
}

template <class Epi, class Sched, bool ALIGN_EPI = true>
__device__ __forceinline__ void gemm_phase(PG8_LAS unsigned char* lds, const Gemm g, const Sched& S, const Epi& E) {
    const int tid = threadIdx.x, wid = __builtin_amdgcn_readfirstlane(tid >> 6), lane = tid & 63, wr = wid >> 2, wc = wid & 3, fr = lane & 15, fq = lane >> 4;
    const int K = g.K, nt = K / BK;
    unsigned voffA[2], voffB[2];
#pragma unroll
    for (int i = 0; i < 2; ++i) { int R, C; stage_rc(tid * 16 + i * 8192, R, C); const int Rb = (R & ~31) + perm32(R & 31);
        voffA[i] = (unsigned)(R * K + C) * 2u; voffB[i] = (unsigned)(Rb * K + C) * 2u; }
    const size_t kstep = (size_t)(BK * 2);
    const size_t hstep = (size_t)HALF * K * 2;
    const size_t tstep = 2 * hstep;
    const unsigned ldsw = (unsigned)wid * 1024u;
    const int aoff = lds_byte(wr * 64 + fr, fq * 8), boff = lds_byte(wc * 32 + fr, fq * 8);
#define PG8_SA(b, h) (((b) * 2 + (h)) * HTB)
#define PG8_SB(b, h) ((4 + (b) * 2 + (h)) * HTB)
#define PG8_STAGE(bufoff, gbase, voff) do { _Pragma("unroll") for (int _i = 0; _i < 2; ++_i) \
        __builtin_amdgcn_global_load_lds((const unsigned*)((const char*)(gbase) + (voff)[_i]), (PG8_LAS unsigned*)(lds + (bufoff) + ldsw + _i * 8192), 16, 0, 0); } while (0)
#define PG8_LDA(dst, b, h) do { _Pragma("unroll") for (int m = 0; m < 4; ++m) _Pragma("unroll") for (int k = 0; k < 2; ++k) dst[m][k] = *(const PG8_LAS bf16x8*)(lds + PG8_SA(b, h) + aoff + m * 2048 + k * 1024); } while (0)
#define PG8_LDB(dst, b, h) do { _Pragma("unroll") for (int n = 0; n < 2; ++n) _Pragma("unroll") for (int k = 0; k < 2; ++k) dst[n][k] = *(const PG8_LAS bf16x8*)(lds + PG8_SB(b, h) + boff + n * 2048 + k * 1024); } while (0)
#define PG8_MMA(ai, bj, At, Bt) do { __builtin_amdgcn_s_setprio(1); _Pragma("unroll") for (int m = 0; m < 4; ++m) _Pragma("unroll") for (int n = 0; n < 2; ++n) _Pragma("unroll") for (int k = 0; k < 2; ++k) \
        acc[ai][bj][m][n] = __builtin_amdgcn_mfma_f32_16x16x32_bf16(Bt[n][k], At[m][k], acc[ai][bj][m][n], 0, 0, 0); __builtin_amdgcn_s_setprio(0); } while (0)
#define PG8_WAIT_V(n) asm volatile("s_waitcnt vmcnt(" #n ")" ::: "memory")
#define PG8_WAIT_L(n) asm volatile("s_waitcnt lgkmcnt(" #n ")" ::: "memory")
#define PG8_BAR __builtin_amdgcn_s_barrier()
#define PG8_SCHED __builtin_amdgcn_sched_barrier(0)
    Unit cur, nxt; int ui = 0;
    if (!S.next(0, cur)) return;
    f32x4 acc[2][2][4][2];
#pragma unroll
    for (int a = 0; a < 2; ++a)
#pragma unroll
        for (int b = 0; b < 2; ++b)
#pragma unroll
            for (int m = 0; m < 4; ++m)
#pragma unroll
                for (int n = 0; n < 2; ++n) acc[a][b][m][n] = (f32x4){0.f, 0.f, 0.f, 0.f};
    bf16x8 At[4][2], B0[2][2], B1[2][2];
    const char* cA = (const char*)g.A + (size_t)cur.pm * tstep; const char* cB = (const char*)g.Bt + (size_t)cur.e * g.estride + (size_t)cur.pn * tstep;
    PG8_STAGE(PG8_SB(0, 0), cB, voffB); PG8_STAGE(PG8_SB(0, 1), cB + hstep, voffB); PG8_STAGE(PG8_SA(0, 0), cA, voffA); PG8_STAGE(PG8_SA(0, 1), cA + hstep, voffA);
    if (wr == 1) PG8_BAR;
    PG8_WAIT_V(2); PG8_BAR;
    PG8_STAGE(PG8_SB(1, 0), cB + kstep, voffB); PG8_STAGE(PG8_SA(1, 0), cA + kstep, voffA); PG8_STAGE(PG8_SB(1, 1), cB + hstep + kstep, voffB);
    PG8_WAIT_V(6); PG8_BAR;
    for (;;) {
        const bool has_next = S.next(ui + 1, nxt);
        const char* nA = has_next ? (const char*)g.A + (size_t)nxt.pm * tstep : cA; const char* nB = has_next ? (const char*)g.Bt + (size_t)nxt.e * g.estride + (size_t)nxt.pn * tstep : cB;
        for (int t = 0; t < nt; t += 2) {
            const bool last = (t == nt - 2);
            const char* a1 = cA + (size_t)(t + 1) * kstep;
            const char* a2 = last ? nA : cA + (size_t)(t + 2) * kstep; const char* b2 = last ? nB : cB + (size_t)(t + 2) * kstep;
            const char* a3 = a2 + kstep; const char* b3 = b2 + kstep;
            PG8_LDB(B0, 0, 0); PG8_LDB(B1, 0, 1); PG8_SCHED; PG8_LDA(At, 0, 0); PG8_STAGE(PG8_SA(1, 1), a1 + hstep, voffA);
            PG8_WAIT_V(8); PG8_WAIT_L(0); PG8_BAR; PG8_MMA(0, 0, At, B0); PG8_MMA(0, 1, At, B1); PG8_BAR; PG8_SCHED;
            PG8_LDA(At, 0, 1); PG8_STAGE(PG8_SB(0, 0), b2, voffB); PG8_STAGE(PG8_SB(0, 1), b2 + hstep, voffB); PG8_STAGE(PG8_SA(0, 0), a2, voffA);
            PG8_WAIT_V(8); PG8_WAIT_L(0); PG8_BAR; PG8_MMA(1, 0, At, B0); PG8_MMA(1, 1, At, B1); PG8_BAR; PG8_SCHED;
            PG8_LDB(B0, 1, 0); PG8_LDB(B1, 1, 1); PG8_SCHED; PG8_LDA(At, 1, 0); PG8_STAGE(PG8_SA(0, 1), a2 + hstep, voffA);
            PG8_WAIT_V(8); PG8_WAIT_L(0); PG8_BAR; PG8_MMA(0, 0, At, B0); PG8_MMA(0, 1, At, B1); PG8_BAR; PG8_SCHED;
            PG8_LDA(At, 1, 1); PG8_STAGE(PG8_SB(1, 0), b3, voffB); PG8_STAGE(PG8_SB(1, 1), b3 + hstep, voffB); PG8_STAGE(PG8_SA(1, 0), a3, voffA);
            PG8_WAIT_V(8); PG8_WAIT_L(0); PG8_BAR; PG8_MMA(1, 0, At, B0); PG8_MMA(1, 1, At, B1); PG8_BAR; PG8_SCHED;
        }
        if constexpr (ALIGN_EPI) { if (wr == 0) PG8_BAR; }
        run_epi(E, acc, cur, wr, wc, fr, fq);
        if (!has_next) break;
#pragma unroll
        for (int a = 0; a < 2; ++a)
#pragma unroll
            for (int b = 0; b < 2; ++b)
#pragma unroll
                for (int m = 0; m < 4; ++m)
#pragma unroll
                    for (int n = 0; n < 2; ++n) acc[a][b][m][n] = (f32x4){0.f, 0.f, 0.f, 0.f};
        cur = nxt; cA = nA; cB = nB; ++ui;
        if constexpr (ALIGN_EPI) { if (wr == 1) PG8_BAR; }
    }
    PG8_WAIT_V(0);
    if constexpr (!ALIGN_EPI) { if (wr == 0) PG8_BAR; }
    PG8_BAR;
#undef PG8_SA
#undef PG8_SB
#undef PG8_STAGE
#undef PG8_LDA
#undef PG8_LDB
#undef PG8_MMA
#undef PG8_WAIT_V
#undef PG8_WAIT_L
#undef PG8_BAR
#undef PG8_SCHED
}

template <class Epi, class Sched>
__device__ __forceinline__ void gemm_phase_simple(const Gemm g, const Sched& S, const Epi& E) {
    const int tid = threadIdx.x, wid = tid >> 6, lane = tid & 63, wr = wid >> 2, wc = wid & 3, fr = lane & 15, fq = lane >> 4;
    const int K = g.K;
    Unit cur;
    for (int ui = 0; S.next(ui, cur); ++ui) {
        f32x4 acc[2][2][4][2];
#pragma unroll
        for (int a = 0; a < 2; ++a)
#pragma unroll
            for (int b = 0; b < 2; ++b)
#pragma unroll
                for (int m = 0; m < 4; ++m)
#pragma unroll
                    for (int n = 0; n < 2; ++n) acc[a][b][m][n] = (f32x4){0.f, 0.f, 0.f, 0.f};
        const bf16_t* Ab = g.A + (size_t)(cur.pm * BM + wr * 64 + fr) * K;
        const bf16_t* Bb = (const bf16_t*)((const char*)g.Bt + (size_t)cur.e * g.estride) + (size_t)(cur.pn * BM + wc * 32 + 8 * fq) * K;
        for (int k0 = 0; k0 < K; k0 += 2) {
            float av[2][4][2], bv[2][8][2];
#pragma unroll
            for (int ai = 0; ai < 2; ++ai)
#pragma unroll
                for (int m = 0; m < 4; ++m) { const unsigned u = *(const unsigned*)(Ab + (size_t)(ai * HALF + m * 16) * K + k0); av[ai][m][0] = bf_lo(u); av[ai][m][1] = bf_hi(u); }
#pragma unroll
            for (int bj = 0; bj < 2; ++bj)
#pragma unroll
                for (int j = 0; j < 8; ++j) { const unsigned u = *(const unsigned*)(Bb + (size_t)(bj * HALF + j) * K + k0); bv[bj][j][0] = bf_lo(u); bv[bj][j][1] = bf_hi(u); }
#pragma unroll
            for (int ai = 0; ai < 2; ++ai)
#pragma unroll
                for (int bj = 0; bj < 2; ++bj)
#pragma unroll
                    for (int m = 0; m < 4; ++m)
#pragma unroll
                        for (int n = 0; n < 2; ++n)
#pragma unroll
                            for (int j = 0; j < 4; ++j) acc[ai][bj][m][n][j] += av[ai][m][0] * bv[bj][n * 4 + j][0] + av[ai][m][1] * bv[bj][n * 4 + j][1];
        }
        run_epi(E, acc, cur, wr, wc, fr, fq);
    }
}
}

__device__ __forceinline__ v4u pack8(const f32x4 a, const f32x4 b) { v4u w; w.x = pk2(a[0], a[1]); w.y = pk2(a[2], a[3]); w.z = pk2(b[0], b[1]); w.w = pk2(b[2], b[3]); return w; }
__device__ __forceinline__ void unpack8(const v4u w, f32x4& a, f32x4& b) { a = (f32x4){bf_lo(w.x), bf_hi(w.x), bf_lo(w.y), bf_hi(w.y)}; b = (f32x4){bf_lo(w.z), bf_hi(w.z), bf_lo(w.w), bf_hi(w.w)}; }

struct EpiQKV { bf16* QKV;
    __device__ __forceinline__ void store8(int row, int col, f32x4 v0, f32x4 v1) const {
        const int which = col / AW, rem = col - which * AW, hh = rem >> 6, dim0 = rem & 63, sh = 2 * (hh >> 3);
        const int b = row >> 11, s = row & 2047, pos = ((s & ((1 << sh) - 1)) << (11 - sh)) | (s >> sh);
        if (which == 0) { v0 = v0 * 0.125f; v1 = v1 * 0.125f; }
        *(GAS v4u*)(QKV + ((((size_t)(which * NB + b) * NHEAD + hh) * S + pos) * HD + dim0)) = pack8(v0, v1);
    } };
struct EpiXY { bf16* XR; bf16* YR;
    __device__ __forceinline__ void store8(int row, int col, f32x4 v0, f32x4 v1) const {
        if (col < D) { *(GAS v4u*)(XR + (size_t)row * D + col) = pack8(v0, v1); }
        else {
#pragma unroll
            for (int j = 0; j < 4; ++j) { v0[j] = gelu_tanh_f(v0[j]); v1[j] = gelu_tanh_f(v1[j]); }
            *(GAS v4u*)(YR + (size_t)row * D + (col - D)) = pack8(v0, v1); }
    } };
struct EpiGate { bf16* GA; bf16* GL;
    __device__ __forceinline__ void store8(int row, int col, f32x4 v0, f32x4 v1) const {
#pragma unroll
        for (int j = 0; j < 4; ++j) { v0[j] = sigmoid_f(v0[j]); v1[j] = sigmoid_f(v1[j]); }
        bf16* dst = col < D ? GA + (size_t)row * D + col : GL + (size_t)row * D + (col - D);
        *(GAS v4u*)dst = pack8(v0, v1);
    } };
struct EpiP4a { bf16* GA;
    __device__ __forceinline__ void store8(int row, int col, f32x4 v0, f32x4 v1) const {
        GAS v4u* p = (GAS v4u*)(GA + (size_t)row * D + col); f32x4 g0, g1; unpack8(*p, g0, g1);
        *p = pack8(g0 * v0, g1 * v1);
    } };
struct EpiP4b { const bf16* TMP; bf16* GL;
    __device__ __forceinline__ void store8(int row, int col, f32x4 v0, f32x4 v1) const {
        GAS v4u* p = (GAS v4u*)(GL + (size_t)row * D + col); f32x4 g0, g1, t0, t1; unpack8(*p, g0, g1); unpack8(*(const GAS v4u*)(TMP + (size_t)row * D + col), t0, t1);
        *p = pack8(t0 + g0 * v0, t1 + g1 * v1);
    } };
struct EpiP5 { const float* X; const float* MOD; float* X1;
    __device__ __forceinline__ void store8(int row, int col, f32x4 v0, f32x4 v1) const {
        const int b = row >> 11; const float* gp = MOD + b * 6144 + 2048 + col; const float* xp = X + (size_t)row * D + col;
        const f32x4 g0 = *(const GAS f32x4*)gp, g1 = *(const GAS f32x4*)(gp + 4), x0 = *(const GAS f32x4*)xp, x1 = *(const GAS f32x4*)(xp + 4);
        GAS f32x4* o = (GAS f32x4*)(X1 + (size_t)row * D + col);
        o[0] = x0 + (g0 + 1.0f) * v0; o[1] = x1 + (g1 + 1.0f) * v1;
    } };
struct EpiMoeA { bf16* HB;
    __device__ __forceinline__ void store8(int row, int col, f32x4 v0, f32x4 v1) const {
        f32x4 r;
#pragma unroll
        for (int j = 0; j < 4; ++j) r[j] = v0[j] * sigmoid_f(v0[j]) * v1[j];
        v2u w; w.x = pk2(r[0], r[1]); w.y = pk2(r[2], r[3]);
        *(GAS v2u*)(HB + (size_t)row * DE + (col >> 1)) = w;
    } };
struct EpiMoeB { bf16* Y;
    __device__ __forceinline__ void store8(int row, int col, f32x4 v0, f32x4 v1) const { *(GAS v4u*)(Y + (size_t)row * D + col) = pack8(v0, v1); } };

#define XB_TMO      128
#define XB_XCNT(j)  (256  + 64 * (j))
#define XB_XSUB(j)  (1280 + 64 * (j))
#define XB_XGEN(j)  (2304 + 64 * (j))
#define XB_TOP      3328
#define XB_TOPGEN   3392
#define XCD_BAR_WORDS 3456
#define XB_SPIN_CAP (1u << 20)
__device__ __forceinline__ unsigned xb_ld(unsigned* p)              { return __hip_atomic_load(p, __ATOMIC_RELAXED, __HIP_MEMORY_SCOPE_AGENT); }
__device__ __forceinline__ unsigned xb_add(unsigned* p, unsigned v) { return __hip_atomic_fetch_add(p, v, __ATOMIC_RELAXED, __HIP_MEMORY_SCOPE_AGENT); }
__device__ __forceinline__ unsigned xb_xcc_id() { return (unsigned)__builtin_amdgcn_s_getreg((3 << 11) | 20) & 0xFu; }
#define XB_SPIN(cond, bar) do { unsigned _sp = 0; while (cond) { __builtin_amdgcn_s_sleep(1); \
    if ((++_sp & 255u) == 0u) { if (xb_ld(&(bar)[XB_TMO])) break; if (_sp > XB_SPIN_CAP) { atomicAdd(&(bar)[XB_TMO], 1u); break; } } } } while (0)
struct XcdBarrier { unsigned* bar; unsigned x; volatile LAS unsigned* st; };
__device__ __forceinline__ XcdBarrier xcd_barrier_post(unsigned* bar, volatile LAS unsigned* st) {
    XcdBarrier b; b.bar = bar; b.x = xb_xcc_id(); b.st = st;
    if (threadIdx.x == 0) (void)xb_add(&bar[XB_XCNT(b.x)], 1u);
    return b;
}
__device__ __forceinline__ void xcd_barrier_complete(unsigned* bar, unsigned x, unsigned& nloc, unsigned& nx) {
    const unsigned G = gridDim.x * gridDim.y * gridDim.z;
    unsigned sum, cnt, mine, sp = 0u;
    for (;;) {
        sum = 0u; cnt = 0u; mine = 0u;
#pragma unroll
        for (unsigned j = 0; j < 16; ++j) { const unsigned c = xb_ld(&bar[XB_XCNT(j)]); sum += c; cnt += (c > 0u) ? 1u : 0u; mine = (j == x) ? c : mine; }
        if (sum == G) break;
        __builtin_amdgcn_s_sleep(1);
        if ((++sp & 255u) == 0u) { if (xb_ld(&bar[XB_TMO])) break; if (sp > XB_SPIN_CAP) { atomicAdd(&bar[XB_TMO], 1u); break; } }
    }
    nloc = mine > 0u ? mine : 1u; nx = cnt > 0u ? cnt : 1u;
}
__device__ __forceinline__ void xcd_barrier(const XcdBarrier& b) {
    asm volatile("s_waitcnt vmcnt(0)" ::: "memory");
    __syncthreads();
    if (threadIdx.x == 0) {
        unsigned* bar = b.bar;
        __builtin_amdgcn_s_waitcnt(0);
        unsigned nloc = b.st[0], nx = b.st[1];
        if (nloc == 0u) { xcd_barrier_complete(bar, b.x, nloc, nx); b.st[0] = nloc; b.st[1] = nx; }
        const unsigned old = xb_add(&bar[XB_XSUB(b.x)], 1u);
        const unsigned gen = old / nloc;
        if (old + 1u == (gen + 1u) * nloc) {
            __builtin_amdgcn_fence(__ATOMIC_RELEASE, "agent");
            asm volatile("s_waitcnt vmcnt(0)" ::: "memory");
            const unsigned og = xb_add(&bar[XB_TOP], 1u);
            const unsigned tg = og / nx;
            if (og + 1u == (tg + 1u) * nx) xb_add(&bar[XB_TOPGEN], 1u);
            else XB_SPIN(xb_ld(&bar[XB_TOPGEN]) == tg, bar);
            __builtin_amdgcn_fence(__ATOMIC_ACQUIRE, "agent");
            xb_add(&bar[XB_XGEN(b.x)], 1u);
            asm volatile("s_waitcnt vmcnt(0)" ::: "memory");
        } else {
            XB_SPIN(xb_ld(&bar[XB_XGEN(b.x)]) == gen, bar);
            __builtin_amdgcn_fence(__ATOMIC_ACQUIRE, "agent");
            asm volatile("s_waitcnt vmcnt(0)" ::: "memory");
        }
    }
    __syncthreads();
}

struct Args { const float* in[25]; float* out; unsigned char* ws; int ph_lo, ph_hi; };
struct Frame {
    LAS unsigned char* lds; volatile LAS unsigned* MISC; gu32* ctl;
    int tid, lane, wave, vcu, G;
};

__device__ __forceinline__ void p0_transpose_item(const float* W, int K, int N, bf16* WT, int row_off, int mode, LAS float* scr, int item, int lane) {
    const int nblk = N / 32, kb = item / nblk, nb = item % nblk, k0 = 64 * kb, n0 = 32 * nb;
#pragma unroll 8
    for (int i = 0; i < 32; ++i) { const int kk = 2 * i + (lane >> 5); scr[kk * 33 + (lane & 31)] = W[(size_t)(k0 + kk) * N + n0 + (lane & 31)]; }
    LDS_WAIT(); asm volatile("" ::: "memory");
    const int c = lane & 7;
#pragma unroll
    for (int j = 0; j < 4; ++j) { const int n = (lane >> 3) + 8 * j; const LAS float* s = scr + (8 * c) * 33 + n;
        v4u o; o.x = pk2(s[0 * 33], s[1 * 33]); o.y = pk2(s[2 * 33], s[3 * 33]); o.z = pk2(s[4 * 33], s[5 * 33]); o.w = pk2(s[6 * 33], s[7 * 33]);
        const int nn = n0 + n; const int r = mode == 0 ? row_off + nn : row_off + 8 * (nn >> 2) + (nn & 3) + (mode == 2 ? 4 : 0);
        *(GAS v4u*)(WT + (size_t)r * K + k0 + 8 * c) = o; }
    LDS_WAIT(); asm volatile("" ::: "memory");
}
__device__ __forceinline__ void p0_prologue(Frame& F, const Args& a) {
    unsigned char* ws = a.ws;
    LAS float* scr = (LAS float*)(F.lds + F.wave * 16384);
    const int gw = F.vcu * NWAVES + F.wave, NGW = F.G * NWAVES;
    constexpr int I_IN = (D / 64) * (IN_COLS / 32), I_AO = (AOW / 64) * (D / 32), I_LO = (D / 64) * (D / 32), I_OUT = I_LO, I_E = 256;
    constexpr int NDENSE = I_IN + I_AO + I_LO + I_OUT, NITEMS = NDENSE + 3 * NE * I_E;
    for (int it = gw; it < NITEMS; it += NGW) {
        int r = it;
        if (r < I_IN) { p0_transpose_item(a.in[5], D, IN_COLS, (bf16*)(ws + WS_WIN_T), 0, 0, scr, r, F.lane); continue; } r -= I_IN;
        if (r < I_AO) { p0_transpose_item(a.in[13], AOW, D, (bf16*)(ws + WS_WAO_T), 0, 0, scr, r, F.lane); continue; } r -= I_AO;
        if (r < I_LO) { p0_transpose_item(a.in[14], D, D, (bf16*)(ws + WS_WLO_T), 0, 0, scr, r, F.lane); continue; } r -= I_LO;
        if (r < I_OUT) { p0_transpose_item(a.in[15], D, D, (bf16*)(ws + WS_WOUT_T), 0, 0, scr, r, F.lane); continue; } r -= I_OUT;
        const int mat = r / I_E, item = r % I_E, e = mat / 3, which = mat % 3;
        if (which == 0) p0_transpose_item(a.in[21] + (size_t)e * D * DE, D, DE, (bf16*)(ws + WS_W13_T), e * 1024, 1, scr, item, F.lane);
        else if (which == 1) p0_transpose_item(a.in[22] + (size_t)e * D * DE, D, DE, (bf16*)(ws + WS_W13_T), e * 1024, 2, scr, item, F.lane);
        else p0_transpose_item(a.in[23] + (size_t)e * DE * D, DE, D, (bf16*)(ws + WS_W2_T), e * 1024, 0, scr, item, F.lane);
    }
    if (F.vcu < 192) {
        __syncthreads();
        const float* c = a.in[1]; const float* wm = a.in[2]; const float* bm = a.in[3]; float* MOD = (float*)(ws + WS_MOD);
        LAS float* CA = (LAS float*)F.lds;
        LAS float* PART = (LAS float*)(F.lds + 65536);
        for (int i = F.tid; i < NB * D; i += NTHREADS) { const float v = c[i]; CA[i] = v * sigmoid_f(v); }
        __syncthreads();
        const int kq = F.tid >> 5, col = F.tid & 31, n = F.vcu * 32 + col;
        float acc[NB];
#pragma unroll
        for (int b = 0; b < NB; ++b) acc[b] = 0.f;
#pragma unroll 4
        for (int i = 0; i < 64; ++i) { const int k = kq + 16 * i; const float w = wm[(size_t)k * 6144 + n];
#pragma unroll
            for (int b = 0; b < NB; ++b) acc[b] += CA[b * D + k] * w; }
#pragma unroll
        for (int b = 0; b < NB; ++b) PART[(kq * NB + b) * 32 + col] = acc[b];
        __syncthreads();
        { const int b = F.tid >> 5; float sum = bm[n];
#pragma unroll
            for (int q = 0; q < 16; ++q) sum += PART[(q * NB + b) * 32 + col];
            MOD[b * 6144 + n] = sum; }
        __syncthreads();
    }
}
__device__ __forceinline__ void norm_mod_row(const float* xrow, const float* g, const float* shift, const float* scale, int lane, f32x4 (&h)[4]) {
    const GAS f32x4* xr = (const GAS f32x4*)xrow + lane; float ss = 0.f;
#pragma unroll
    for (int j = 0; j < 4; ++j) { h[j] = xr[64 * j]; ss += (h[j].x * h[j].x + h[j].y * h[j].y) + (h[j].z * h[j].z + h[j].w * h[j].w); }
    const float rstd = 1.0f / sqrtf(wave_sum(ss) * (1.0f / D) + EPS);
#pragma unroll
    for (int j = 0; j < 4; ++j) { const f32x4 gg = ((const GAS f32x4*)g + lane)[64 * j], sc = ((const GAS f32x4*)scale + lane)[64 * j], sf = ((const GAS f32x4*)shift + lane)[64 * j];
        h[j] = h[j] * rstd * gg * (sc + 1.0f) + sf; }
}
__device__ __forceinline__ void store_row_bf16(bf16* orow, int lane, const f32x4 (&h)[4]) {
    GAS v2u* o8 = (GAS v2u*)orow + lane;
#pragma unroll
    for (int j = 0; j < 4; ++j) { v2u w; w.x = pk2(h[j].x, h[j].y); w.y = pk2(h[j].z, h[j].w); o8[64 * j] = w; }
}
__device__ __forceinline__ void p1_norm1(Frame& F, const Args& a) {
    const int gw = F.vcu * NWAVES + F.wave, NGW = F.G * NWAVES;
    const float* MOD = (const float*)(a.ws + WS_MOD); bf16* H = (bf16*)(a.ws + WS_H);
    for (int m = gw; m < T; m += NGW) { const int b = m >> 11; f32x4 h[4];
        norm_mod_row(a.in[0] + (size_t)m * D, a.in[4], MOD + b * 6144, MOD + b * 6144 + 1024, F.lane, h);
        store_row_bf16(H + (size_t)m * D, F.lane, h); }
}
__device__ __forceinline__ void p3_attention_simple(Frame& F, const Args& a) {
    const bf16* QKV = (const bf16*)(a.ws + WS_QKV); bf16* ATT = (bf16*)a.out;
    const int gt = F.vcu * NTHREADS + F.tid, NGT = F.G * NTHREADS;
    for (int q = gt; q < NB * NSLOT * S; q += NGT) {
        const int s = q & 2047, slot = (q >> 11) & 7, b = q >> 14;
        float o[HD]; float m = -INFINITY, l = 0.f;
#pragma unroll
        for (int d = 0; d < HD; ++d) o[d] = 0.f;
        for (int g = 0; g < 3; ++g) {
            const int hh = g * 8 + slot, sh = 2 * g, nsub = S >> sh, p = s & ((1 << sh) - 1), i = s >> sh;
            const bf16* Qp = QKV + (((size_t)(0 * NB + b) * NHEAD + hh) * S + p * nsub + i) * HD;
            const bf16* Kp = QKV + (((size_t)(1 * NB + b) * NHEAD + hh) * S + p * nsub) * HD;
            const bf16* Vp = QKV + (((size_t)(2 * NB + b) * NHEAD + hh) * S + p * nsub) * HD;
            float qv[HD];
#pragma unroll
            for (int c = 0; c < 8; ++c) { const v4u w = *(const GAS v4u*)(Qp + 8 * c); f32x4 x0, x1; unpack8(w, x0, x1);
#pragma unroll
                for (int j = 0; j < 4; ++j) { qv[8 * c + j] = x0[j]; qv[8 * c + 4 + j] = x1[j]; } }
            const int j0 = i - 128 < 0 ? 0 : i - 128;
            for (int j = j0; j <= i; ++j) {
                float dot = 0.f;
#pragma unroll
                for (int c = 0; c < 8; ++c) { const v4u w = *(const GAS v4u*)(Kp + (size_t)j * HD + 8 * c); f32x4 x0, x1; unpack8(w, x0, x1);
#pragma unroll
                    for (int jj = 0; jj < 4; ++jj) dot += qv[8 * c + jj] * x0[jj] + qv[8 * c + 4 + jj] * x1[jj]; }
                const float mn = fmaxf(m, dot), al = __expf(m - mn), pe = __expf(dot - mn);
                l = l * al + pe; m = mn;
#pragma unroll
                for (int c = 0; c < 8; ++c) { const v4u w = *(const GAS v4u*)(Vp + (size_t)j * HD + 8 * c); f32x4 x0, x1; unpack8(w, x0, x1);
#pragma unroll
                    for (int jj = 0; jj < 4; ++jj) { o[8 * c + jj] = o[8 * c + jj] * al + pe * x0[jj]; o[8 * c + 4 + jj] = o[8 * c + 4 + jj] * al + pe * x1[jj]; } }
            }
        }
        const float inv = 1.0f / l;
        bf16* op = ATT + ((size_t)(b * S + s)) * AOW + slot * HD;
#pragma unroll
        for (int c = 0; c < 8; ++c) { v4u w; w.x = pk2(o[8 * c] * inv, o[8 * c + 1] * inv); w.y = pk2(o[8 * c + 2] * inv, o[8 * c + 3] * inv); w.z = pk2(o[8 * c + 4] * inv, o[8 * c + 5] * inv); w.w = pk2(o[8 * c + 6] * inv, o[8 * c + 7] * inv);
            *(GAS v4u*)(op + 8 * c) = w; }
    }
}
__device__ __forceinline__ void p5_lru_simple(Frame& F, const Args& a) {
    const bf16* XR = (const bf16*)(a.ws + WS_XR); const bf16* YR = (const bf16*)(a.ws + WS_YR); bf16* LRU = (bf16*)(a.ws + WS_LRU);
    const int gw = F.vcu * NWAVES + F.wave, NGW = F.G * NWAVES, lane = F.lane;
    for (int item = gw; item < NB * 16; item += NGW) {
        const int b = item >> 4, cb = item & 15, c = cb * 64 + lane;
        float wx[64], wa[64];
#pragma unroll
        for (int i = 0; i < 64; ++i) { wx[i] = a.in[8][(size_t)(cb * 64 + i) * 64 + lane]; wa[i] = a.in[10][(size_t)(cb * 64 + i) * 64 + lane]; }
        const float cw0 = a.in[6][c], cw1 = a.in[6][D + c], cw2 = a.in[6][2 * D + c], cw3 = a.in[6][3 * D + c], cbias = a.in[7][c];
        const float bx = a.in[9][c], ba = a.in[11][c], lam = a.in[12][c];
        const float sp = log1pf(__expf(-lam));
        float x1 = 0.f, x2 = 0.f, x3 = 0.f, h = 0.f;
        for (int s = 0; s < S; ++s) {
            const size_t idx = ((size_t)(b * S + s)) * D + c;
            const float xr = bf2f(XR[idx]);
            const float xc = cw0 * x3 + cw1 * x2 + cw2 * x1 + cw3 * xr + cbias;
            x3 = x2; x2 = x1; x1 = xr;
            float pi = bx, pr = ba;
#pragma unroll
            for (int i = 0; i < 64; ++i) { const float xi = __shfl(xc, i); pi += xi * wx[i]; pr += xi * wa[i]; }
            const float gi = sigmoid_f(pi), gr = sigmoid_f(pr);
            const float log_a = -8.0f * gr * sp, av = __expf(log_a), mult = sqrtf(fmaxf(0.f, -expm1f(2.0f * log_a)));
            h = av * h + mult * gi * xc;
            LRU[idx] = (bf16)f2bf(h * bf2f(YR[idx]));
        }
    }
}
__device__ __forceinline__ void p10_router(Frame& F, const Args& a) {
    LAS float* WT = (LAS float*)F.lds;
    for (int i = F.tid; i < 36 * D; i += NTHREADS) { const int o = i >> 10, k = i & 1023; WT[i] = o < 4 ? a.in[17][k * 4 + o] : a.in[19][k * 32 + (o - 4)]; }
    __syncthreads();
    const int gw = F.vcu * NWAVES + F.wave, NGW = F.G * NWAVES, lane = F.lane;
    const float* MOD = (const float*)(a.ws + WS_MOD); bf16* H2 = (bf16*)(a.ws + WS_H); const float* X1 = a.out;
    int* TOKE = (int*)(a.ws + WS_TOKE); int* TOKR = (int*)(a.ws + WS_TOKR); float* TOKW = (float*)(a.ws + WS_TOKW);
    for (int m = gw; m < T; m += NGW) { const int b = m >> 11; f32x4 h[4];
        norm_mod_row(X1 + (size_t)m * D, a.in[16], MOD + b * 6144 + 3072, MOD + b * 6144 + 4096, lane, h);
        store_row_bf16(H2 + (size_t)m * D, lane, h);
        float lg[36];
#pragma unroll
        for (int o = 0; o < 36; ++o) { float p = 0.f;
#pragma unroll
            for (int j = 0; j < 4; ++j) { const f32x4 w = *(const LAS f32x4*)(WT + o * D + 256 * j + 4 * lane); p += (h[j].x * w.x + h[j].y * w.y) + (h[j].z * w.z + h[j].w * w.w); }
            lg[o] = wave_sum(p);
            if ((o & 3) == 3) asm volatile("" ::: "memory"); }
        float gl[4];
#pragma unroll
        for (int o = 0; o < 4; ++o) gl[o] = lg[o] + a.in[18][o];
        int gi = 0; float gm = gl[0];
#pragma unroll
        for (int o = 1; o < 4; ++o) if (gl[o] > gm) { gm = gl[o]; gi = o; }
        float den = 0.f;
#pragma unroll
        for (int o = 0; o < 4; ++o) den += __expf(gl[o] - gm);
        const float ggate = 1.0f / den;
        float el[8];
#pragma unroll
        for (int j = 0; j < 8; ++j) { float v = lg[4 + j];
#pragma unroll
            for (int gg = 1; gg < 4; ++gg) v = (gi == gg) ? lg[4 + gg * 8 + j] : v;
            el[j] = v + a.in[20][gi * 8 + j]; }
        int i1 = 0; float v1 = el[0];
#pragma unroll
        for (int j = 1; j < 8; ++j) if (el[j] > v1) { v1 = el[j]; i1 = j; }
        int i2 = -1; float v2 = -INFINITY;
#pragma unroll
        for (int j = 0; j < 8; ++j) if (j != i1 && el[j] > v2) { v2 = el[j]; i2 = j; }
        const float e2 = __expf(v2 - v1), w1 = ggate / (1.0f + e2), w2 = ggate * e2 / (1.0f + e2);
        if (lane == 0) {
            const int e1 = gi * 8 + i1, e2i = gi * 8 + i2;
            const int r1 = (int)atomicAdd((unsigned*)(a.ws + WS_CTL) + CW_CNT + 64 * e1, 1u), r2 = (int)atomicAdd((unsigned*)(a.ws + WS_CTL) + CW_CNT + 64 * e2i, 1u);
            TOKE[2 * m] = e1; TOKE[2 * m + 1] = e2i; TOKR[2 * m] = r1; TOKR[2 * m + 1] = r2; TOKW[2 * m] = w1; TOKW[2 * m + 1] = w2;
        }
    }
    __syncthreads();
}
__device__ __forceinline__ int moe_tables(Frame& F, const Args& a, LAS int* off, LAS int* tile_e) {
    if (F.tid == 0) { int acc = 0;
        for (int e = 0; e < NE; ++e) { off[e] = acc; const int cnt = (int)__hip_atomic_load((unsigned*)(a.ws + WS_CTL) + CW_CNT + 64 * e, RLX_AGENT); const int nt = (cnt + 255) >> 8;
            for (int t = 0; t < nt; ++t) tile_e[(acc >> 8) + t] = e; acc += nt * 256; }
        off[NE] = acc; }
    __syncthreads();
    return off[NE] >> 8;
}
__device__ __forceinline__ void p11_scatter(Frame& F, const Args& a) {
    LAS int* off = (LAS int*)(F.lds + LDSX_OFF); LAS int* tile_e = off + 64;
    (void)moe_tables(F, a, off, tile_e);
    const int gw = F.vcu * NWAVES + F.wave, NGW = F.G * NWAVES, lane = F.lane;
    const bf16* H2 = (const bf16*)(a.ws + WS_H); bf16* XP = (bf16*)(a.ws + WS_XP);
    const int* TOKE = (const int*)(a.ws + WS_TOKE); const int* TOKR = (const int*)(a.ws + WS_TOKR); int* TOKS = (int*)(a.ws + WS_TOKS);
    for (int m = gw; m < T; m += NGW) {
        const v4u r0 = ((const GAS v4u*)(H2 + (size_t)m * D))[lane], r1 = ((const GAS v4u*)(H2 + (size_t)m * D))[64 + lane];
#pragma unroll
        for (int k = 0; k < 2; ++k) { const int e = TOKE[2 * m + k], slot = off[e] + TOKR[2 * m + k];
            GAS v4u* d = (GAS v4u*)(XP + (size_t)slot * D); d[lane] = r0; d[64 + lane] = r1;
            if (lane == 0) TOKS[2 * m + k] = slot; }
    }
    __syncthreads();
}
__device__ __forceinline__ void p14_final(Frame& F, const Args& a) {
    const int gw = F.vcu * NWAVES + F.wave, NGW = F.G * NWAVES, lane = F.lane;
    const float* MOD = (const float*)(a.ws + WS_MOD); const bf16* Y = (const bf16*)(a.ws + WS_Y);
    const int* TOKS = (const int*)(a.ws + WS_TOKS); const float* TOKW = (const float*)(a.ws + WS_TOKW);
    for (int m = gw; m < T; m += NGW) { const int b = m >> 11;
        const int s0 = TOKS[2 * m], s1 = TOKS[2 * m + 1]; const float w0 = TOKW[2 * m], w1 = TOKW[2 * m + 1];
        GAS f32x4* xr = (GAS f32x4*)(a.out + (size_t)m * D) + lane; f32x4 v[4]; float ss = 0.f;
#pragma unroll
        for (int j = 0; j < 4; ++j) {
            const v2u ya = ((const GAS v2u*)(Y + (size_t)s0 * D) + lane)[64 * j], yb = ((const GAS v2u*)(Y + (size_t)s1 * D) + lane)[64 * j];
            const f32x4 y0 = (f32x4){bf_lo(ya.x), bf_hi(ya.x), bf_lo(ya.y), bf_hi(ya.y)}, y1 = (f32x4){bf_lo(yb.x), bf_hi(yb.x), bf_lo(yb.y), bf_hi(yb.y)};
            const f32x4 g2 = ((const GAS f32x4*)(MOD + b * 6144 + 5120) + lane)[64 * j];
            v[j] = xr[64 * j] + (g2 + 1.0f) * (y0 * w0 + y1 * w1);
            ss += (v[j].x * v[j].x + v[j].y * v[j].y) + (v[j].z * v[j].z + v[j].w * v[j].w); }
        const float rstd = 1.0f / sqrtf(wave_sum(ss) * (1.0f / D) + EPS);
#pragma unroll
        for (int j = 0; j < 4; ++j) xr[64 * j] = v[j] * rstd * ((const GAS f32x4*)a.in[24] + lane)[64 * j];
    }
}

template <class Epi, class Sched> __device__ __forceinline__ void run_gemm(Frame& F, const pg8::Gemm& g, const Sched& S, const Epi& E) {
#if MK_SIMPLE_GEMM
    pg8::gemm_phase_simple<Epi, Sched>(g, S, E);
#else
    pg8::gemm_phase<Epi, Sched, true>(F.lds, g, S, E);
#endif
}

constexpr int NPHASES = 15;
__global__ void __launch_bounds__(NTHREADS, 2) mk_fwd(Args args) {
    extern __shared__ __attribute__((aligned(16))) unsigned char lds_raw[];
    Frame F;
    F.lds = (LAS unsigned char*)lds_raw; F.MISC = (volatile LAS unsigned*)(F.lds + MISC_OFF);
    F.tid = threadIdx.x; F.lane = F.tid & 63; F.wave = __builtin_amdgcn_readfirstlane(F.tid >> 6);
    F.G = gridDim.x; { const int bx = blockIdx.x; F.vcu = (F.G % 8 == 0) ? (bx % 8) * (F.G / 8) + bx / 8 : bx; }
    unsigned char* ws = args.ws; F.ctl = (gu32*)(ws + WS_CTL);
    if (F.tid < 64) F.MISC[F.tid] = 0u;
    __syncthreads();
    XcdBarrier bar; bar.bar = (unsigned*)(ws + WS_CTL) + CW_BAR; bar.x = 0; bar.st = nullptr;
    if (MK_N_LAUNCHES == 1) bar = xcd_barrier_post((unsigned*)(ws + WS_CTL) + CW_BAR, F.MISC + 8);
    const int lo = args.ph_lo, hi = args.ph_hi;
#ifndef PH_MASK
#define PH_MASK 0x7fff
#endif
#define IN(k) (((PH_MASK >> (k)) & 1) && lo <= (k) && (k) < hi)
#define SEAM(k) do { if (IN(k) && IN((k) + 1)) xcd_barrier(bar); } while (0)
    const bf16* H = (const bf16*)(ws + WS_H);
    const bf16* WIN_T = (const bf16*)(ws + WS_WIN_T);

    if (IN(0)) { p0_prologue(F, args); SEAM(0); }
    if (IN(1)) { p1_norm1(F, args); SEAM(1); }
    if (IN(2)) {
        pg8::Gemm g{H, WIN_T, T, 3 * AW, D, 0}; pg8::StaticOrder So; So.init(T, 3 * AW, F.G, (int)blockIdx.x);
        EpiQKV E{(bf16*)(ws + WS_QKV)}; run_gemm(F, g, So, E); SEAM(2); }
    if (IN(3)) { p3_attention_simple(F, args); SEAM(3); }
    if (IN(4)) {
        pg8::Gemm g{H, WIN_T + (size_t)(3 * AW) * D, T, 2 * D, D, 0}; pg8::StaticOrder So; So.init(T, 2 * D, F.G, (int)blockIdx.x);
        EpiXY E{(bf16*)(ws + WS_XR), (bf16*)(ws + WS_YR)}; run_gemm(F, g, So, E); SEAM(4); }
    if (IN(5)) { p5_lru_simple(F, args); SEAM(5); }
    if (IN(6)) {
        pg8::Gemm g{H, WIN_T + (size_t)(3 * AW + 2 * D) * D, T, 2 * D, D, 0}; pg8::StaticOrder So; So.init(T, 2 * D, F.G, (int)blockIdx.x);
        EpiGate E{(bf16*)(ws + WS_GA), (bf16*)(ws + WS_GL)}; run_gemm(F, g, So, E); SEAM(6); }
    if (IN(7)) {
        pg8::Gemm g{(const bf16*)args.out, (const bf16*)(ws + WS_WAO_T), T, D, AOW, 0}; pg8::StaticOrder So; So.init(T, D, F.G, (int)blockIdx.x);
        EpiP4a E{(bf16*)(ws + WS_GA)}; run_gemm(F, g, So, E); SEAM(7); }
    if (IN(8)) {
        pg8::Gemm g{(const bf16*)(ws + WS_LRU), (const bf16*)(ws + WS_WLO_T), T, D, D, 0}; pg8::StaticOrder So; So.init(T, D, F.G, (int)blockIdx.x);
        EpiP4b E{(const bf16*)(ws + WS_GA), (bf16*)(ws + WS_GL)}; run_gemm(F, g, So, E); SEAM(8); }
    if (IN(9)) {
        pg8::Gemm g{(const bf16*)(ws + WS_GL), (const bf16*)(ws + WS_WOUT_T), T, D, D, 0}; pg8::StaticOrder So; So.init(T, D, F.G, (int)blockIdx.x);
        EpiP5 E{args.in[0], (const float*)(ws + WS_MOD), args.out}; run_gemm(F, g, So, E); SEAM(9); }
    if (IN(10)) { p10_router(F, args); SEAM(10); }
    if (IN(11)) { p11_scatter(F, args); SEAM(11); }
    if (IN(12)) {
        LAS int* off = (LAS int*)(F.lds + LDSX_OFF); LAS int* tile_e = off + 64;
        const int ntiles = moe_tables(F, args, off, tile_e);
        pg8::Gemm g{(const bf16*)(ws + WS_XP), (const bf16*)(ws + WS_W13_T), ntiles * 256, D, D, (size_t)D * D * 2}; pg8::MoeOrder So{ntiles, F.G, F.vcu, tile_e};
        EpiMoeA E{(bf16*)(ws + WS_HB)}; run_gemm(F, g, So, E); SEAM(12); }
    if (IN(13)) {
        LAS int* off = (LAS int*)(F.lds + LDSX_OFF); LAS int* tile_e = off + 64;
        const int ntiles = moe_tables(F, args, off, tile_e);
        pg8::Gemm g{(const bf16*)(ws + WS_HB), (const bf16*)(ws + WS_W2_T), ntiles * 256, D, DE, (size_t)D * DE * 2}; pg8::MoeOrder So{ntiles, F.G, F.vcu, tile_e};
        EpiMoeB E{(bf16*)(ws + WS_Y)}; run_gemm(F, g, So, E); SEAM(13); }
    if (IN(14)) { p14_final(F, args); }
#undef IN
#undef SEAM
}

extern "C" void kernel_launch(void* const* d_in, const int* in_sizes, int n_in, void* d_out, int out_size, void* d_ws, size_t ws_size, hipStream_t stream) {
    static int grid = 0;
    if (grid == 0) {
        if (n_in != 25 || out_size != T * D || ws_size < WS_END) { fprintf(stderr, "kernel_launch: unexpected shapes: n_in %d out %d ws %zu (need %zu)\n", n_in, out_size, ws_size, (size_t)WS_END); grid = -1; return; }
        int dev = 0, cus = 0, per_cu = 0;
        if (hipGetDevice(&dev) != hipSuccess || hipDeviceGetAttribute(&cus, hipDeviceAttributeMultiprocessorCount, dev) != hipSuccess) { grid = -1; return; }
        if (hipFuncSetAttribute((const void*)mk_fwd, hipFuncAttributeMaxDynamicSharedMemorySize, LDS_BYTES) != hipSuccess) { fprintf(stderr, "kernel_launch: hipFuncSetAttribute failed\n"); grid = -1; return; }
        if (hipOccupancyMaxActiveBlocksPerMultiprocessor(&per_cu, (const void*)mk_fwd, NTHREADS, LDS_BYTES) != hipSuccess || per_cu < 1) { fprintf(stderr, "kernel_launch: occupancy query says %d\n", per_cu); }
        (void)hipGetLastError();
        grid = cus;
    }
    if (grid < 0) return;
    if (hipMemsetAsync((char*)d_ws + WS_CTL, 0, CTL_ZERO_BYTES, stream) != hipSuccess) return;
    Args a{};
    for (int i = 0; i < 25; ++i) a.in[i] = (const float*)d_in[i];
    a.out = (float*)d_out; a.ws = (unsigned char*)d_ws;
    if (MK_N_LAUNCHES == 1) { a.ph_lo = 0; a.ph_hi = NPHASES; hipLaunchKernelGGL(mk_fwd, dim3(grid), dim3(NTHREADS), LDS_BYTES, stream, a); }
    else for (int p = 0; p < NPHASES; ++p) { a.ph_lo = p; a.ph_hi = p + 1; hipLaunchKernelGGL(mk_fwd, dim3(grid), dim3(NTHREADS), LDS_BYTES, stream, a); }
}
```

```cpp
#include <hip/hip_runtime.h>
#include <cstdio>
#include <cstdint>

#ifndef MK_N_LAUNCHES
#define MK_N_LAUNCHES 1
#endif
#ifndef MK_SIMPLE_GEMM
#define MK_SIMPLE_GEMM 0
#endif

#define GAS __attribute__((address_space(1)))
#define LAS __attribute__((address_space(3)))
typedef unsigned short bf16;
typedef unsigned v4u __attribute__((ext_vector_type(4)));
typedef unsigned v2u __attribute__((ext_vector_type(2)));
typedef float f32x4 __attribute__((ext_vector_type(4)));
typedef float f32x2 __attribute__((ext_vector_type(2)));
typedef short bf16x8 __attribute__((ext_vector_type(8)));
typedef GAS unsigned gu32;

constexpr int NB = 16, S = 2048, D = 1024, T = NB * S;
constexpr int HD = 64, NSLOT = 8, NHEAD = 24, AW = 1536, AOW = 512;
constexpr int IN_COLS = 8704, NE = 32, DE = 512, MAX_TILES = 288;
constexpr float EPS = 1e-6f, QSCALE = 0.125f * 1.4426950408889634f;
constexpr int NWAVES = 8, NTHREADS = 512;

constexpr size_t MiB = 1u << 20, KiB = 1u << 10;
constexpr size_t WS_CTL = 0, CTL_ZERO_BYTES = 1 * MiB;
constexpr size_t WS_MOD = 128 * KiB;
constexpr size_t WS_TOKE = 1 * MiB, WS_TOKR = WS_TOKE + 256 * KiB, WS_TOKW = WS_TOKR + 256 * KiB, WS_TOKS = WS_TOKW + 256 * KiB;
constexpr size_t WS_WIN_T = 2 * MiB;
constexpr size_t WS_WAO_T = 19 * MiB, WS_WLO_T = 20 * MiB, WS_WOUT_T = 22 * MiB;
constexpr size_t WS_LSE = 26 * MiB;
constexpr size_t WS_W13_T = 32 * MiB;
constexpr size_t WS_W2_T = 96 * MiB;
constexpr size_t WS_H = 128 * MiB;
constexpr size_t WS_R = 192 * MiB;
constexpr size_t WS_QKV = WS_R;
constexpr size_t WS_XR = WS_R, WS_YR = WS_R + 64 * MiB, WS_LRU = WS_R + 128 * MiB, WS_GA = WS_R + 192 * MiB, WS_GL = WS_R + 256 * MiB;
constexpr size_t WS_XP = WS_R, WS_HB = WS_R + 144 * MiB, WS_Y = WS_R;
constexpr size_t WS_END = 512 * MiB;
constexpr int CW_TMO = 0, CW_CNT = 1024, CW_BAR = 4096;

constexpr int RING_BYTES = 131072;
constexpr int LDSX_OFF = RING_BYTES;
constexpr int LDS_BYTES = 155648;
constexpr int MISC_OFF = LDS_BYTES - 256;

#define LDS_WAIT() asm volatile("s_waitcnt lgkmcnt(0)" ::: "memory")
#define VM_WAIT() asm volatile("s_waitcnt vmcnt(0)" ::: "memory")
#define RLX_AGENT __ATOMIC_RELAXED, __HIP_MEMORY_SCOPE_AGENT

__device__ __forceinline__ unsigned f2bf(float f) { unsigned u = __builtin_bit_cast(unsigned, f); return (u + 0x7fffu + ((u >> 16) & 1u)) >> 16; }
__device__ __forceinline__ unsigned pk2(float lo, float hi) { return f2bf(lo) | (f2bf(hi) << 16); }
__device__ __forceinline__ float bf_lo(unsigned u) { return __builtin_bit_cast(float, u << 16); }
__device__ __forceinline__ float bf_hi(unsigned u) { return __builtin_bit_cast(float, u & 0xffff0000u); }
__device__ __forceinline__ float bf2f(bf16 b) { return __builtin_bit_cast(float, ((unsigned)b) << 16); }
__device__ __forceinline__ float fast_rcp(float x) { return __builtin_amdgcn_rcpf(x); }
__device__ __forceinline__ float sigmoid_f(float x) { return fast_rcp(1.0f + __expf(-x)); }
__device__ __forceinline__ float gelu_tanh_f(float v) { const float u = 0.7978845608028654f * (v + 0.044715f * v * v * v); return v * fast_rcp(1.0f + __expf(-2.0f * u)); }
__device__ __forceinline__ float wave_sum(float v) {
#pragma unroll
    for (int o = 1; o < 64; o <<= 1) v += __shfl_xor(v, o);
    return v;
}

namespace pg8 {
#define PG8_LAS __attribute__((address_space(3)))
typedef unsigned short bf16_t;
constexpr int BM = 256, BK = 64, HALF = 128, HTB = HALF * BK * 2, STAGE_BYTES = 8 * HTB, NXCD = 8, WGM = 8;

__host__ __device__ __forceinline__ int lds_byte(int r, int c) { const int st = (r >> 4) * 2 + (c >> 5), rr = r & 15, cc = c & 31, ob = rr * 64 + cc * 2; return st * 1024 + (ob ^ (((ob >> 9) & 1) << 5)); }
__host__ __device__ __forceinline__ void stage_rc(int b, int& R, int& C) { const int st = b / 1024, sb = b % 1024, swz = sb ^ (((sb >> 9) & 1) << 5); R = (st >> 1) * 16 + swz / 64; C = (st & 1) * 32 + (swz % 64) / 2; }
__host__ __device__ __forceinline__ int perm32(int rho) { const int n = rho >> 4, i = rho & 15; return 8 * (i >> 2) + 4 * n + (i & 3); }

struct Unit { int pm, pn, e; };
struct Gemm { const bf16_t* A; const bf16_t* Bt; int M, N, K; size_t estride; };

struct StaticOrder {
    int nM, nN, nwg, G, c;
    __host__ __device__ void init(int M, int N, int G_, int c_) { nM = M / BM; nN = N / BM; nwg = nM * nN; G = G_; c = c_; }
    __host__ __device__ bool next(int i, Unit& u) const {
        const long L = (long)i * G + c; if (L >= nwg) return false;
        int wgid = (int)L; { const int q = nwg / NXCD, r = nwg % NXCD, xcd = wgid % NXCD, off = wgid / NXCD; wgid = (xcd < r ? xcd * (q + 1) : r * (q + 1) + (xcd - r) * q) + off; }
        const int nig = WGM * nN, gid = wgid / nig, fm = gid * WGM, gsz = (nM - fm) < WGM ? (nM - fm) : WGM;
        u.pm = fm + ((wgid % nig) % gsz); u.pn = (wgid % nig) / gsz; u.e = 0; return true;
    }
};
struct MoeOrder {
    int ntiles, G, vcu; const PG8_LAS int* tile_e;
    __device__ bool next(int i, Unit& u) const {
        const int L = i * G + vcu; if (L >= ntiles * 4) return false;
        u.pm = L >> 2; u.pn = L & 3; u.e = __builtin_amdgcn_readfirstlane(tile_e[u.pm]); return true;
    }
};

template <class Epi> __device__ __forceinline__ void run_epi(const Epi& E, const f32x4 (&acc)[2][2][4][2], const Unit& u, int wr, int wc, int fr, int fq) {
    const int row0 = u.pm * BM + wr * 64 + fr, col0 = u.pn * BM + wc * 32 + 8 * fq;
#pragma unroll
    for (int ai = 0; ai < 2; ++ai)
#pragma unroll
        for (int m = 0; m < 4; ++m)
#pragma unroll
            for (int bj = 0; bj < 2; ++bj) E.store8(row0 + ai * HALF + m * 16, col0 + bj * HALF, acc[ai][bj][m][0], acc[ai][bj][m][1]);
}

template <class Epi, class Sched, bool ALIGN_EPI = true>
__device__ __forceinline__ void gemm_phase(PG8_LAS unsigned char* lds, const Gemm g, const Sched& S, const Epi& E) {
    int tid = threadIdx.x; asm volatile("" : "+v"(tid));
    const int wid = __builtin_amdgcn_readfirstlane(tid >> 6), lane = tid & 63, wr = wid >> 2, wc = wid & 3, fr = lane & 15, fq = lane >> 4;
    const int K = g.K, nt = K / BK;
    unsigned voffA[2], voffB[2];
#pragma unroll
    for (int i = 0; i < 2; ++i) { int R, C; stage_rc(tid * 16 + i * 8192, R, C); const int Rb = (R & ~31) + perm32(R & 31);
        voffA[i] = (unsigned)(R * K + C) * 2u; voffB[i] = (unsigned)(Rb * K + C) * 2u; }
    const size_t kstep = (size_t)(BK * 2);
    const size_t hstep = (size_t)HALF * K * 2;
    const size_t tstep = 2 * hstep;
    const unsigned ldsw = (unsigned)wid * 1024u;
    const int aoff = lds_byte(wr * 64 + fr, fq * 8), boff = lds_byte(wc * 32 + fr, fq * 8);
#define PG8_SA(b, h) (((b) * 2 + (h)) * HTB)
#define PG8_SB(b, h) ((4 + (b) * 2 + (h)) * HTB)
#define PG8_STAGE(bufoff, gbase, voff) do { _Pragma("unroll") for (int _i = 0; _i < 2; ++_i) \
        __builtin_amdgcn_global_load_lds((const unsigned*)((const char*)(gbase) + (voff)[_i]), (PG8_LAS unsigned*)(lds + (bufoff) + ldsw + _i * 8192), 16, 0, 0); } while (0)
#define PG8_LDA(dst, b, h) do { _Pragma("unroll") for (int m = 0; m < 4; ++m) _Pragma("unroll") for (int k = 0; k < 2; ++k) dst[m][k] = *(const PG8_LAS bf16x8*)(lds + PG8_SA(b, h) + aoff + m * 2048 + k * 1024); } while (0)
#define PG8_LDB(dst, b, h) do { _Pragma("unroll") for (int n = 0; n < 2; ++n) _Pragma("unroll") for (int k = 0; k < 2; ++k) dst[n][k] = *(const PG8_LAS bf16x8*)(lds + PG8_SB(b, h) + boff + n * 2048 + k * 1024); } while (0)
#define PG8_MMA(ai, bj, At, Bt) do { __builtin_amdgcn_s_setprio(1); _Pragma("unroll") for (int m = 0; m < 4; ++m) _Pragma("unroll") for (int n = 0; n < 2; ++n) _Pragma("unroll") for (int k = 0; k < 2; ++k) \
        acc[ai][bj][m][n] = __builtin_amdgcn_mfma_f32_16x16x32_bf16(Bt[n][k], At[m][k], acc[ai][bj][m][n], 0, 0, 0); __builtin_amdgcn_s_setprio(0); } while (0)
#define PG8_WAIT_V(n) asm volatile("s_waitcnt vmcnt(" #n ")" ::: "memory")
#define PG8_WAIT_L(n) asm volatile("s_waitcnt lgkmcnt(" #n ")" ::: "memory")
#define PG8_BAR __builtin_amdgcn_s_barrier()
#define PG8_SCHED __builtin_amdgcn_sched_barrier(0)
    Unit cur, nxt; int ui = 0;
    if (!S.next(0, cur)) return;
    f32x4 acc[2][2][4][2];
#pragma unroll
    for (int a = 0; a < 2; ++a)
#pragma unroll
        for (int b = 0; b < 2; ++b)
#pragma unroll
            for (int m = 0; m < 4; ++m)
#pragma unroll
                for (int n = 0; n < 2; ++n) acc[a][b][m][n] = (f32x4){0.f, 0.f, 0.f, 0.f};
    bf16x8 At[4][2], B0[2][2], B1[2][2];
    const char* cA = (const char*)g.A + (size_t)cur.pm * tstep; const char* cB = (const char*)g.Bt + (size_t)cur.e * g.estride + (size_t)cur.pn * tstep;
    PG8_STAGE(PG8_SB(0, 0), cB, voffB); PG8_STAGE(PG8_SB(0, 1), cB + hstep, voffB); PG8_STAGE(PG8_SA(0, 0), cA, voffA); PG8_STAGE(PG8_SA(0, 1), cA + hstep, voffA);
    if (wr == 1) PG8_BAR;
    PG8_WAIT_V(2); PG8_BAR;
    PG8_STAGE(PG8_SB(1, 0), cB + kstep, voffB); PG8_STAGE(PG8_SA(1, 0), cA + kstep, voffA); PG8_STAGE(PG8_SB(1, 1), cB + hstep + kstep, voffB);
    PG8_WAIT_V(6); PG8_BAR;
    for (;;) {
        const bool has_next = S.next(ui + 1, nxt);
        const char* nA = has_next ? (const char*)g.A + (size_t)nxt.pm * tstep : cA; const char* nB = has_next ? (const char*)g.Bt + (size_t)nxt.e * g.estride + (size_t)nxt.pn * tstep : cB;
        for (int t = 0; t < nt; t += 2) {
            const bool last = (t == nt - 2);
            const char* a1 = cA + (size_t)(t + 1) * kstep;
            const char* a2 = last ? nA : cA + (size_t)(t + 2) * kstep; const char* b2 = last ? nB : cB + (size_t)(t + 2) * kstep;
            const char* a3 = a2 + kstep; const char* b3 = b2 + kstep;
            PG8_LDB(B0, 0, 0); PG8_LDB(B1, 0, 1); PG8_SCHED; PG8_LDA(At, 0, 0); PG8_STAGE(PG8_SA(1, 1), a1 + hstep, voffA);
            PG8_WAIT_V(8); PG8_WAIT_L(0); PG8_BAR; PG8_MMA(0, 0, At, B0); PG8_MMA(0, 1, At, B1); PG8_BAR; PG8_SCHED;
            PG8_LDA(At, 0, 1); PG8_STAGE(PG8_SB(0, 0), b2, voffB); PG8_STAGE(PG8_SB(0, 1), b2 + hstep, voffB); PG8_STAGE(PG8_SA(0, 0), a2, voffA);
            PG8_WAIT_V(8); PG8_WAIT_L(0); PG8_BAR; PG8_MMA(1, 0, At, B0); PG8_MMA(1, 1, At, B1); PG8_BAR; PG8_SCHED;
            PG8_LDB(B0, 1, 0); PG8_LDB(B1, 1, 1); PG8_SCHED; PG8_LDA(At, 1, 0); PG8_STAGE(PG8_SA(0, 1), a2 + hstep, voffA);
            PG8_WAIT_V(8); PG8_WAIT_L(0); PG8_BAR; PG8_MMA(0, 0, At, B0); PG8_MMA(0, 1, At, B1); PG8_BAR; PG8_SCHED;
            PG8_LDA(At, 1, 1); PG8_STAGE(PG8_SB(1, 0), b3, voffB); PG8_STAGE(PG8_SB(1, 1), b3 + hstep, voffB); PG8_STAGE(PG8_SA(1, 0), a3, voffA);
            PG8_WAIT_V(8); PG8_WAIT_L(0); PG8_BAR; PG8_MMA(1, 0, At, B0); PG8_MMA(1, 1, At, B1); PG8_BAR; PG8_SCHED;
        }
        if constexpr (ALIGN_EPI) { if (wr == 0) PG8_BAR; }
        run_epi(E, acc, cur, wr, wc, fr, fq);
        if (!has_next) break;
#pragma unroll
        for (int a = 0; a < 2; ++a)
#pragma unroll
            for (int b = 0; b < 2; ++b)
#pragma unroll
                for (int m = 0; m < 4; ++m)
#pragma unroll
                    for (int n = 0; n < 2; ++n) acc[a][b][m][n] = (f32x4){0.f, 0.f, 0.f, 0.f};
        cur = nxt; cA = nA; cB = nB; ++ui;
        if constexpr (ALIGN_EPI) { if (wr == 1) PG8_BAR; }
    }
    PG8_WAIT_V(0);
    if constexpr (!ALIGN_EPI) { if (wr == 0) PG8_BAR; }
    PG8_BAR;
#undef PG8_SA
#undef PG8_SB
#undef PG8_STAGE
#undef PG8_LDA
#undef PG8_LDB
#undef PG8_MMA
#undef PG8_WAIT_V
#undef PG8_WAIT_L
#undef PG8_BAR
#undef PG8_SCHED
}

template <class Epi, class Sched>
__device__ __forceinline__ void gemm_phase_simple(const Gemm g, const Sched& S, const Epi& E) {
    const int tid = threadIdx.x, wid = tid >> 6, lane = tid & 63, wr = wid >> 2, wc = wid & 3, fr = lane & 15, fq = lane >> 4;
    const int K = g.K;
    Unit cur;
    for (int ui = 0; S.next(ui, cur); ++ui) {
        f32x4 acc[2][2][4][2];
#pragma unroll
        for (int a = 0; a < 2; ++a)
#pragma unroll
            for (int b = 0; b < 2; ++b)
#pragma unroll
                for (int m = 0; m < 4; ++m)
#pragma unroll
                    for (int n = 0; n < 2; ++n) acc[a][b][m][n] = (f32x4){0.f, 0.f, 0.f, 0.f};
        const bf16_t* Ab = g.A + (size_t)(cur.pm * BM + wr * 64 + fr) * K;
        const bf16_t* Bb = (const bf16_t*)((const char*)g.Bt + (size_t)cur.e * g.estride) + (size_t)(cur.pn * BM + wc * 32 + 8 * fq) * K;
        for (int k0 = 0; k0 < K; k0 += 2) {
            float av[2][4][2], bv[2][8][2];
#pragma unroll
            for (int ai = 0; ai < 2; ++ai)
#pragma unroll
                for (int m = 0; m < 4; ++m) { const unsigned u = *(const unsigned*)(Ab + (size_t)(ai * HALF + m * 16) * K + k0); av[ai][m][0] = bf_lo(u); av[ai][m][1] = bf_hi(u); }
#pragma unroll
            for (int bj = 0; bj < 2; ++bj)
#pragma unroll
                for (int j = 0; j < 8; ++j) { const unsigned u = *(const unsigned*)(Bb + (size_t)(bj * HALF + j) * K + k0); bv[bj][j][0] = bf_lo(u); bv[bj][j][1] = bf_hi(u); }
#pragma unroll
            for (int ai = 0; ai < 2; ++ai)
#pragma unroll
                for (int bj = 0; bj < 2; ++bj)
#pragma unroll
                    for (int m = 0; m < 4; ++m)
#pragma unroll
                        for (int n = 0; n < 2; ++n)
#pragma unroll
                            for (int j = 0; j < 4; ++j) acc[ai][bj][m][n][j] += av[ai][m][0] * bv[bj][n * 4 + j][0] + av[ai][m][1] * bv[bj][n * 4 + j][1];
        }
        run_epi(E, acc, cur, wr, wc, fr, fq);
    }
}
}

__device__ __forceinline__ v4u pack8(const f32x4 a, const f32x4 b) { v4u w; w.x = pk2(a[0], a[1]); w.y = pk2(a[2], a[3]); w.z = pk2(b[0], b[1]); w.w = pk2(b[2], b[3]); return w; }
__device__ __forceinline__ void unpack8(const v4u w, f32x4& a, f32x4& b) { a = (f32x4){bf_lo(w.x), bf_hi(w.x), bf_lo(w.y), bf_hi(w.y)}; b = (f32x4){bf_lo(w.z), bf_hi(w.z), bf_lo(w.w), bf_hi(w.w)}; }

struct EpiQKV { bf16* QKV;
    __device__ __forceinline__ void store8(int row, int col, f32x4 v0, f32x4 v1) const {
        const int which = col / AW, rem = col - which * AW, hh = rem >> 6, dim0 = rem & 63, sh = 2 * (hh >> 3);
        const int b = row >> 11, s = row & 2047, pos = ((s & ((1 << sh) - 1)) << (11 - sh)) | (s >> sh);
        if (which == 0) { v0 = v0 * QSCALE; v1 = v1 * QSCALE; }
        *(GAS v4u*)(QKV + ((((size_t)(which * NB + b) * NHEAD + hh) * S + pos) * HD + dim0)) = pack8(v0, v1);
    } };
struct EpiXY { bf16* XR; bf16* YR;
    __device__ __forceinline__ void store8(int row, int col, f32x4 v0, f32x4 v1) const {
        if (col < D) { *(GAS v4u*)(XR + (size_t)row * D + col) = pack8(v0, v1); }
        else {
#pragma unroll
            for (int j = 0; j < 4; ++j) { v0[j] = gelu_tanh_f(v0[j]); v1[j] = gelu_tanh_f(v1[j]); }
            *(GAS v4u*)(YR + (size_t)row * D + (col - D)) = pack8(v0, v1); }
    } };
struct EpiGate { bf16* GA; bf16* GL;
    __device__ __forceinline__ void store8(int row, int col, f32x4 v0, f32x4 v1) const {
#pragma unroll
        for (int j = 0; j < 4; ++j) { v0[j] = sigmoid_f(v0[j]); v1[j] = sigmoid_f(v1[j]); }
        bf16* dst = col < D ? GA + (size_t)row * D + col : GL + (size_t)row * D + (col - D);
        *(GAS v4u*)dst = pack8(v0, v1);
    } };
struct EpiP4a { bf16* GA;
    __device__ __forceinline__ void store8(int row, int col, f32x4 v0, f32x4 v1) const {
        GAS v4u* p = (GAS v4u*)(GA + (size_t)row * D + col); f32x4 g0, g1; unpack8(*p, g0, g1);
        *p = pack8(g0 * v0, g1 * v1);
    } };
struct EpiP4b { const bf16* TMP; bf16* GL;
    __device__ __forceinline__ void store8(int row, int col, f32x4 v0, f32x4 v1) const {
        GAS v4u* p = (GAS v4u*)(GL + (size_t)row * D + col); f32x4 g0, g1, t0, t1; unpack8(*p, g0, g1); unpack8(*(const GAS v4u*)(TMP + (size_t)row * D + col), t0, t1);
        *p = pack8(t0 + g0 * v0, t1 + g1 * v1);
    } };
struct EpiP5 { const float* X; const float* MOD; float* X1;
    __device__ __forceinline__ void store8(int row, int col, f32x4 v0, f32x4 v1) const {
        const int b = row >> 11; const float* gp = MOD + b * 6144 + 2048 + col; const float* xp = X + (size_t)row * D + col;
        const f32x4 g0 = *(const GAS f32x4*)gp, g1 = *(const GAS f32x4*)(gp + 4), x0 = *(const GAS f32x4*)xp, x1 = *(const GAS f32x4*)(xp + 4);
        GAS f32x4* o = (GAS f32x4*)(X1 + (size_t)row * D + col);
        o[0] = x0 + (g0 + 1.0f) * v0; o[1] = x1 + (g1 + 1.0f) * v1;
    } };
struct EpiMoeA { bf16* HB;
    __device__ __forceinline__ void store8(int row, int col, f32x4 v0, f32x4 v1) const {
        f32x4 r;
#pragma unroll
        for (int j = 0; j < 4; ++j) r[j] = v0[j] * sigmoid_f(v0[j]) * v1[j];
        v2u w; w.x = pk2(r[0], r[1]); w.y = pk2(r[2], r[3]);
        *(GAS v2u*)(HB + (size_t)row * DE + (col >> 1)) = w;
    } };
struct EpiMoeB { bf16* Y;
    __device__ __forceinline__ void store8(int row, int col, f32x4 v0, f32x4 v1) const { *(GAS v4u*)(Y + (size_t)row * D + col) = pack8(v0, v1); } };

#define XB_TMO      128
#define XB_XCNT(j)  (256  + 64 * (j))
#define XB_XSUB(j)  (1280 + 64 * (j))
#define XB_XGEN(j)  (2304 + 64 * (j))
#define XB_TOP      3328
#define XB_TOPGEN   3392
#define XCD_BAR_WORDS 3456
#define XB_SPIN_CAP (1u << 20)
__device__ __forceinline__ unsigned xb_ld(unsigned* p)              { return __hip_atomic_load(p, __ATOMIC_RELAXED, __HIP_MEMORY_SCOPE_AGENT); }
__device__ __forceinline__ unsigned xb_add(unsigned* p, unsigned v) { return __hip_atomic_fetch_add(p, v, __ATOMIC_RELAXED, __HIP_MEMORY_SCOPE_AGENT); }
__device__ __forceinline__ unsigned xb_xcc_id() { return (unsigned)__builtin_amdgcn_s_getreg((3 << 11) | 20) & 0xFu; }
#define XB_SPIN(cond, bar) do { unsigned _sp = 0; while (cond) { __builtin_amdgcn_s_sleep(1); \
    if ((++_sp & 255u) == 0u) { if (xb_ld(&(bar)[XB_TMO])) break; if (_sp > XB_SPIN_CAP) { atomicAdd(&(bar)[XB_TMO], 1u); break; } } } } while (0)
struct XcdBarrier { unsigned* bar; unsigned x; volatile LAS unsigned* st; };
__device__ __forceinline__ XcdBarrier xcd_barrier_post(unsigned* bar, volatile LAS unsigned* st) {
    XcdBarrier b; b.bar = bar; b.x = xb_xcc_id(); b.st = st;
    if (threadIdx.x == 0) (void)xb_add(&bar[XB_XCNT(b.x)], 1u);
    return b;
}
__device__ __forceinline__ void xcd_barrier_complete(unsigned* bar, unsigned x, unsigned& nloc, unsigned& nx) {
    const unsigned G = gridDim.x * gridDim.y * gridDim.z;
    unsigned sum, cnt, mine, sp = 0u;
    for (;;) {
        sum = 0u; cnt = 0u; mine = 0u;
#pragma unroll
        for (unsigned j = 0; j < 16; ++j) { const unsigned c = xb_ld(&bar[XB_XCNT(j)]); sum += c; cnt += (c > 0u) ? 1u : 0u; mine = (j == x) ? c : mine; }
        if (sum == G) break;
        __builtin_amdgcn_s_sleep(1);
        if ((++sp & 255u) == 0u) { if (xb_ld(&bar[XB_TMO])) break; if (sp > XB_SPIN_CAP) { atomicAdd(&bar[XB_TMO], 1u); break; } }
    }
    nloc = mine > 0u ? mine : 1u; nx = cnt > 0u ? cnt : 1u;
}
__device__ __forceinline__ void xcd_barrier(const XcdBarrier& b) {
    asm volatile("s_waitcnt vmcnt(0)" ::: "memory");
    __syncthreads();
    if (threadIdx.x == 0) {
        unsigned* bar = b.bar;
        __builtin_amdgcn_s_waitcnt(0);
        unsigned nloc = b.st[0], nx = b.st[1];
        if (nloc == 0u) { xcd_barrier_complete(bar, b.x, nloc, nx); b.st[0] = nloc; b.st[1] = nx; }
        const unsigned old = xb_add(&bar[XB_XSUB(b.x)], 1u);
        const unsigned gen = old / nloc;
        if (old + 1u == (gen + 1u) * nloc) {
            __builtin_amdgcn_fence(__ATOMIC_RELEASE, "agent");
            asm volatile("s_waitcnt vmcnt(0)" ::: "memory");
            const unsigned og = xb_add(&bar[XB_TOP], 1u);
            const unsigned tg = og / nx;
            if (og + 1u == (tg + 1u) * nx) xb_add(&bar[XB_TOPGEN], 1u);
            else XB_SPIN(xb_ld(&bar[XB_TOPGEN]) == tg, bar);
            __builtin_amdgcn_fence(__ATOMIC_ACQUIRE, "agent");
            xb_add(&bar[XB_XGEN(b.x)], 1u);
            asm volatile("s_waitcnt vmcnt(0)" ::: "memory");
        } else {
            XB_SPIN(xb_ld(&bar[XB_XGEN(b.x)]) == gen, bar);
            __builtin_amdgcn_fence(__ATOMIC_ACQUIRE, "agent");
            asm volatile("s_waitcnt vmcnt(0)" ::: "memory");
        }
    }
    __syncthreads();
}

struct Args { const float* in[25]; float* out; unsigned char* ws; int ph_lo, ph_hi; };
struct Frame {
    LAS unsigned char* lds; volatile LAS unsigned* MISC; gu32* ctl;
    int tid, lane, wave, vcu, G;
};

__device__ __forceinline__ void p0_transpose_item(const float* W, int K, int N, bf16* WT, int row_off, int mode, LAS float* scr, int item, int lane) {
    const int nblk = N / 32, kb = item / nblk, nb = item % nblk, k0 = 64 * kb, n0 = 32 * nb;
#pragma unroll 8
    for (int i = 0; i < 32; ++i) { const int kk = 2 * i + (lane >> 5); scr[kk * 33 + (lane & 31)] = W[(size_t)(k0 + kk) * N + n0 + (lane & 31)]; }
    LDS_WAIT(); asm volatile("" ::: "memory");
    const int c = lane & 7;
#pragma unroll
    for (int j = 0; j < 4; ++j) { const int n = (lane >> 3) + 8 * j; const LAS float* s = scr + (8 * c) * 33 + n;
        v4u o; o.x = pk2(s[0 * 33], s[1 * 33]); o.y = pk2(s[2 * 33], s[3 * 33]); o.z = pk2(s[4 * 33], s[5 * 33]); o.w = pk2(s[6 * 33], s[7 * 33]);
        const int nn = n0 + n; const int r = mode == 0 ? row_off + nn : row_off + 8 * (nn >> 2) + (nn & 3) + (mode == 2 ? 4 : 0);
        *(GAS v4u*)(WT + (size_t)r * K + k0 + 8 * c) = o; }
    LDS_WAIT(); asm volatile("" ::: "memory");
}
__device__ __forceinline__ void p0_prologue(Frame& F, const Args& a) {
    unsigned char* ws = a.ws;
    LAS float* scr = (LAS float*)(F.lds + F.wave * 16384);
    const int gw = F.vcu * NWAVES + F.wave, NGW = F.G * NWAVES;
    constexpr int I_IN = (D / 64) * (IN_COLS / 32), I_AO = (AOW / 64) * (D / 32), I_LO = (D / 64) * (D / 32), I_OUT = I_LO, I_E = 256;
    constexpr int NDENSE = I_IN + I_AO + I_LO + I_OUT, NITEMS = NDENSE + 3 * NE * I_E;
    for (int it = gw; it < NITEMS; it += NGW) {
        int r = it;
        if (r < I_IN) { p0_transpose_item(a.in[5], D, IN_COLS, (bf16*)(ws + WS_WIN_T), 0, 0, scr, r, F.lane); continue; } r -= I_IN;
        if (r < I_AO) { p0_transpose_item(a.in[13], AOW, D, (bf16*)(ws + WS_WAO_T), 0, 0, scr, r, F.lane); continue; } r -= I_AO;
        if (r < I_LO) { p0_transpose_item(a.in[14], D, D, (bf16*)(ws + WS_WLO_T), 0, 0, scr, r, F.lane); continue; } r -= I_LO;
        if (r < I_OUT) { p0_transpose_item(a.in[15], D, D, (bf16*)(ws + WS_WOUT_T), 0, 0, scr, r, F.lane); continue; } r -= I_OUT;
        const int mat = r / I_E, item = r % I_E, e = mat / 3, which = mat % 3;
        if (which == 0) p0_transpose_item(a.in[21] + (size_t)e * D * DE, D, DE, (bf16*)(ws + WS_W13_T), e * 1024, 1, scr, item, F.lane);
        else if (which == 1) p0_transpose_item(a.in[22] + (size_t)e * D * DE, D, DE, (bf16*)(ws + WS_W13_T), e * 1024, 2, scr, item, F.lane);
        else p0_transpose_item(a.in[23] + (size_t)e * DE * D, DE, D, (bf16*)(ws + WS_W2_T), e * 1024, 0, scr, item, F.lane);
    }
    if (F.vcu < 192) {
        __syncthreads();
        const float* c = a.in[1]; const float* wm = a.in[2]; const float* bm = a.in[3]; float* MOD = (float*)(ws + WS_MOD);
        LAS float* CA = (LAS float*)F.lds;
        LAS float* PART = (LAS float*)(F.lds + 65536);
        for (int i = F.tid; i < NB * D; i += NTHREADS) { const float v = c[i]; CA[i] = v * sigmoid_f(v); }
        __syncthreads();
        const int kq = F.tid >> 5, col = F.tid & 31, n = F.vcu * 32 + col;
        float acc[NB];
#pragma unroll
        for (int b = 0; b < NB; ++b) acc[b] = 0.f;
#pragma unroll 4
        for (int i = 0; i < 64; ++i) { const int k = kq + 16 * i; const float w = wm[(size_t)k * 6144 + n];
#pragma unroll
            for (int b = 0; b < NB; ++b) acc[b] += CA[b * D + k] * w; }
#pragma unroll
        for (int b = 0; b < NB; ++b) PART[(kq * NB + b) * 32 + col] = acc[b];
        __syncthreads();
        { const int b = F.tid >> 5; float sum = bm[n];
#pragma unroll
            for (int q = 0; q < 16; ++q) sum += PART[(q * NB + b) * 32 + col];
            MOD[b * 6144 + n] = sum; }
        __syncthreads();
    }
}
__device__ __forceinline__ void norm_mod_row(const float* xrow, const float* g, const float* shift, const float* scale, int lane, f32x4 (&h)[4]) {
    const GAS f32x4* xr = (const GAS f32x4*)xrow + lane; float ss = 0.f;
#pragma unroll
    for (int j = 0; j < 4; ++j) { h[j] = xr[64 * j]; ss += (h[j].x * h[j].x + h[j].y * h[j].y) + (h[j].z * h[j].z + h[j].w * h[j].w); }
    const float rstd = 1.0f / sqrtf(wave_sum(ss) * (1.0f / D) + EPS);
#pragma unroll
    for (int j = 0; j < 4; ++j) { const f32x4 gg = ((const GAS f32x4*)g + lane)[64 * j], sc = ((const GAS f32x4*)scale + lane)[64 * j], sf = ((const GAS f32x4*)shift + lane)[64 * j];
        h[j] = h[j] * rstd * gg * (sc + 1.0f) + sf; }
}
__device__ __forceinline__ void store_row_bf16(bf16* orow, int lane, const f32x4 (&h)[4]) {
    GAS v2u* o8 = (GAS v2u*)orow + lane;
#pragma unroll
    for (int j = 0; j < 4; ++j) { v2u w; w.x = pk2(h[j].x, h[j].y); w.y = pk2(h[j].z, h[j].w); o8[64 * j] = w; }
}
__device__ __forceinline__ void p1_norm1(Frame& F, const Args& a) {
    const int gw = F.vcu * NWAVES + F.wave, NGW = F.G * NWAVES;
    const float* MOD = (const float*)(a.ws + WS_MOD); bf16* H = (bf16*)(a.ws + WS_H);
    for (int m = gw; m < T; m += NGW) { const int b = m >> 11; f32x4 h[4];
        norm_mod_row(a.in[0] + (size_t)m * D, a.in[4], MOD + b * 6144, MOD + b * 6144 + 1024, F.lane, h);
        store_row_bf16(H + (size_t)m * D, F.lane, h); }
}
typedef float f32x16 __attribute__((ext_vector_type(16)));
typedef short v4i16_t __attribute__((ext_vector_type(4)));
__device__ __forceinline__ void attn_q32(const bf16* Qs, const bf16* Ks, const bf16* Vs, int i0, LAS unsigned char* vl, int lane, f32x16 (&O)[2], float& lse2) {
    const int r = lane & 31, hi = lane >> 5;
    bf16x8 Qf[4];
#pragma unroll
    for (int kk = 0; kk < 4; ++kk) Qf[kk] = __builtin_bit_cast(bf16x8, *(const GAS v4u*)(Qs + (size_t)(i0 + r) * HD + 16 * kk + 8 * hi));
#pragma unroll
    for (int dt = 0; dt < 2; ++dt)
#pragma unroll
        for (int i = 0; i < 16; ++i) O[dt][i] = 0.f;
    float m = -1e30f, l = 0.f;
    const int ktl = i0 >> 5, kt0 = ktl - 4 < 0 ? 0 : ktl - 4;
    const unsigned trbase = (unsigned)((4 * hi + ((lane & 15) >> 2)) * 64 + (16 * ((lane >> 4) & 1) + 4 * (lane & 3)) * 2);
    for (int kt = kt0; kt <= ktl; ++kt) {
        bf16x8 Kf[4];
#pragma unroll
        for (int kk = 0; kk < 4; ++kk) Kf[kk] = __builtin_bit_cast(bf16x8, *(const GAS v4u*)(Ks + (size_t)(32 * kt + r) * HD + 16 * kk + 8 * hi));
#pragma unroll
        for (int c4 = 0; c4 < 4; ++c4) { const int idx = c4 * 64 + lane, key = idx >> 3, piece = idx & 7;
            const v4u v = *(const GAS v4u*)(Vs + (size_t)(32 * kt + key) * HD + 8 * piece);
            *(LAS v4u*)(vl + (piece >> 2) * 2048 + key * 64 + (piece & 3) * 16) = v; }
        f32x16 sc;
#pragma unroll
        for (int i = 0; i < 16; ++i) sc[i] = 0.f;
#pragma unroll
        for (int kk = 0; kk < 4; ++kk) sc = __builtin_amdgcn_mfma_f32_32x32x16_bf16(Kf[kk], Qf[kk], sc, 0, 0, 0);
        if (kt == ktl) {
#pragma unroll
            for (int i = 0; i < 16; ++i) { const int key = 8 * (i >> 2) + 4 * hi + (i & 3); sc[i] = key > r ? -1e30f : sc[i]; } }
        if (kt == ktl - 4) {
#pragma unroll
            for (int i = 0; i < 16; ++i) { const int key = 8 * (i >> 2) + 4 * hi + (i & 3); sc[i] = key < r ? -1e30f : sc[i]; } }
        float mx = sc[0];
#pragma unroll
        for (int i = 1; i < 16; ++i) mx = fmaxf(mx, sc[i]);
        mx = fmaxf(mx, __shfl_xor(mx, 32));
        const float mn = fmaxf(m, mx), al = __builtin_amdgcn_exp2f(m - mn); m = mn;
        float ps = 0.f;
#pragma unroll
        for (int i = 0; i < 16; ++i) { sc[i] = __builtin_amdgcn_exp2f(sc[i] - mn); ps += sc[i]; }
        l = l * al + ps;
#pragma unroll
        for (int dt = 0; dt < 2; ++dt)
#pragma unroll
            for (int i = 0; i < 16; ++i) O[dt][i] *= al;
        bf16x8 Pf[2];
#pragma unroll
        for (int st = 0; st < 2; ++st) { v4u w; w.x = pk2(sc[8 * st], sc[8 * st + 1]); w.y = pk2(sc[8 * st + 2], sc[8 * st + 3]); w.z = pk2(sc[8 * st + 4], sc[8 * st + 5]); w.w = pk2(sc[8 * st + 6], sc[8 * st + 7]);
            Pf[st] = __builtin_bit_cast(bf16x8, w); }
#pragma unroll
        for (int st = 0; st < 2; ++st)
#pragma unroll
            for (int dt = 0; dt < 2; ++dt) {
                const v4i16_t lo = __builtin_amdgcn_ds_read_tr16_b64_v4i16((LAS v4i16_t*)(vl + dt * 2048 + st * 1024 + trbase));
                const v4i16_t hh = __builtin_amdgcn_ds_read_tr16_b64_v4i16((LAS v4i16_t*)(vl + dt * 2048 + st * 1024 + 512 + trbase));
                bf16x8 Vf; Vf[0] = lo[0]; Vf[1] = lo[1]; Vf[2] = lo[2]; Vf[3] = lo[3]; Vf[4] = hh[0]; Vf[5] = hh[1]; Vf[6] = hh[2]; Vf[7] = hh[3];
                O[dt] = __builtin_amdgcn_mfma_f32_32x32x16_bf16(Vf, Pf[st], O[dt], 0, 0, 0); }
    }
    const float lt = l + __shfl_xor(l, 32), inv = fast_rcp(lt);
    lse2 = m + __builtin_amdgcn_logf(lt);
#pragma unroll
    for (int dt = 0; dt < 2; ++dt)
#pragma unroll
        for (int i = 0; i < 16; ++i) O[dt][i] *= inv;
}
template <bool MERGE, bool LAST>
__device__ __forceinline__ void attn_store(bf16* ATT, float* LSE, int token, int slot, int lane, f32x16 (&O)[2], float lse2) {
    const int hi = lane >> 5; bf16* base = ATT + (size_t)token * AOW + slot * HD + 4 * hi;
    if (MERGE) {
        const float lp = LSE[token * NSLOT + slot], M = fmaxf(lse2, lp), wa = __builtin_amdgcn_exp2f(lse2 - M), wb = __builtin_amdgcn_exp2f(lp - M), inv = fast_rcp(wa + wb), ca = wa * inv, cb = wb * inv;
        lse2 = M + __builtin_amdgcn_logf(wa + wb);
#pragma unroll
        for (int dt = 0; dt < 2; ++dt)
#pragma unroll
            for (int g = 0; g < 4; ++g) { const v2u w = *(const GAS v2u*)(base + 32 * dt + 8 * g);
                O[dt][4 * g] = ca * O[dt][4 * g] + cb * bf_lo(w.x); O[dt][4 * g + 1] = ca * O[dt][4 * g + 1] + cb * bf_hi(w.x);
                O[dt][4 * g + 2] = ca * O[dt][4 * g + 2] + cb * bf_lo(w.y); O[dt][4 * g + 3] = ca * O[dt][4 * g + 3] + cb * bf_hi(w.y); }
    }
#pragma unroll
    for (int dt = 0; dt < 2; ++dt)
#pragma unroll
        for (int g = 0; g < 4; ++g) { v2u w; w.x = pk2(O[dt][4 * g], O[dt][4 * g + 1]); w.y = pk2(O[dt][4 * g + 2], O[dt][4 * g + 3]); *(GAS v2u*)(base + 32 * dt + 8 * g) = w; }
    if (!LAST && hi == 0) LSE[token * NSLOT + slot] = lse2;
}
__device__ __forceinline__ void p3_attention(Frame& F, const Args& a) {
    const bf16* QKV = (const bf16*)(a.ws + WS_QKV); bf16* ATT = (bf16*)a.out; float* LSE = (float*)(a.ws + WS_LSE);
    int lane = F.lane; asm volatile("" : "+v"(lane));
    const int w = F.wave, r = lane & 31;
    LAS unsigned char* vl = F.lds + w * 4096;
    const size_t WSTR = (size_t)NB * NHEAD * S * HD;
    for (int item = F.vcu; item < NB * NSLOT * 4; item += F.G) {
        const int c = item & 3, slot = (item >> 2) & 7, b = item >> 5;
        for (int t = 0; t < 2; ++t) { const int ph = 2 * w + t; const bf16* Qs = QKV + (((size_t)b * NHEAD + 16 + slot) * S + ph * 128) * HD;
            f32x16 O[2]; float lse2; attn_q32(Qs, Qs + WSTR, Qs + 2 * WSTR, 32 * c, vl, lane, O, lse2);
            attn_store<false, false>(ATT, LSE, b * S + (32 * c + r) * 16 + ph, slot, lane, O, lse2); }
        VM_WAIT(); __syncthreads(); __builtin_amdgcn_fence(__ATOMIC_ACQUIRE, "agent"); VM_WAIT();
        for (int t = 0; t < 2; ++t) { const int ph = w >> 1, sub = 2 * (w & 1) + t, i0 = 128 * c + 32 * sub; const bf16* Qs = QKV + (((size_t)b * NHEAD + 8 + slot) * S + ph * 512) * HD;
            f32x16 O[2]; float lse2; attn_q32(Qs, Qs + WSTR, Qs + 2 * WSTR, i0, vl, lane, O, lse2);
            attn_store<true, false>(ATT, LSE, b * S + (i0 + r) * 4 + ph, slot, lane, O, lse2); }
        VM_WAIT(); __syncthreads(); __builtin_amdgcn_fence(__ATOMIC_ACQUIRE, "agent"); VM_WAIT();
        for (int t = 0; t < 2; ++t) { const int i0 = 512 * c + 32 * (2 * w + t); const bf16* Qs = QKV + (((size_t)b * NHEAD + slot) * S) * HD;
            f32x16 O[2]; float lse2; attn_q32(Qs, Qs + WSTR, Qs + 2 * WSTR, i0, vl, lane, O, lse2);
            attn_store<true, true>(ATT, LSE, b * S + i0 + r, slot, lane, O, lse2); }
    }
    VM_WAIT(); __syncthreads();
}
__device__ __forceinline__ void p5_lru(Frame& F, const Args& a) {
    const bf16* XR = (const bf16*)(a.ws + WS_XR); const bf16* YR = (const bf16*)(a.ws + WS_YR); bf16* LRU = (bf16*)(a.ws + WS_LRU);
    LAS v4u* BF = (LAS v4u*)(F.lds);
    LAS float* CW = (LAS float*)(F.lds + 24576);
    LAS float* CARRY = (LAS float*)(F.lds + 24576 + 2048);
    volatile LAS int* FLAG = (volatile LAS int*)(F.lds + 24576 + 2048 + 65 * 256);
    int lane = F.lane; asm volatile("" : "+v"(lane));
    const int r = lane & 31, hi = lane >> 5, w = F.wave;
    const float LOG2E = 1.4426950408889634f;
    for (int item = F.vcu; item < NB * 16; item += F.G) {
        const int b = item >> 4, cb = item & 15;
        __syncthreads();
        for (int idx = F.tid; idx < 3 * 8 * 64; idx += NTHREADS) { const int l = idx & 63, f = idx >> 6, nt = f & 1, kk = (f >> 1) & 3, mat = f >> 3, rr = l & 31, hh = l >> 5, n = rr + 32 * nt;
            unsigned v[4];
#pragma unroll
            for (int jj = 0; jj < 4; ++jj) { float e[2];
#pragma unroll
                for (int q = 0; q < 2; ++q) { const int k = 16 * kk + 8 * hh + 2 * jj + q;
                    e[q] = mat == 0 ? a.in[8][(size_t)(cb * 64 + k) * 64 + n] : mat == 1 ? a.in[10][(size_t)(cb * 64 + k) * 64 + n] : (k == n ? 1.0f : 0.0f); }
                v[jj] = pk2(e[0], e[1]); }
            v4u o; o.x = v[0]; o.y = v[1]; o.z = v[2]; o.w = v[3]; BF[idx] = o; }
        for (int idx = F.tid; idx < 5 * 64; idx += NTHREADS) CW[idx] = idx < 256 ? a.in[6][(idx >> 6) * D + cb * 64 + (idx & 63)] : a.in[7][cb * 64 + (idx & 63)];
        if (F.tid < 65) FLAG[F.tid] = F.tid == 0 ? 1 : 0;
        if (F.tid < 64) CARRY[F.tid] = 0.f;
        __syncthreads();
        float bxv[2], bav[2], cav[2];
#pragma unroll
        for (int nt = 0; nt < 2; ++nt) { const int c = cb * 64 + r + 32 * nt; bxv[nt] = a.in[9][c]; bav[nt] = a.in[11][c]; cav[nt] = -8.0f * log1pf(__expf(-a.in[12][c])) * LOG2E; }
        for (int j = w; j < 64; j += 8) {
            const int t0 = 32 * j;
            bf16x8 Af[4];
#pragma unroll
            for (int kk = 0; kk < 4; ++kk) { const int c0 = 16 * kk + 8 * hi;
                f32x4 s0 = *(const LAS f32x4*)(CW + 256 + c0), s1 = *(const LAS f32x4*)(CW + 256 + c0 + 4);
#pragma unroll
                for (int d = 0; d < 4; ++d) { const int tok = t0 + r - d; const bool ok = tok >= 0;
                    const v4u x = *(const GAS v4u*)(XR + (size_t)(b * S + (ok ? tok : 0)) * D + cb * 64 + c0);
                    f32x4 x0, x1; unpack8(x, x0, x1); if (!ok) { x0 = x0 * 0.f; x1 = x1 * 0.f; }
                    const f32x4 w0 = *(const LAS f32x4*)(CW + (3 - d) * 64 + c0), w1 = *(const LAS f32x4*)(CW + (3 - d) * 64 + c0 + 4);
                    s0 = s0 + w0 * x0; s1 = s1 + w1 * x1; }
                Af[kk] = __builtin_bit_cast(bf16x8, pack8(s0, s1)); }
            f32x16 ci[2], cr[2], cx[2];
#pragma unroll
            for (int nt = 0; nt < 2; ++nt) {
#pragma unroll
                for (int i = 0; i < 16; ++i) { ci[nt][i] = 0.f; cr[nt][i] = 0.f; cx[nt][i] = 0.f; } }
#pragma unroll
            for (int kk = 0; kk < 4; ++kk)
#pragma unroll
                for (int nt = 0; nt < 2; ++nt) {
                    ci[nt] = __builtin_amdgcn_mfma_f32_32x32x16_bf16(Af[kk], __builtin_bit_cast(bf16x8, BF[((0 * 4 + kk) * 2 + nt) * 64 + lane]), ci[nt], 0, 0, 0);
                    cr[nt] = __builtin_amdgcn_mfma_f32_32x32x16_bf16(Af[kk], __builtin_bit_cast(bf16x8, BF[((1 * 4 + kk) * 2 + nt) * 64 + lane]), cr[nt], 0, 0, 0);
                    cx[nt] = __builtin_amdgcn_mfma_f32_32x32x16_bf16(Af[kk], __builtin_bit_cast(bf16x8, BF[((2 * 4 + kk) * 2 + nt) * 64 + lane]), cx[nt], 0, 0, 0); }
            unsigned short yv[2][16];
#pragma unroll
            for (int nt = 0; nt < 2; ++nt)
#pragma unroll
                for (int i = 0; i < 16; ++i) yv[nt][i] = YR[(size_t)(b * S + t0 + 8 * (i >> 2) + 4 * hi + (i & 3)) * D + cb * 64 + r + 32 * nt];
#pragma unroll
            for (int nt = 0; nt < 2; ++nt)
#pragma unroll
                for (int i = 0; i < 16; ++i) {
                    const float gi = fast_rcp(1.0f + __builtin_amdgcn_exp2f(-(ci[nt][i] + bxv[nt]) * LOG2E)), gr = fast_rcp(1.0f + __builtin_amdgcn_exp2f(-(cr[nt][i] + bav[nt]) * LOG2E));
                    const float av = __builtin_amdgcn_exp2f(cav[nt] * gr), mult = __builtin_amdgcn_sqrtf(fmaxf(0.f, 1.0f - av * av));
                    cr[nt][i] = av; ci[nt][i] = mult * gi * cx[nt][i]; }
            float A1[2][4], B1[2][4], A2[2][4], B2[2][4], SA[2], SB[2];
#pragma unroll
            for (int nt = 0; nt < 2; ++nt) { SA[nt] = 1.f; SB[nt] = 0.f;
#pragma unroll
                for (int g = 0; g < 4; ++g) { const int i0 = 4 * g;
                    const float ga = (cr[nt][i0] * cr[nt][i0 + 1]) * (cr[nt][i0 + 2] * cr[nt][i0 + 3]);
                    const float gb = ((ci[nt][i0] * cr[nt][i0 + 1] + ci[nt][i0 + 1]) * cr[nt][i0 + 2] + ci[nt][i0 + 2]) * cr[nt][i0 + 3] + ci[nt][i0 + 3];
                    const float pa = __shfl_xor(ga, 32), pb = __shfl_xor(gb, 32);
                    A1[nt][g] = hi ? pa : ga; B1[nt][g] = hi ? pb : gb; A2[nt][g] = hi ? ga : pa; B2[nt][g] = hi ? gb : pb;
                    SB[nt] = A1[nt][g] * SB[nt] + B1[nt][g]; SA[nt] = A1[nt][g] * SA[nt];
                    SB[nt] = A2[nt][g] * SB[nt] + B2[nt][g]; SA[nt] = A2[nt][g] * SA[nt]; } }
            if (j > 0) { while (FLAG[j] == 0) __builtin_amdgcn_s_sleep(1); }
            asm volatile("" ::: "memory");
            float h[2];
#pragma unroll
            for (int nt = 0; nt < 2; ++nt) { h[nt] = CARRY[j * 64 + r + 32 * nt]; if (hi == 0) CARRY[(j + 1) * 64 + r + 32 * nt] = SA[nt] * h[nt] + SB[nt]; }
            asm volatile("s_waitcnt lgkmcnt(0)" ::: "memory");
            if (lane == 0) FLAG[j + 1] = 1;
#pragma unroll
            for (int nt = 0; nt < 2; ++nt)
#pragma unroll
                for (int g = 0; g < 4; ++g) { const float h1 = A1[nt][g] * h[nt] + B1[nt][g]; float hh = hi ? h1 : h[nt]; h[nt] = A2[nt][g] * h1 + B2[nt][g];
#pragma unroll
                    for (int q = 0; q < 4; ++q) { const int i = 4 * g + q; hh = cr[nt][i] * hh + ci[nt][i];
                        LRU[(size_t)(b * S + t0 + 8 * g + 4 * hi + q) * D + cb * 64 + r + 32 * nt] = (bf16)f2bf(hh * bf2f(yv[nt][i])); } }
        }
    }
    __syncthreads();
}
__device__ __forceinline__ void p10_router(Frame& F, const Args& a) {
    LAS float* WT = (LAS float*)F.lds;
    for (int i = F.tid; i < 36 * D; i += NTHREADS) { const int o = i >> 10, k = i & 1023; WT[i] = o < 4 ? a.in[17][k * 4 + o] : a.in[19][k * 32 + (o - 4)]; }
    __syncthreads();
    const int gw = F.vcu * NWAVES + F.wave, NGW = F.G * NWAVES, lane = F.lane;
    const float* MOD = (const float*)(a.ws + WS_MOD); bf16* H2 = (bf16*)(a.ws + WS_H); const float* X1 = a.out;
    int* TOKE = (int*)(a.ws + WS_TOKE); int* TOKR = (int*)(a.ws + WS_TOKR); float* TOKW = (float*)(a.ws + WS_TOKW);
    for (int m = gw; m < T; m += NGW) { const int b = m >> 11; f32x4 h[4];
        norm_mod_row(X1 + (size_t)m * D, a.in[16], MOD + b * 6144 + 3072, MOD + b * 6144 + 4096, lane, h);
        store_row_bf16(H2 + (size_t)m * D, lane, h);
        float lg[36];
#pragma unroll
        for (int o = 0; o < 36; ++o) { float p = 0.f;
#pragma unroll
            for (int j = 0; j < 4; ++j) { const f32x4 w = *(const LAS f32x4*)(WT + o * D + 256 * j + 4 * lane); p += (h[j].x * w.x + h[j].y * w.y) + (h[j].z * w.z + h[j].w * w.w); }
            lg[o] = wave_sum(p);
            if ((o & 3) == 3) asm volatile("" ::: "memory"); }
        float gl[4];
#pragma unroll
        for (int o = 0; o < 4; ++o) gl[o] = lg[o] + a.in[18][o];
        int gi = 0; float gm = gl[0];
#pragma unroll
        for (int o = 1; o < 4; ++o) if (gl[o] > gm) { gm = gl[o]; gi = o; }
        float den = 0.f;
#pragma unroll
        for (int o = 0; o < 4; ++o) den += __expf(gl[o] - gm);
        const float ggate = 1.0f / den;
        float el[8];
#pragma unroll
        for (int j = 0; j < 8; ++j) { float v = lg[4 + j];
#pragma unroll
            for (int gg = 1; gg < 4; ++gg) v = (gi == gg) ? lg[4 + gg * 8 + j] : v;
            el[j] = v + a.in[20][gi * 8 + j]; }
        int i1 = 0; float v1 = el[0];
#pragma unroll
        for (int j = 1; j < 8; ++j) if (el[j] > v1) { v1 = el[j]; i1 = j; }
        int i2 = -1; float v2 = -INFINITY;
#pragma unroll
        for (int j = 0; j < 8; ++j) if (j != i1 && el[j] > v2) { v2 = el[j]; i2 = j; }
        const float e2 = __expf(v2 - v1), w1 = ggate / (1.0f + e2), w2 = ggate * e2 / (1.0f + e2);
        if (lane == 0) {
            const int e1 = gi * 8 + i1, e2i = gi * 8 + i2;
            const int r1 = (int)atomicAdd((unsigned*)(a.ws + WS_CTL) + CW_CNT + 64 * e1, 1u), r2 = (int)atomicAdd((unsigned*)(a.ws + WS_CTL) + CW_CNT + 64 * e2i, 1u);
            TOKE[2 * m] = e1; TOKE[2 * m + 1] = e2i; TOKR[2 * m] = r1; TOKR[2 * m + 1] = r2; TOKW[2 * m] = w1; TOKW[2 * m + 1] = w2;
        }
    }
    __syncthreads();
}
__device__ __forceinline__ int moe_tables(Frame& F, const Args& a, LAS int* off, LAS int* tile_e) {
    if (F.tid == 0) { int acc = 0;
        for (int e = 0; e < NE; ++e) { off[e] = acc; const int cnt = (int)__hip_atomic_load((unsigned*)(a.ws + WS_CTL) + CW_CNT + 64 * e, RLX_AGENT); const int nt = (cnt + 255) >> 8;
            for (int t = 0; t < nt; ++t) tile_e[(acc >> 8) + t] = e; acc += nt * 256; }
        off[NE] = acc; }
    __syncthreads();
    return off[NE] >> 8;
}
__device__ __forceinline__ void p11_scatter(Frame& F, const Args& a) {
    LAS int* off = (LAS int*)(F.lds + LDSX_OFF); LAS int* tile_e = off + 64;
    (void)moe_tables(F, a, off, tile_e);
    const int gw = F.vcu * NWAVES + F.wave, NGW = F.G * NWAVES, lane = F.lane;
    const bf16* H2 = (const bf16*)(a.ws + WS_H); bf16* XP = (bf16*)(a.ws + WS_XP);
    const int* TOKE = (const int*)(a.ws + WS_TOKE); const int* TOKR = (const int*)(a.ws + WS_TOKR); int* TOKS = (int*)(a.ws + WS_TOKS);
    for (int m = gw; m < T; m += NGW) {
        const v4u r0 = ((const GAS v4u*)(H2 + (size_t)m * D))[lane], r1 = ((const GAS v4u*)(H2 + (size_t)m * D))[64 + lane];
#pragma unroll
        for (int k = 0; k < 2; ++k) { const int e = TOKE[2 * m + k], slot = off[e] + TOKR[2 * m + k];
            GAS v4u* d = (GAS v4u*)(XP + (size_t)slot * D); d[lane] = r0; d[64 + lane] = r1;
            if (lane == 0) TOKS[2 * m + k] = slot; }
    }
    __syncthreads();
}
__device__ __forceinline__ void p14_final(Frame& F, const Args& a) {
    const int gw = F.vcu * NWAVES + F.wave, NGW = F.G * NWAVES, lane = F.lane;
    const float* MOD = (const float*)(a.ws + WS_MOD); const bf16* Y = (const bf16*)(a.ws + WS_Y);
    const int* TOKS = (const int*)(a.ws + WS_TOKS); const float* TOKW = (const float*)(a.ws + WS_TOKW);
    for (int m = gw; m < T; m += NGW) { const int b = m >> 11;
        const int s0 = TOKS[2 * m], s1 = TOKS[2 * m + 1]; const float w0 = TOKW[2 * m], w1 = TOKW[2 * m + 1];
        GAS f32x4* xr = (GAS f32x4*)(a.out + (size_t)m * D) + lane; f32x4 v[4]; float ss = 0.f;
#pragma unroll
        for (int j = 0; j < 4; ++j) {
            const v2u ya = ((const GAS v2u*)(Y + (size_t)s0 * D) + lane)[64 * j], yb = ((const GAS v2u*)(Y + (size_t)s1 * D) + lane)[64 * j];
            const f32x4 y0 = (f32x4){bf_lo(ya.x), bf_hi(ya.x), bf_lo(ya.y), bf_hi(ya.y)}, y1 = (f32x4){bf_lo(yb.x), bf_hi(yb.x), bf_lo(yb.y), bf_hi(yb.y)};
            const f32x4 g2 = ((const GAS f32x4*)(MOD + b * 6144 + 5120) + lane)[64 * j];
            v[j] = xr[64 * j] + (g2 + 1.0f) * (y0 * w0 + y1 * w1);
            ss += (v[j].x * v[j].x + v[j].y * v[j].y) + (v[j].z * v[j].z + v[j].w * v[j].w); }
        const float rstd = 1.0f / sqrtf(wave_sum(ss) * (1.0f / D) + EPS);
#pragma unroll
        for (int j = 0; j < 4; ++j) xr[64 * j] = v[j] * rstd * ((const GAS f32x4*)a.in[24] + lane)[64 * j];
    }
}

template <class Epi, class Sched> __device__ __forceinline__ void run_gemm(Frame& F, const pg8::Gemm& g, const Sched& S, const Epi& E) {
#if MK_SIMPLE_GEMM
    pg8::gemm_phase_simple<Epi, Sched>(g, S, E);
#else
    pg8::gemm_phase<Epi, Sched, true>(F.lds, g, S, E);
#endif
}

constexpr int NPHASES = 15;
__global__ void __launch_bounds__(NTHREADS, 2) mk_fwd(Args args) {
    extern __shared__ __attribute__((aligned(16))) unsigned char lds_raw[];
    Frame F;
    F.lds = (LAS unsigned char*)lds_raw; F.MISC = (volatile LAS unsigned*)(F.lds + MISC_OFF);
    F.tid = threadIdx.x; F.lane = F.tid & 63; F.wave = __builtin_amdgcn_readfirstlane(F.tid >> 6);
    F.G = gridDim.x; { const int bx = blockIdx.x; F.vcu = (F.G % 8 == 0) ? (bx % 8) * (F.G / 8) + bx / 8 : bx; }
    unsigned char* ws = args.ws; F.ctl = (gu32*)(ws + WS_CTL);
    if (F.tid < 64) F.MISC[F.tid] = 0u;
    __syncthreads();
    XcdBarrier bar; bar.bar = (unsigned*)(ws + WS_CTL) + CW_BAR; bar.x = 0; bar.st = nullptr;
    if (MK_N_LAUNCHES == 1) bar = xcd_barrier_post((unsigned*)(ws + WS_CTL) + CW_BAR, F.MISC + 8);
    const int lo = args.ph_lo, hi = args.ph_hi;
#ifndef PH_MASK
#define PH_MASK 0x7fff
#endif
#define IN(k) (((PH_MASK >> (k)) & 1) && lo <= (k) && (k) < hi)
#define SEAM(k) do { if (IN(k) && IN((k) + 1)) xcd_barrier(bar); } while (0)
    const bf16* H = (const bf16*)(ws + WS_H);
    const bf16* WIN_T = (const bf16*)(ws + WS_WIN_T);

    if (IN(0)) { p0_prologue(F, args); SEAM(0); }
    if (IN(1)) { p1_norm1(F, args); SEAM(1); }
    if (IN(2)) {
        pg8::Gemm g{H, WIN_T, T, 3 * AW, D, 0}; pg8::StaticOrder So; So.init(T, 3 * AW, F.G, (int)blockIdx.x);
        EpiQKV E{(bf16*)(ws + WS_QKV)}; run_gemm(F, g, So, E); SEAM(2); }
    if (IN(3)) { p3_attention(F, args); SEAM(3); }
    if (IN(4)) {
        pg8::Gemm g{H, WIN_T + (size_t)(3 * AW) * D, T, 2 * D, D, 0}; pg8::StaticOrder So; So.init(T, 2 * D, F.G, (int)blockIdx.x);
        EpiXY E{(bf16*)(ws + WS_XR), (bf16*)(ws + WS_YR)}; run_gemm(F, g, So, E); SEAM(4); }
    if (IN(5)) { p5_lru(F, args); SEAM(5); }
    if (IN(6)) {
        pg8::Gemm g{H, WIN_T + (size_t)(3 * AW + 2 * D) * D, T, 2 * D, D, 0}; pg8::StaticOrder So; So.init(T, 2 * D, F.G, (int)blockIdx.x);
        EpiGate E{(bf16*)(ws + WS_GA), (bf16*)(ws + WS_GL)}; run_gemm(F, g, So, E); SEAM(6); }
    if (IN(7)) {
        pg8::Gemm g{(const bf16*)args.out, (const bf16*)(ws + WS_WAO_T), T, D, AOW, 0}; pg8::StaticOrder So; So.init(T, D, F.G, (int)blockIdx.x);
        EpiP4a E{(bf16*)(ws + WS_GA)}; run_gemm(F, g, So, E); SEAM(7); }
    if (IN(8)) {
        pg8::Gemm g{(const bf16*)(ws + WS_LRU), (const bf16*)(ws + WS_WLO_T), T, D, D, 0}; pg8::StaticOrder So; So.init(T, D, F.G, (int)blockIdx.x);
        EpiP4b E{(const bf16*)(ws + WS_GA), (bf16*)(ws + WS_GL)}; run_gemm(F, g, So, E); SEAM(8); }
    if (IN(9)) {
        pg8::Gemm g{(const bf16*)(ws + WS_GL), (const bf16*)(ws + WS_WOUT_T), T, D, D, 0}; pg8::StaticOrder So; So.init(T, D, F.G, (int)blockIdx.x);
        EpiP5 E{args.in[0], (const float*)(ws + WS_MOD), args.out}; run_gemm(F, g, So, E); SEAM(9); }
    if (IN(10)) { p10_router(F, args); SEAM(10); }
    if (IN(11)) { p11_scatter(F, args); SEAM(11); }
    if (IN(12)) {
        LAS int* off = (LAS int*)(F.lds + LDSX_OFF); LAS int* tile_e = off + 64;
        const int ntiles = moe_tables(F, args, off, tile_e);
        pg8::Gemm g{(const bf16*)(ws + WS_XP), (const bf16*)(ws + WS_W13_T), ntiles * 256, D, D, (size_t)D * D * 2}; pg8::MoeOrder So{ntiles, F.G, F.vcu, tile_e};
        EpiMoeA E{(bf16*)(ws + WS_HB)}; run_gemm(F, g, So, E); SEAM(12); }
    if (IN(13)) {
        LAS int* off = (LAS int*)(F.lds + LDSX_OFF); LAS int* tile_e = off + 64;
        const int ntiles = moe_tables(F, args, off, tile_e);
        pg8::Gemm g{(const bf16*)(ws + WS_HB), (const bf16*)(ws + WS_W2_T), ntiles * 256, D, DE, (size_t)D * DE * 2}; pg8::MoeOrder So{ntiles, F.G, F.vcu, tile_e};
        EpiMoeB E{(bf16*)(ws + WS_Y)}; run_gemm(F, g, So, E); SEAM(13); }
    if (IN(14)) { p14_final(F, args); }
#undef IN
#undef SEAM
}

extern "C" void kernel_launch(void* const* d_in, const int* in_sizes, int n_in, void* d_out, int out_size, void* d_ws, size_t ws_size, hipStream_t stream) {
    static int grid = 0;
    if (grid == 0) {
        if (n_in != 25 || out_size != T * D || ws_size < WS_END) { fprintf(stderr, "kernel_launch: unexpected shapes: n_in %d out %d ws %zu (need %zu)\n", n_in, out_size, ws_size, (size_t)WS_END); grid = -1; return; }
        int dev = 0, cus = 0, per_cu = 0;
        if (hipGetDevice(&dev) != hipSuccess || hipDeviceGetAttribute(&cus, hipDeviceAttributeMultiprocessorCount, dev) != hipSuccess) { grid = -1; return; }
        if (hipFuncSetAttribute((const void*)mk_fwd, hipFuncAttributeMaxDynamicSharedMemorySize, LDS_BYTES) != hipSuccess) { fprintf(stderr, "kernel_launch: hipFuncSetAttribute failed\n"); grid = -1; return; }
        if (hipOccupancyMaxActiveBlocksPerMultiprocessor(&per_cu, (const void*)mk_fwd, NTHREADS, LDS_BYTES) != hipSuccess || per_cu < 1) { fprintf(stderr, "kernel_launch: occupancy query says %d\n", per_cu); }
        (void)hipGetLastError();
        grid = cus;
    }
    if (grid < 0) return;
    if (hipMemsetAsync((char*)d_ws + WS_CTL, 0, CTL_ZERO_BYTES, stream) != hipSuccess) return;
    Args a{};
    for (int i = 0; i < 25; ++i) a.in[i] = (const float*)d_in[i];
    a.out = (float*)d_out; a.ws = (unsigned char*)d_ws;
    if (MK_N_LAUNCHES == 1) { a.ph_lo = 0; a.ph_hi = NPHASES; hipLaunchKernelGGL(mk_fwd, dim3(grid), dim3(NTHREADS), LDS_BYTES, stream, a); }
    else for (int p = 0; p < NPHASES; ++p) { a.ph_lo = p; a.ph_hi = p + 1; hipLaunchKernelGGL(mk_fwd, dim3(grid), dim3(NTHREADS), LDS_BYTES, stream, a); }
}
```

```cpp
#include <hip/hip_runtime.h>
#include <cstdio>
#include <cstdint>

#ifndef MK_N_LAUNCHES
#define MK_N_LAUNCHES 1
#endif
#ifndef MK_SIMPLE_GEMM
#define MK_SIMPLE_GEMM 0
#endif

#define GAS __attribute__((address_space(1)))
#define LAS __attribute__((address_space(3)))
typedef unsigned short bf16;
typedef unsigned v4u __attribute__((ext_vector_type(4)));
typedef unsigned v2u __attribute__((ext_vector_type(2)));
typedef float f32x4 __attribute__((ext_vector_type(4)));
typedef float f32x2 __attribute__((ext_vector_type(2)));
typedef short bf16x8 __attribute__((ext_vector_type(8)));
typedef GAS unsigned gu32;

constexpr int NB = 16, S = 2048, D = 1024, T = NB * S;
constexpr int HD = 64, NSLOT = 8, NHEAD = 24, AW = 1536, AOW = 512;
constexpr int IN_COLS = 8704, NE = 32, DE = 512, MAX_TILES = 288;
constexpr float EPS = 1e-6f, QSCALE = 0.125f * 1.4426950408889634f;
constexpr int NWAVES = 8, NTHREADS = 512;

constexpr size_t MiB = 1u << 20, KiB = 1u << 10;
constexpr size_t WS_CTL = 0, CTL_ZERO_BYTES = 1 * MiB;
constexpr size_t WS_MOD = 128 * KiB;
constexpr size_t WS_TOKE = 1 * MiB, WS_TOKR = WS_TOKE + 256 * KiB, WS_TOKW = WS_TOKR + 256 * KiB, WS_TOKS = WS_TOKW + 256 * KiB;
constexpr size_t WS_WIN_T = 2 * MiB;
constexpr size_t WS_WAO_T = 19 * MiB, WS_WLO_T = 20 * MiB, WS_WOUT_T = 22 * MiB;
constexpr size_t WS_LSE = 26 * MiB;
constexpr size_t WS_W13_T = 32 * MiB;
constexpr size_t WS_W2_T = 96 * MiB;
constexpr size_t WS_H = 128 * MiB;
constexpr size_t WS_R = 192 * MiB;
constexpr size_t WS_QKV = WS_R;
constexpr size_t WS_XR = WS_R, WS_YR = WS_R + 64 * MiB, WS_LRU = WS_R + 128 * MiB, WS_GA = WS_R + 192 * MiB, WS_GL = WS_R + 256 * MiB;
constexpr size_t WS_XP = WS_R, WS_HB = WS_R + 144 * MiB, WS_Y = WS_R;
constexpr size_t WS_END = 512 * MiB;
constexpr int CW_TMO = 0, CW_CNT = 1024, CW_BAR = 4096;

constexpr int RING_BYTES = 131072;
constexpr int LDSX_OFF = RING_BYTES;
constexpr int LDS_BYTES = 155648;
constexpr int MISC_OFF = LDS_BYTES - 256;

#define LDS_WAIT() asm volatile("s_waitcnt lgkmcnt(0)" ::: "memory")
#define VM_WAIT() asm volatile("s_waitcnt vmcnt(0)" ::: "memory")
#define RLX_AGENT __ATOMIC_RELAXED, __HIP_MEMORY_SCOPE_AGENT

__device__ __forceinline__ unsigned f2bf(float f) { unsigned u = __builtin_bit_cast(unsigned, f); return (u + 0x7fffu + ((u >> 16) & 1u)) >> 16; }
__device__ __forceinline__ unsigned pk2(float lo, float hi) { unsigned r; asm("v_cvt_pk_bf16_f32 %0, %1, %2" : "=v"(r) : "v"(lo), "v"(hi)); return r; }
__device__ __forceinline__ float bf_lo(unsigned u) { return __builtin_bit_cast(float, u << 16); }
__device__ __forceinline__ float bf_hi(unsigned u) { return __builtin_bit_cast(float, u & 0xffff0000u); }
__device__ __forceinline__ float bf2f(bf16 b) { return __builtin_bit_cast(float, ((unsigned)b) << 16); }
__device__ __forceinline__ float fast_rcp(float x) { return __builtin_amdgcn_rcpf(x); }
__device__ __forceinline__ float sigmoid_f(float x) { return fast_rcp(1.0f + __expf(-x)); }
__device__ __forceinline__ float gelu_tanh_f(float v) { const float u = 0.7978845608028654f * (v + 0.044715f * v * v * v); return v * fast_rcp(1.0f + __expf(-2.0f * u)); }
__device__ __forceinline__ float wave_sum(float v) {
#pragma unroll
    for (int o = 1; o < 64; o <<= 1) v += __shfl_xor(v, o);
    return v;
}

namespace pg8 {
#define PG8_LAS __attribute__((address_space(3)))
typedef unsigned short bf16_t;
constexpr int BM = 256, BK = 64, HALF = 128, HTB = HALF * BK * 2, STAGE_BYTES = 8 * HTB, NXCD = 8, WGM = 8;

__host__ __device__ __forceinline__ int lds_byte(int r, int c) { const int st = (r >> 4) * 2 + (c >> 5), rr = r & 15, cc = c & 31, ob = rr * 64 + cc * 2; return st * 1024 + (ob ^ (((ob >> 9) & 1) << 5)); }
__host__ __device__ __forceinline__ void stage_rc(int b, int& R, int& C) { const int st = b / 1024, sb = b % 1024, swz = sb ^ (((sb >> 9) & 1) << 5); R = (st >> 1) * 16 + swz / 64; C = (st & 1) * 32 + (swz % 64) / 2; }
__host__ __device__ __forceinline__ int perm32(int rho) { const int n = rho >> 4, i = rho & 15; return 8 * (i >> 2) + 4 * n + (i & 3); }

struct Unit { int pm, pn, e; };
struct Gemm { const bf16_t* A; const bf16_t* Bt; int M, N, K; size_t estride; };

struct StaticOrder {
    int nM, nN, nwg, G, c;
    __host__ __device__ void init(int M, int N, int G_, int c_) { nM = M / BM; nN = N / BM; nwg = nM * nN; G = G_; c = c_; }
    __host__ __device__ bool next(int i, Unit& u) const {
        const long L = (long)i * G + c; if (L >= nwg) return false;
        int wgid = (int)L; { const int q = nwg / NXCD, r = nwg % NXCD, xcd = wgid % NXCD, off = wgid / NXCD; wgid = (xcd < r ? xcd * (q + 1) : r * (q + 1) + (xcd - r) * q) + off; }
        const int nig = WGM * nN, gid = wgid / nig, fm = gid * WGM, gsz = (nM - fm) < WGM ? (nM - fm) : WGM;
        u.pm = fm + ((wgid % nig) % gsz); u.pn = (wgid % nig) / gsz; u.e = 0; return true;
    }
};
struct MoeOrder {
    int ntiles, G, vcu; const PG8_LAS int* tile_e;
    __device__ bool next(int i, Unit& u) const {
        const int L = i * G + vcu; if (L >= ntiles * 4) return false;
        u.pm = L >> 2; u.pn = L & 3; u.e = __builtin_amdgcn_readfirstlane(tile_e[u.pm]); return true;
    }
};

template <class Epi> __device__ __forceinline__ void run_epi(const Epi& E, const f32x4 (&acc)[2][2][4][2], const Unit& u, int wr, int wc, int fr, int fq) {
    const int row0 = u.pm * BM + wr * 64 + fr, col0 = u.pn * BM + wc * 32 + 8 * fq;
#pragma unroll
    for (int ai = 0; ai < 2; ++ai)
#pragma unroll
        for (int m = 0; m < 4; ++m)
#pragma unroll
            for (int bj = 0; bj < 2; ++bj) E.store8(row0 + ai * HALF + m * 16, col0 + bj * HALF, acc[ai][bj][m][0], acc[ai][bj][m][1]);
}

template <class Epi, class Sched, bool ALIGN_EPI = true>
__device__ __forceinline__ void gemm_phase(PG8_LAS unsigned char* lds, const Gemm g, const Sched& S, const Epi& E) {
    int tid = threadIdx.x; asm volatile("" : "+v"(tid));
    const int wid = __builtin_amdgcn_readfirstlane(tid >> 6), lane = tid & 63, wr = wid >> 2, wc = wid & 3, fr = lane & 15, fq = lane >> 4;
    const int K = g.K, nt = K / BK;
    unsigned voffA[2], voffB[2];
#pragma unroll
    for (int i = 0; i < 2; ++i) { int R, C; stage_rc(tid * 16 + i * 8192, R, C); const int Rb = (R & ~31) + perm32(R & 31);
        voffA[i] = (unsigned)(R * K + C) * 2u; voffB[i] = (unsigned)(Rb * K + C) * 2u; }
    const size_t kstep = (size_t)(BK * 2);
    const size_t hstep = (size_t)HALF * K * 2;
    const size_t tstep = 2 * hstep;
    const unsigned ldsw = (unsigned)wid * 1024u;
    const int aoff = lds_byte(wr * 64 + fr, fq * 8), boff = lds_byte(wc * 32 + fr, fq * 8);
#define PG8_SA(b, h) (((b) * 2 + (h)) * HTB)
#define PG8_SB(b, h) ((4 + (b) * 2 + (h)) * HTB)
#define PG8_STAGE(bufoff, gbase, voff) do { _Pragma("unroll") for (int _i = 0; _i < 2; ++_i) \
        __builtin_amdgcn_global_load_lds((const unsigned*)((const char*)(gbase) + (voff)[_i]), (PG8_LAS unsigned*)(lds + (bufoff) + ldsw + _i * 8192), 16, 0, 0); } while (0)
#define PG8_LDA(dst, b, h) do { _Pragma("unroll") for (int m = 0; m < 4; ++m) _Pragma("unroll") for (int k = 0; k < 2; ++k) dst[m][k] = *(const PG8_LAS bf16x8*)(lds + PG8_SA(b, h) + aoff + m * 2048 + k * 1024); } while (0)
#define PG8_LDB(dst, b, h) do { _Pragma("unroll") for (int n = 0; n < 2; ++n) _Pragma("unroll") for (int k = 0; k < 2; ++k) dst[n][k] = *(const PG8_LAS bf16x8*)(lds + PG8_SB(b, h) + boff + n * 2048 + k * 1024); } while (0)
#define PG8_MMA(ai, bj, At, Bt) do { __builtin_amdgcn_s_setprio(1); _Pragma("unroll") for (int m = 0; m < 4; ++m) _Pragma("unroll") for (int n = 0; n < 2; ++n) _Pragma("unroll") for (int k = 0; k < 2; ++k) \
        acc[ai][bj][m][n] = __builtin_amdgcn_mfma_f32_16x16x32_bf16(Bt[n][k], At[m][k], acc[ai][bj][m][n], 0, 0, 0); __builtin_amdgcn_s_setprio(0); } while (0)
#define PG8_WAIT_V(n) asm volatile("s_waitcnt vmcnt(" #n ")" ::: "memory")
#define PG8_WAIT_L(n) asm volatile("s_waitcnt lgkmcnt(" #n ")" ::: "memory")
#define PG8_BAR __builtin_amdgcn_s_barrier()
#define PG8_SCHED __builtin_amdgcn_sched_barrier(0)
    Unit cur, nxt; int ui = 0;
    if (!S.next(0, cur)) return;
    f32x4 acc[2][2][4][2];
#pragma unroll
    for (int a = 0; a < 2; ++a)
#pragma unroll
        for (int b = 0; b < 2; ++b)
#pragma unroll
            for (int m = 0; m < 4; ++m)
#pragma unroll
                for (int n = 0; n < 2; ++n) acc[a][b][m][n] = (f32x4){0.f, 0.f, 0.f, 0.f};
    bf16x8 At[4][2], B0[2][2], B1[2][2];
    const char* cA = (const char*)g.A + (size_t)cur.pm * tstep; const char* cB = (const char*)g.Bt + (size_t)cur.e * g.estride + (size_t)cur.pn * tstep;
    PG8_STAGE(PG8_SB(0, 0), cB, voffB); PG8_STAGE(PG8_SB(0, 1), cB + hstep, voffB); PG8_STAGE(PG8_SA(0, 0), cA, voffA); PG8_STAGE(PG8_SA(0, 1), cA + hstep, voffA);
    if (wr == 1) PG8_BAR;
    PG8_WAIT_V(2); PG8_BAR;
    PG8_STAGE(PG8_SB(1, 0), cB + kstep, voffB); PG8_STAGE(PG8_SA(1, 0), cA + kstep, voffA); PG8_STAGE(PG8_SB(1, 1), cB + hstep + kstep, voffB);
    PG8_WAIT_V(6); PG8_BAR;
    for (;;) {
        const bool has_next = S.next(ui + 1, nxt);
        const char* nA = has_next ? (const char*)g.A + (size_t)nxt.pm * tstep : cA; const char* nB = has_next ? (const char*)g.Bt + (size_t)nxt.e * g.estride + (size_t)nxt.pn * tstep : cB;
        for (int t = 0; t < nt; t += 2) {
            const bool last = (t == nt - 2);
            const char* a1 = cA + (size_t)(t + 1) * kstep;
            const char* a2 = last ? nA : cA + (size_t)(t + 2) * kstep; const char* b2 = last ? nB : cB + (size_t)(t + 2) * kstep;
            const char* a3 = a2 + kstep; const char* b3 = b2 + kstep;
            PG8_LDB(B0, 0, 0); PG8_LDB(B1, 0, 1); PG8_SCHED; PG8_LDA(At, 0, 0); PG8_STAGE(PG8_SA(1, 1), a1 + hstep, voffA);
            PG8_WAIT_V(8); PG8_WAIT_L(0); PG8_BAR; PG8_MMA(0, 0, At, B0); PG8_MMA(0, 1, At, B1); PG8_BAR; PG8_SCHED;
            PG8_LDA(At, 0, 1); PG8_STAGE(PG8_SB(0, 0), b2, voffB); PG8_STAGE(PG8_SB(0, 1), b2 + hstep, voffB); PG8_STAGE(PG8_SA(0, 0), a2, voffA);
            PG8_WAIT_V(8); PG8_WAIT_L(0); PG8_BAR; PG8_MMA(1, 0, At, B0); PG8_MMA(1, 1, At, B1); PG8_BAR; PG8_SCHED;
            PG8_LDB(B0, 1, 0); PG8_LDB(B1, 1, 1); PG8_SCHED; PG8_LDA(At, 1, 0); PG8_STAGE(PG8_SA(0, 1), a2 + hstep, voffA);
            PG8_WAIT_V(8); PG8_WAIT_L(0); PG8_BAR; PG8_MMA(0, 0, At, B0); PG8_MMA(0, 1, At, B1); PG8_BAR; PG8_SCHED;
            PG8_LDA(At, 1, 1); PG8_STAGE(PG8_SB(1, 0), b3, voffB); PG8_STAGE(PG8_SB(1, 1), b3 + hstep, voffB); PG8_STAGE(PG8_SA(1, 0), a3, voffA);
            PG8_WAIT_V(8); PG8_WAIT_L(0); PG8_BAR; PG8_MMA(1, 0, At, B0); PG8_MMA(1, 1, At, B1); PG8_BAR; PG8_SCHED;
        }
        if constexpr (ALIGN_EPI) { if (wr == 0) PG8_BAR; }
        run_epi(E, acc, cur, wr, wc, fr, fq);
        if (!has_next) break;
#pragma unroll
        for (int a = 0; a < 2; ++a)
#pragma unroll
            for (int b = 0; b < 2; ++b)
#pragma unroll
                for (int m = 0; m < 4; ++m)
#pragma unroll
                    for (int n = 0; n < 2; ++n) acc[a][b][m][n] = (f32x4){0.f, 0.f, 0.f, 0.f};
        cur = nxt; cA = nA; cB = nB; ++ui;
        if constexpr (ALIGN_EPI) { if (wr == 1) PG8_BAR; }
    }
    PG8_WAIT_V(0);
    if constexpr (!ALIGN_EPI) { if (wr == 0) PG8_BAR; }
    PG8_BAR;
#undef PG8_SA
#undef PG8_SB
#undef PG8_STAGE
#undef PG8_LDA
#undef PG8_LDB
#undef PG8_MMA
#undef PG8_WAIT_V
#undef PG8_WAIT_L
#undef PG8_BAR
#undef PG8_SCHED
}

template <class Epi, class Sched>
__device__ __forceinline__ void gemm_phase_simple(const Gemm g, const Sched& S, const Epi& E) {
    const int tid = threadIdx.x, wid = tid >> 6, lane = tid & 63, wr = wid >> 2, wc = wid & 3, fr = lane & 15, fq = lane >> 4;
    const int K = g.K;
    Unit cur;
    for (int ui = 0; S.next(ui, cur); ++ui) {
        f32x4 acc[2][2][4][2];
#pragma unroll
        for (int a = 0; a < 2; ++a)
#pragma unroll
            for (int b = 0; b < 2; ++b)
#pragma unroll
                for (int m = 0; m < 4; ++m)
#pragma unroll
                    for (int n = 0; n < 2; ++n) acc[a][b][m][n] = (f32x4){0.f, 0.f, 0.f, 0.f};
        const bf16_t* Ab = g.A + (size_t)(cur.pm * BM + wr * 64 + fr) * K;
        const bf16_t* Bb = (const bf16_t*)((const char*)g.Bt + (size_t)cur.e * g.estride) + (size_t)(cur.pn * BM + wc * 32 + 8 * fq) * K;
        for (int k0 = 0; k0 < K; k0 += 2) {
            float av[2][4][2], bv[2][8][2];
#pragma unroll
            for (int ai = 0; ai < 2; ++ai)
#pragma unroll
                for (int m = 0; m < 4; ++m) { const unsigned u = *(const unsigned*)(Ab + (size_t)(ai * HALF + m * 16) * K + k0); av[ai][m][0] = bf_lo(u); av[ai][m][1] = bf_hi(u); }
#pragma unroll
            for (int bj = 0; bj < 2; ++bj)
#pragma unroll
                for (int j = 0; j < 8; ++j) { const unsigned u = *(const unsigned*)(Bb + (size_t)(bj * HALF + j) * K + k0); bv[bj][j][0] = bf_lo(u); bv[bj][j][1] = bf_hi(u); }
#pragma unroll
            for (int ai = 0; ai < 2; ++ai)
#pragma unroll
                for (int bj = 0; bj < 2; ++bj)
#pragma unroll
                    for (int m = 0; m < 4; ++m)
#pragma unroll
                        for (int n = 0; n < 2; ++n)
#pragma unroll
                            for (int j = 0; j < 4; ++j) acc[ai][bj][m][n][j] += av[ai][m][0] * bv[bj][n * 4 + j][0] + av[ai][m][1] * bv[bj][n * 4 + j][1];
        }
        run_epi(E, acc, cur, wr, wc, fr, fq);
    }
}
}

__device__ __forceinline__ v4u pack8(const f32x4 a, const f32x4 b) { v4u w; w.x = pk2(a[0], a[1]); w.y = pk2(a[2], a[3]); w.z = pk2(b[0], b[1]); w.w = pk2(b[2], b[3]); return w; }
__device__ __forceinline__ void unpack8(const v4u w, f32x4& a, f32x4& b) { a = (f32x4){bf_lo(w.x), bf_hi(w.x), bf_lo(w.y), bf_hi(w.y)}; b = (f32x4){bf_lo(w.z), bf_hi(w.z), bf_lo(w.w), bf_hi(w.w)}; }

struct EpiQKV { bf16* QKV;
    __device__ __forceinline__ void store8(int row, int col, f32x4 v0, f32x4 v1) const {
        const int which = col / AW, rem = col - which * AW, hh = rem >> 6, dim0 = rem & 63, sh = 2 * (hh >> 3);
        const int b = row >> 11, s = row & 2047, pos = ((s & ((1 << sh) - 1)) << (11 - sh)) | (s >> sh);
        if (which == 0) { v0 = v0 * QSCALE; v1 = v1 * QSCALE; }
        *(GAS v4u*)(QKV + ((((size_t)(which * NB + b) * NHEAD + hh) * S + pos) * HD + dim0)) = pack8(v0, v1);
    } };
struct EpiXY { bf16* XR; bf16* YR;
    __device__ __forceinline__ void store8(int row, int col, f32x4 v0, f32x4 v1) const {
        if (col < D) { *(GAS v4u*)(XR + (size_t)row * D + col) = pack8(v0, v1); }
        else {
#pragma unroll
            for (int j = 0; j < 4; ++j) { v0[j] = gelu_tanh_f(v0[j]); v1[j] = gelu_tanh_f(v1[j]); }
            *(GAS v4u*)(YR + (size_t)row * D + (col - D)) = pack8(v0, v1); }
    } };
struct EpiGate { bf16* GA; bf16* GL;
    __device__ __forceinline__ void store8(int row, int col, f32x4 v0, f32x4 v1) const {
#pragma unroll
        for (int j = 0; j < 4; ++j) { v0[j] = sigmoid_f(v0[j]); v1[j] = sigmoid_f(v1[j]); }
        bf16* dst = col < D ? GA + (size_t)row * D + col : GL + (size_t)row * D + (col - D);
        *(GAS v4u*)dst = pack8(v0, v1);
    } };
struct EpiP4a { bf16* GA;
    __device__ __forceinline__ void store8(int row, int col, f32x4 v0, f32x4 v1) const {
        GAS v4u* p = (GAS v4u*)(GA + (size_t)row * D + col); f32x4 g0, g1; unpack8(*p, g0, g1);
        *p = pack8(g0 * v0, g1 * v1);
    } };
struct EpiP4b { const bf16* TMP; bf16* GL;
    __device__ __forceinline__ void store8(int row, int col, f32x4 v0, f32x4 v1) const {
        GAS v4u* p = (GAS v4u*)(GL + (size_t)row * D + col); f32x4 g0, g1, t0, t1; unpack8(*p, g0, g1); unpack8(*(const GAS v4u*)(TMP + (size_t)row * D + col), t0, t1);
        *p = pack8(t0 + g0 * v0, t1 + g1 * v1);
    } };
struct EpiP5 { const float* X; const float* MOD; float* X1;
    __device__ __forceinline__ void store8(int row, int col, f32x4 v0, f32x4 v1) const {
        const int b = row >> 11; const float* gp = MOD + b * 6144 + 2048 + col; const float* xp = X + (size_t)row * D + col;
        const f32x4 g0 = *(const GAS f32x4*)gp, g1 = *(const GAS f32x4*)(gp + 4), x0 = *(const GAS f32x4*)xp, x1 = *(const GAS f32x4*)(xp + 4);
        GAS f32x4* o = (GAS f32x4*)(X1 + (size_t)row * D + col);
        o[0] = x0 + (g0 + 1.0f) * v0; o[1] = x1 + (g1 + 1.0f) * v1;
    } };
struct EpiMoeA { bf16* HB;
    __device__ __forceinline__ void store8(int row, int col, f32x4 v0, f32x4 v1) const {
        f32x4 r;
#pragma unroll
        for (int j = 0; j < 4; ++j) r[j] = v0[j] * sigmoid_f(v0[j]) * v1[j];
        v2u w; w.x = pk2(r[0], r[1]); w.y = pk2(r[2], r[3]);
        *(GAS v2u*)(HB + (size_t)row * DE + (col >> 1)) = w;
    } };
struct EpiMoeB { bf16* Y;
    __device__ __forceinline__ void store8(int row, int col, f32x4 v0, f32x4 v1) const { *(GAS v4u*)(Y + (size_t)row * D + col) = pack8(v0, v1); } };

#define XB_TMO      128
#define XB_XCNT(j)  (256  + 64 * (j))
#define XB_XSUB(j)  (1280 + 64 * (j))
#define XB_XGEN(j)  (2304 + 64 * (j))
#define XB_TOP      3328
#define XB_TOPGEN   3392
#define XCD_BAR_WORDS 3456
#define XB_SPIN_CAP (1u << 20)
__device__ __forceinline__ unsigned xb_ld(unsigned* p)              { return __hip_atomic_load(p, __ATOMIC_RELAXED, __HIP_MEMORY_SCOPE_AGENT); }
__device__ __forceinline__ unsigned xb_add(unsigned* p, unsigned v) { return __hip_atomic_fetch_add(p, v, __ATOMIC_RELAXED, __HIP_MEMORY_SCOPE_AGENT); }
__device__ __forceinline__ unsigned xb_xcc_id() { return (unsigned)__builtin_amdgcn_s_getreg((3 << 11) | 20) & 0xFu; }
#define XB_SPIN(cond, bar) do { unsigned _sp = 0; while (cond) { __builtin_amdgcn_s_sleep(1); \
    if ((++_sp & 255u) == 0u) { if (xb_ld(&(bar)[XB_TMO])) break; if (_sp > XB_SPIN_CAP) { atomicAdd(&(bar)[XB_TMO], 1u); break; } } } } while (0)
struct XcdBarrier { unsigned* bar; unsigned x; volatile LAS unsigned* st; };
__device__ __forceinline__ XcdBarrier xcd_barrier_post(unsigned* bar, volatile LAS unsigned* st) {
    XcdBarrier b; b.bar = bar; b.x = xb_xcc_id(); b.st = st;
    if (threadIdx.x == 0) (void)xb_add(&bar[XB_XCNT(b.x)], 1u);
    return b;
}
__device__ __forceinline__ void xcd_barrier_complete(unsigned* bar, unsigned x, unsigned& nloc, unsigned& nx) {
    const unsigned G = gridDim.x * gridDim.y * gridDim.z;
    unsigned sum, cnt, mine, sp = 0u;
    for (;;) {
        sum = 0u; cnt = 0u; mine = 0u;
#pragma unroll
        for (unsigned j = 0; j < 16; ++j) { const unsigned c = xb_ld(&bar[XB_XCNT(j)]); sum += c; cnt += (c > 0u) ? 1u : 0u; mine = (j == x) ? c : mine; }
        if (sum == G) break;
        __builtin_amdgcn_s_sleep(1);
        if ((++sp & 255u) == 0u) { if (xb_ld(&bar[XB_TMO])) break; if (sp > XB_SPIN_CAP) { atomicAdd(&bar[XB_TMO], 1u); break; } }
    }
    nloc = mine > 0u ? mine : 1u; nx = cnt > 0u ? cnt : 1u;
}
__device__ __forceinline__ void xcd_barrier(const XcdBarrier& b) {
    asm volatile("s_waitcnt vmcnt(0)" ::: "memory");
    __syncthreads();
    if (threadIdx.x == 0) {
        unsigned* bar = b.bar;
        __builtin_amdgcn_s_waitcnt(0);
        unsigned nloc = b.st[0], nx = b.st[1];
        if (nloc == 0u) { xcd_barrier_complete(bar, b.x, nloc, nx); b.st[0] = nloc; b.st[1] = nx; }
        const unsigned old = xb_add(&bar[XB_XSUB(b.x)], 1u);
        const unsigned gen = old / nloc;
        if (old + 1u == (gen + 1u) * nloc) {
            __builtin_amdgcn_fence(__ATOMIC_RELEASE, "agent");
            asm volatile("s_waitcnt vmcnt(0)" ::: "memory");
            const unsigned og = xb_add(&bar[XB_TOP], 1u);
            const unsigned tg = og / nx;
            if (og + 1u == (tg + 1u) * nx) xb_add(&bar[XB_TOPGEN], 1u);
            else XB_SPIN(xb_ld(&bar[XB_TOPGEN]) == tg, bar);
            __builtin_amdgcn_fence(__ATOMIC_ACQUIRE, "agent");
            xb_add(&bar[XB_XGEN(b.x)], 1u);
            asm volatile("s_waitcnt vmcnt(0)" ::: "memory");
        } else {
            XB_SPIN(xb_ld(&bar[XB_XGEN(b.x)]) == gen, bar);
            __builtin_amdgcn_fence(__ATOMIC_ACQUIRE, "agent");
            asm volatile("s_waitcnt vmcnt(0)" ::: "memory");
        }
    }
    __syncthreads();
}

struct Args { const float* in[25]; float* out; unsigned char* ws; int ph_lo, ph_hi; };
struct Frame {
    LAS unsigned char* lds; volatile LAS unsigned* MISC; gu32* ctl;
    int tid, lane, wave, vcu, G;
};

__device__ __forceinline__ void p0_transpose_item(const float* W, int K, int N, bf16* WT, int row_off, int mode, LAS float* scr, int item, int lane) {
    const int nblk = N / 32, kb = item / nblk, nb = item % nblk, k0 = 64 * kb, n0 = 32 * nb;
#pragma unroll 8
    for (int i = 0; i < 32; ++i) { const int kk = 2 * i + (lane >> 5); scr[kk * 33 + (lane & 31)] = W[(size_t)(k0 + kk) * N + n0 + (lane & 31)]; }
    LDS_WAIT(); asm volatile("" ::: "memory");
    const int c = lane & 7;
#pragma unroll
    for (int j = 0; j < 4; ++j) { const int n = (lane >> 3) + 8 * j; const LAS float* s = scr + (8 * c) * 33 + n;
        v4u o; o.x = pk2(s[0 * 33], s[1 * 33]); o.y = pk2(s[2 * 33], s[3 * 33]); o.z = pk2(s[4 * 33], s[5 * 33]); o.w = pk2(s[6 * 33], s[7 * 33]);
        const int nn = n0 + n; const int r = mode == 0 ? row_off + nn : row_off + 8 * (nn >> 2) + (nn & 3) + (mode == 2 ? 4 : 0);
        *(GAS v4u*)(WT + (size_t)r * K + k0 + 8 * c) = o; }
    LDS_WAIT(); asm volatile("" ::: "memory");
}
__device__ __forceinline__ void p0_prologue(Frame& F, const Args& a) {
    unsigned char* ws = a.ws;
    LAS float* scr = (LAS float*)(F.lds + F.wave * 16384);
    const int gw = F.vcu * NWAVES + F.wave, NGW = F.G * NWAVES;
    constexpr int I_IN = (D / 64) * (IN_COLS / 32), I_AO = (AOW / 64) * (D / 32), I_LO = (D / 64) * (D / 32), I_OUT = I_LO, I_E = 256;
    constexpr int NDENSE = I_IN + I_AO + I_LO + I_OUT, NITEMS = NDENSE + 3 * NE * I_E;
    for (int it = gw; it < NITEMS; it += NGW) {
        int r = it;
        if (r < I_IN) { p0_transpose_item(a.in[5], D, IN_COLS, (bf16*)(ws + WS_WIN_T), 0, 0, scr, r, F.lane); continue; } r -= I_IN;
        if (r < I_AO) { p0_transpose_item(a.in[13], AOW, D, (bf16*)(ws + WS_WAO_T), 0, 0, scr, r, F.lane); continue; } r -= I_AO;
        if (r < I_LO) { p0_transpose_item(a.in[14], D, D, (bf16*)(ws + WS_WLO_T), 0, 0, scr, r, F.lane); continue; } r -= I_LO;
        if (r < I_OUT) { p0_transpose_item(a.in[15], D, D, (bf16*)(ws + WS_WOUT_T), 0, 0, scr, r, F.lane); continue; } r -= I_OUT;
        const int mat = r / I_E, item = r % I_E, e = mat / 3, which = mat % 3;
        if (which == 0) p0_transpose_item(a.in[21] + (size_t)e * D * DE, D, DE, (bf16*)(ws + WS_W13_T), e * 1024, 1, scr, item, F.lane);
        else if (which == 1) p0_transpose_item(a.in[22] + (size_t)e * D * DE, D, DE, (bf16*)(ws + WS_W13_T), e * 1024, 2, scr, item, F.lane);
        else p0_transpose_item(a.in[23] + (size_t)e * DE * D, DE, D, (bf16*)(ws + WS_W2_T), e * 1024, 0, scr, item, F.lane);
    }
    if (F.vcu < 192) {
        __syncthreads();
        const float* c = a.in[1]; const float* wm = a.in[2]; const float* bm = a.in[3]; float* MOD = (float*)(ws + WS_MOD);
        LAS float* CA = (LAS float*)F.lds;
        LAS float* PART = (LAS float*)(F.lds + 65536);
        for (int i = F.tid; i < NB * D; i += NTHREADS) { const float v = c[i]; CA[i] = v * sigmoid_f(v); }
        __syncthreads();
        const int kq = F.tid >> 5, col = F.tid & 31, n = F.vcu * 32 + col;
        float acc[NB];
#pragma unroll
        for (int b = 0; b < NB; ++b) acc[b] = 0.f;
#pragma unroll 4
        for (int i = 0; i < 64; ++i) { const int k = kq + 16 * i; const float w = wm[(size_t)k * 6144 + n];
#pragma unroll
            for (int b = 0; b < NB; ++b) acc[b] += CA[b * D + k] * w; }
#pragma unroll
        for (int b = 0; b < NB; ++b) PART[(kq * NB + b) * 32 + col] = acc[b];
        __syncthreads();
        { const int b = F.tid >> 5; float sum = bm[n];
#pragma unroll
            for (int q = 0; q < 16; ++q) sum += PART[(q * NB + b) * 32 + col];
            MOD[b * 6144 + n] = sum; }
        __syncthreads();
    }
}
__device__ __forceinline__ void norm_mod_row(const float* xrow, const float* g, const float* shift, const float* scale, int lane, f32x4 (&h)[4]) {
    const GAS f32x4* xr = (const GAS f32x4*)xrow + lane; float ss = 0.f;
#pragma unroll
    for (int j = 0; j < 4; ++j) { h[j] = xr[64 * j]; ss += (h[j].x * h[j].x + h[j].y * h[j].y) + (h[j].z * h[j].z + h[j].w * h[j].w); }
    const float rstd = 1.0f / sqrtf(wave_sum(ss) * (1.0f / D) + EPS);
#pragma unroll
    for (int j = 0; j < 4; ++j) { const f32x4 gg = ((const GAS f32x4*)g + lane)[64 * j], sc = ((const GAS f32x4*)scale + lane)[64 * j], sf = ((const GAS f32x4*)shift + lane)[64 * j];
        h[j] = h[j] * rstd * gg * (sc + 1.0f) + sf; }
}
__device__ __forceinline__ void store_row_bf16(bf16* orow, int lane, const f32x4 (&h)[4]) {
    GAS v2u* o8 = (GAS v2u*)orow + lane;
#pragma unroll
    for (int j = 0; j < 4; ++j) { v2u w; w.x = pk2(h[j].x, h[j].y); w.y = pk2(h[j].z, h[j].w); o8[64 * j] = w; }
}
__device__ __forceinline__ void p1_norm1(Frame& F, const Args& a) {
    const int gw = F.vcu * NWAVES + F.wave, NGW = F.G * NWAVES;
    const float* MOD = (const float*)(a.ws + WS_MOD); bf16* H = (bf16*)(a.ws + WS_H);
    for (int m = gw; m < T; m += NGW) { const int b = m >> 11; f32x4 h[4];
        norm_mod_row(a.in[0] + (size_t)m * D, a.in[4], MOD + b * 6144, MOD + b * 6144 + 1024, F.lane, h);
        store_row_bf16(H + (size_t)m * D, F.lane, h); }
}
typedef float f32x16 __attribute__((ext_vector_type(16)));
typedef short v4i16_t __attribute__((ext_vector_type(4)));
__device__ __forceinline__ void attn_tile(const bf16x8 (&Kf)[4], const bf16x8 (&Qf)[4], LAS unsigned char* vl, unsigned trbase, int r, int hi, bool causal, bool lower, f32x16 (&O)[2], float& m, float& l) {
    f32x16 sc;
#pragma unroll
    for (int i = 0; i < 16; ++i) sc[i] = 0.f;
#pragma unroll
    for (int kk = 0; kk < 4; ++kk) sc = __builtin_amdgcn_mfma_f32_32x32x16_bf16(Kf[kk], Qf[kk], sc, 0, 0, 0);
    if (causal) {
#pragma unroll
        for (int i = 0; i < 16; ++i) { const int key = 8 * (i >> 2) + 4 * hi + (i & 3); sc[i] = key > r ? -1e30f : sc[i]; } }
    if (lower) {
#pragma unroll
        for (int i = 0; i < 16; ++i) { const int key = 8 * (i >> 2) + 4 * hi + (i & 3); sc[i] = key < r ? -1e30f : sc[i]; } }
    float mx = sc[0];
#pragma unroll
    for (int i = 1; i < 16; ++i) mx = fmaxf(mx, sc[i]);
    mx = fmaxf(mx, __shfl_xor(mx, 32));
    const float mn = fmaxf(m, mx), al = __builtin_amdgcn_exp2f(m - mn); m = mn;
    float ps = 0.f;
#pragma unroll
    for (int i = 0; i < 16; ++i) { sc[i] = __builtin_amdgcn_exp2f(sc[i] - mn); ps += sc[i]; }
    l = l * al + ps;
#pragma unroll
    for (int dt = 0; dt < 2; ++dt)
#pragma unroll
        for (int i = 0; i < 16; ++i) O[dt][i] *= al;
    bf16x8 Pf[2];
#pragma unroll
    for (int st = 0; st < 2; ++st) { v4u w; w.x = pk2(sc[8 * st], sc[8 * st + 1]); w.y = pk2(sc[8 * st + 2], sc[8 * st + 3]); w.z = pk2(sc[8 * st + 4], sc[8 * st + 5]); w.w = pk2(sc[8 * st + 6], sc[8 * st + 7]);
        Pf[st] = __builtin_bit_cast(bf16x8, w); }
#pragma unroll
    for (int st = 0; st < 2; ++st)
#pragma unroll
        for (int dt = 0; dt < 2; ++dt) {
            const v4i16_t lo = __builtin_amdgcn_ds_read_tr16_b64_v4i16((LAS v4i16_t*)(vl + dt * 2048 + st * 1024 + trbase));
            const v4i16_t hh = __builtin_amdgcn_ds_read_tr16_b64_v4i16((LAS v4i16_t*)(vl + dt * 2048 + st * 1024 + 512 + trbase));
            bf16x8 Vf; Vf[0] = lo[0]; Vf[1] = lo[1]; Vf[2] = lo[2]; Vf[3] = lo[3]; Vf[4] = hh[0]; Vf[5] = hh[1]; Vf[6] = hh[2]; Vf[7] = hh[3];
            O[dt] = __builtin_amdgcn_mfma_f32_32x32x16_bf16(Vf, Pf[st], O[dt], 0, 0, 0); }
}
__device__ __forceinline__ void attn_q64(const bf16* Qs, const bf16* Ks, const bf16* Vs, int i0, LAS unsigned char* vl, int lane, f32x16 (&OA)[2], float& lseA, f32x16 (&OB)[2], float& lseB) {
    const int r = lane & 31, hi = lane >> 5;
    const int ktA = i0 >> 5, kt0 = ktA - 4 < 0 ? 0 : ktA - 4, ktl = ktA + 1;
    const int koff = r * HD + 8 * hi, voff = (lane >> 3) * HD + 8 * (lane & 7);
    const unsigned vlw = (unsigned)(((lane & 7) >> 2) * 2048 + (lane >> 3) * 64 + (lane & 3) * 16);
    v4u Kn[4], Vn[4];
#pragma unroll
    for (int kk = 0; kk < 4; ++kk) Kn[kk] = *(const GAS v4u*)(Ks + (size_t)(32 * kt0) * HD + koff + 16 * kk);
#pragma unroll
    for (int c4 = 0; c4 < 4; ++c4) Vn[c4] = *(const GAS v4u*)(Vs + (size_t)(32 * kt0 + 8 * c4) * HD + voff);
    bf16x8 QA[4], QB[4];
#pragma unroll
    for (int kk = 0; kk < 4; ++kk) { QA[kk] = __builtin_bit_cast(bf16x8, *(const GAS v4u*)(Qs + (size_t)(i0 + r) * HD + 16 * kk + 8 * hi));
        QB[kk] = __builtin_bit_cast(bf16x8, *(const GAS v4u*)(Qs + (size_t)(i0 + 32 + r) * HD + 16 * kk + 8 * hi)); }
#pragma unroll
    for (int dt = 0; dt < 2; ++dt)
#pragma unroll
        for (int i = 0; i < 16; ++i) { OA[dt][i] = 0.f; OB[dt][i] = 0.f; }
    float mA = -1e30f, lA = 0.f, mB = -1e30f, lB = 0.f;
    const unsigned trbase = (unsigned)((4 * hi + ((lane & 15) >> 2)) * 64 + (16 * ((lane >> 4) & 1) + 4 * (lane & 3)) * 2);
    for (int kt = kt0; kt <= ktl; ++kt) {
        bf16x8 Kf[4];
#pragma unroll
        for (int kk = 0; kk < 4; ++kk) Kf[kk] = __builtin_bit_cast(bf16x8, Kn[kk]);
#pragma unroll
        for (int c4 = 0; c4 < 4; ++c4) *(LAS v4u*)(vl + vlw + c4 * 512) = Vn[c4];
        if (kt < ktl) {
#pragma unroll
            for (int kk = 0; kk < 4; ++kk) Kn[kk] = *(const GAS v4u*)(Ks + (size_t)(32 * (kt + 1)) * HD + koff + 16 * kk);
#pragma unroll
            for (int c4 = 0; c4 < 4; ++c4) Vn[c4] = *(const GAS v4u*)(Vs + (size_t)(32 * (kt + 1) + 8 * c4) * HD + voff);
        }
        if (kt <= ktA) attn_tile(Kf, QA, vl, trbase, r, hi, kt == ktA, kt == ktA - 4, OA, mA, lA);
        if (kt >= ktA - 3) attn_tile(Kf, QB, vl, trbase, r, hi, kt == ktA + 1, kt == ktA - 3, OB, mB, lB);
    }
    { const float lt = lA + __shfl_xor(lA, 32), inv = fast_rcp(lt); lseA = mA + __builtin_amdgcn_logf(lt);
#pragma unroll
      for (int dt = 0; dt < 2; ++dt)
#pragma unroll
          for (int i = 0; i < 16; ++i) OA[dt][i] *= inv; }
    { const float lt = lB + __shfl_xor(lB, 32), inv = fast_rcp(lt); lseB = mB + __builtin_amdgcn_logf(lt);
#pragma unroll
      for (int dt = 0; dt < 2; ++dt)
#pragma unroll
          for (int i = 0; i < 16; ++i) OB[dt][i] *= inv; }
}
template <bool MERGE, bool LAST>
__device__ __forceinline__ void attn_store(bf16* ATT, float* LSE, int tok0, int tstride, int slot, int lane, LAS unsigned char* ost, f32x16 (&O)[2], float lse2) {
    const int r = lane & 31, hi = lane >> 5, rrow = lane >> 3, chunk = lane & 7;
    LAS unsigned char* mine = ost + r * 144 + 8 * hi;
    if (MERGE) {
#pragma unroll
        for (int it = 0; it < 4; ++it) { const int row = it * 8 + rrow;
            *(LAS v4u*)(ost + row * 144 + chunk * 16) = *(const GAS v4u*)(ATT + (size_t)(tok0 + row * tstride) * AOW + slot * HD + chunk * 8); }
        const float lp = LSE[(tok0 + r * tstride) * NSLOT + slot], M = fmaxf(lse2, lp), wa = __builtin_amdgcn_exp2f(lse2 - M), wb = __builtin_amdgcn_exp2f(lp - M), inv = fast_rcp(wa + wb), ca = wa * inv, cb = wb * inv;
        lse2 = M + __builtin_amdgcn_logf(wa + wb);
#pragma unroll
        for (int dt = 0; dt < 2; ++dt)
#pragma unroll
            for (int g = 0; g < 4; ++g) { const v2u w = *(const LAS v2u*)(mine + 64 * dt + 16 * g);
                O[dt][4 * g] = ca * O[dt][4 * g] + cb * bf_lo(w.x); O[dt][4 * g + 1] = ca * O[dt][4 * g + 1] + cb * bf_hi(w.x);
                O[dt][4 * g + 2] = ca * O[dt][4 * g + 2] + cb * bf_lo(w.y); O[dt][4 * g + 3] = ca * O[dt][4 * g + 3] + cb * bf_hi(w.y); }
    }
#pragma unroll
    for (int dt = 0; dt < 2; ++dt)
#pragma unroll
        for (int g = 0; g < 4; ++g) { v2u w; w.x = pk2(O[dt][4 * g], O[dt][4 * g + 1]); w.y = pk2(O[dt][4 * g + 2], O[dt][4 * g + 3]); *(LAS v2u*)(mine + 64 * dt + 16 * g) = w; }
#pragma unroll
    for (int it = 0; it < 4; ++it) { const int row = it * 8 + rrow;
        *(GAS v4u*)(ATT + (size_t)(tok0 + row * tstride) * AOW + slot * HD + chunk * 8) = *(const LAS v4u*)(ost + row * 144 + chunk * 16); }
    if (!LAST && hi == 0) LSE[(tok0 + r * tstride) * NSLOT + slot] = lse2;
}
__device__ __forceinline__ void p3_attention(Frame& F, const Args& a) {
    const bf16* QKV = (const bf16*)(a.ws + WS_QKV); bf16* ATT = (bf16*)a.out; float* LSE = (float*)(a.ws + WS_LSE);
    int lane = F.lane; asm volatile("" : "+v"(lane));
    const int w = F.wave;
    LAS unsigned char* vl = F.lds + w * 8960; LAS unsigned char* ost = vl + 4096;
    const size_t WSTR = (size_t)NB * NHEAD * S * HD;
    for (int item = F.vcu; item < NB * NSLOT * 2; item += F.G) {
        const int c = item & 1, slot = (item >> 1) & 7, b = item >> 4;
#pragma unroll 1
        for (int t = 0; t < 2; ++t) { int ln = lane; asm volatile("" : "+v"(ln) :: "memory"); const int ph = 2 * w + t, i0 = 64 * c; const bf16* Qs = QKV + (((size_t)b * NHEAD + 16 + slot) * S + ph * 128) * HD;
            f32x16 OA[2], OB[2]; float la, lb; attn_q64(Qs, Qs + WSTR, Qs + 2 * WSTR, i0, vl, ln, OA, la, OB, lb);
            attn_store<false, false>(ATT, LSE, b * S + i0 * 16 + ph, 16, slot, ln, ost, OA, la);
            attn_store<false, false>(ATT, LSE, b * S + (i0 + 32) * 16 + ph, 16, slot, ln, ost, OB, lb); }
        VM_WAIT(); __syncthreads(); __builtin_amdgcn_fence(__ATOMIC_ACQUIRE, "agent"); VM_WAIT();
#pragma unroll 1
        for (int t = 0; t < 2; ++t) { int ln = lane; asm volatile("" : "+v"(ln) :: "memory"); const int u = 2 * w + t, ph = u >> 2, i0 = 256 * c + 64 * (u & 3); const bf16* Qs = QKV + (((size_t)b * NHEAD + 8 + slot) * S + ph * 512) * HD;
            f32x16 OA[2], OB[2]; float la, lb; attn_q64(Qs, Qs + WSTR, Qs + 2 * WSTR, i0, vl, ln, OA, la, OB, lb);
            attn_store<true, false>(ATT, LSE, b * S + i0 * 4 + ph, 4, slot, ln, ost, OA, la);
            attn_store<true, false>(ATT, LSE, b * S + (i0 + 32) * 4 + ph, 4, slot, ln, ost, OB, lb); }
        VM_WAIT(); __syncthreads(); __builtin_amdgcn_fence(__ATOMIC_ACQUIRE, "agent"); VM_WAIT();
#pragma unroll 1
        for (int t = 0; t < 2; ++t) { int ln = lane; asm volatile("" : "+v"(ln) :: "memory"); const int i0 = 1024 * c + 64 * (2 * w + t); const bf16* Qs = QKV + (((size_t)b * NHEAD + slot) * S) * HD;
            f32x16 OA[2], OB[2]; float la, lb; attn_q64(Qs, Qs + WSTR, Qs + 2 * WSTR, i0, vl, ln, OA, la, OB, lb);
            attn_store<true, true>(ATT, LSE, b * S + i0, 1, slot, ln, ost, OA, la);
            attn_store<true, true>(ATT, LSE, b * S + i0 + 32, 1, slot, ln, ost, OB, lb); }
    }
    VM_WAIT(); __syncthreads();
}
__device__ __forceinline__ void p5_lru(Frame& F, const Args& a) {
    const bf16* XR = (const bf16*)(a.ws + WS_XR); const bf16* YR = (const bf16*)(a.ws + WS_YR); bf16* LRU = (bf16*)(a.ws + WS_LRU);
    LAS v4u* BF = (LAS v4u*)(F.lds);
    LAS float* CW = (LAS float*)(F.lds + 24576);
    LAS float* CARRY = (LAS float*)(F.lds + 24576 + 2048);
    volatile LAS int* FLAG = (volatile LAS int*)(F.lds + 24576 + 2048 + 65 * 256);
    int lane = F.lane; asm volatile("" : "+v"(lane));
    const int r = lane & 31, hi = lane >> 5, w = F.wave;
    const float LOG2E = 1.4426950408889634f;
    for (int item = F.vcu; item < NB * 16; item += F.G) {
        const int b = item >> 4, cb = item & 15;
        __syncthreads();
        for (int idx = F.tid; idx < 3 * 8 * 64; idx += NTHREADS) { const int l = idx & 63, f = idx >> 6, nt = f & 1, kk = (f >> 1) & 3, mat = f >> 3, rr = l & 31, hh = l >> 5, n = rr + 32 * nt;
            unsigned v[4];
#pragma unroll
            for (int jj = 0; jj < 4; ++jj) { float e[2];
#pragma unroll
                for (int q = 0; q < 2; ++q) { const int k = 16 * kk + 8 * hh + 2 * jj + q;
                    e[q] = mat == 0 ? a.in[8][(size_t)(cb * 64 + k) * 64 + n] : mat == 1 ? a.in[10][(size_t)(cb * 64 + k) * 64 + n] : (k == n ? 1.0f : 0.0f); }
                v[jj] = pk2(e[0], e[1]); }
            v4u o; o.x = v[0]; o.y = v[1]; o.z = v[2]; o.w = v[3]; BF[idx] = o; }
        for (int idx = F.tid; idx < 5 * 64; idx += NTHREADS) CW[idx] = idx < 256 ? a.in[6][(idx >> 6) * D + cb * 64 + (idx & 63)] : a.in[7][cb * 64 + (idx & 63)];
        if (F.tid < 65) FLAG[F.tid] = F.tid == 0 ? 1 : 0;
        if (F.tid < 64) CARRY[F.tid] = 0.f;
        __syncthreads();
        float bxv[2], bav[2], cav[2];
#pragma unroll
        for (int nt = 0; nt < 2; ++nt) { const int c = cb * 64 + r + 32 * nt; bxv[nt] = a.in[9][c]; bav[nt] = a.in[11][c]; cav[nt] = -8.0f * log1pf(__expf(-a.in[12][c])) * LOG2E; }
        for (int j = w; j < 64; j += 8) {
            const int t0 = 32 * j;
            bf16x8 Af[4];
#pragma unroll
            for (int kk = 0; kk < 4; ++kk) { const int c0 = 16 * kk + 8 * hi;
                f32x4 s0 = *(const LAS f32x4*)(CW + 256 + c0), s1 = *(const LAS f32x4*)(CW + 256 + c0 + 4);
#pragma unroll
                for (int d = 0; d < 4; ++d) { const int tok = t0 + r - d; const bool ok = tok >= 0;
                    const v4u x = *(const GAS v4u*)(XR + (size_t)(b * S + (ok ? tok : 0)) * D + cb * 64 + c0);
                    f32x4 x0, x1; unpack8(x, x0, x1); if (!ok) { x0 = x0 * 0.f; x1 = x1 * 0.f; }
                    const f32x4 w0 = *(const LAS f32x4*)(CW + (3 - d) * 64 + c0), w1 = *(const LAS f32x4*)(CW + (3 - d) * 64 + c0 + 4);
                    s0 = s0 + w0 * x0; s1 = s1 + w1 * x1; }
                Af[kk] = __builtin_bit_cast(bf16x8, pack8(s0, s1)); }
            f32x16 ci[2], cr[2], cx[2];
#pragma unroll
            for (int nt = 0; nt < 2; ++nt) {
#pragma unroll
                for (int i = 0; i < 16; ++i) { ci[nt][i] = 0.f; cr[nt][i] = 0.f; cx[nt][i] = 0.f; } }
#pragma unroll
            for (int kk = 0; kk < 4; ++kk)
#pragma unroll
                for (int nt = 0; nt < 2; ++nt) {
                    ci[nt] = __builtin_amdgcn_mfma_f32_32x32x16_bf16(Af[kk], __builtin_bit_cast(bf16x8, BF[((0 * 4 + kk) * 2 + nt) * 64 + lane]), ci[nt], 0, 0, 0);
                    cr[nt] = __builtin_amdgcn_mfma_f32_32x32x16_bf16(Af[kk], __builtin_bit_cast(bf16x8, BF[((1 * 4 + kk) * 2 + nt) * 64 + lane]), cr[nt], 0, 0, 0);
                    cx[nt] = __builtin_amdgcn_mfma_f32_32x32x16_bf16(Af[kk], __builtin_bit_cast(bf16x8, BF[((2 * 4 + kk) * 2 + nt) * 64 + lane]), cx[nt], 0, 0, 0); }
            unsigned short yv[2][16];
#pragma unroll
            for (int nt = 0; nt < 2; ++nt)
#pragma unroll
                for (int i = 0; i < 16; ++i) yv[nt][i] = YR[(size_t)(b * S + t0 + 8 * (i >> 2) + 4 * hi + (i & 3)) * D + cb * 64 + r + 32 * nt];
#pragma unroll
            for (int nt = 0; nt < 2; ++nt)
#pragma unroll
                for (int i = 0; i < 16; ++i) {
                    const float gi = fast_rcp(1.0f + __builtin_amdgcn_exp2f(-(ci[nt][i] + bxv[nt]) * LOG2E)), gr = fast_rcp(1.0f + __builtin_amdgcn_exp2f(-(cr[nt][i] + bav[nt]) * LOG2E));
                    const float av = __builtin_amdgcn_exp2f(cav[nt] * gr), mult = __builtin_amdgcn_sqrtf(fmaxf(0.f, 1.0f - av * av));
                    cr[nt][i] = av; ci[nt][i] = mult * gi * cx[nt][i]; }
            float A1[2][4], B1[2][4], A2[2][4], B2[2][4], SA[2], SB[2];
#pragma unroll
            for (int nt = 0; nt < 2; ++nt) { SA[nt] = 1.f; SB[nt] = 0.f;
#pragma unroll
                for (int g = 0; g < 4; ++g) { const int i0 = 4 * g;
                    const float ga = (cr[nt][i0] * cr[nt][i0 + 1]) * (cr[nt][i0 + 2] * cr[nt][i0 + 3]);
                    const float gb = ((ci[nt][i0] * cr[nt][i0 + 1] + ci[nt][i0 + 1]) * cr[nt][i0 + 2] + ci[nt][i0 + 2]) * cr[nt][i0 + 3] + ci[nt][i0 + 3];
                    const float pa = __shfl_xor(ga, 32), pb = __shfl_xor(gb, 32);
                    A1[nt][g] = hi ? pa : ga; B1[nt][g] = hi ? pb : gb; A2[nt][g] = hi ? ga : pa; B2[nt][g] = hi ? gb : pb;
                    SB[nt] = A1[nt][g] * SB[nt] + B1[nt][g]; SA[nt] = A1[nt][g] * SA[nt];
                    SB[nt] = A2[nt][g] * SB[nt] + B2[nt][g]; SA[nt] = A2[nt][g] * SA[nt]; } }
            if (j > 0) { while (FLAG[j] == 0) __builtin_amdgcn_s_sleep(1); }
            asm volatile("" ::: "memory");
            float h[2];
#pragma unroll
            for (int nt = 0; nt < 2; ++nt) { h[nt] = CARRY[j * 64 + r + 32 * nt]; if (hi == 0) CARRY[(j + 1) * 64 + r + 32 * nt] = SA[nt] * h[nt] + SB[nt]; }
            asm volatile("s_waitcnt lgkmcnt(0)" ::: "memory");
            if (lane == 0) FLAG[j + 1] = 1;
#pragma unroll
            for (int nt = 0; nt < 2; ++nt)
#pragma unroll
                for (int g = 0; g < 4; ++g) { const float h1 = A1[nt][g] * h[nt] + B1[nt][g]; float hh = hi ? h1 : h[nt]; h[nt] = A2[nt][g] * h1 + B2[nt][g];
#pragma unroll
                    for (int q = 0; q < 4; ++q) { const int i = 4 * g + q; hh = cr[nt][i] * hh + ci[nt][i];
                        LRU[(size_t)(b * S + t0 + 8 * g + 4 * hi + q) * D + cb * 64 + r + 32 * nt] = (bf16)f2bf(hh * bf2f(yv[nt][i])); } }
        }
    }
    __syncthreads();
}
__device__ __forceinline__ void p10_router(Frame& F, const Args& a) {
    LAS float* WT = (LAS float*)F.lds;
    for (int i = F.tid; i < 36 * D; i += NTHREADS) { const int o = i >> 10, k = i & 1023; WT[i] = o < 4 ? a.in[17][k * 4 + o] : a.in[19][k * 32 + (o - 4)]; }
    __syncthreads();
    const int gw = F.vcu * NWAVES + F.wave, NGW = F.G * NWAVES, lane = F.lane;
    const float* MOD = (const float*)(a.ws + WS_MOD); bf16* H2 = (bf16*)(a.ws + WS_H); const float* X1 = a.out;
    int* TOKE = (int*)(a.ws + WS_TOKE); int* TOKR = (int*)(a.ws + WS_TOKR); float* TOKW = (float*)(a.ws + WS_TOKW);
    for (int m = gw; m < T; m += NGW) { const int b = m >> 11; f32x4 h[4];
        norm_mod_row(X1 + (size_t)m * D, a.in[16], MOD + b * 6144 + 3072, MOD + b * 6144 + 4096, lane, h);
        store_row_bf16(H2 + (size_t)m * D, lane, h);
        float lg[36];
#pragma unroll
        for (int o = 0; o < 36; ++o) { float p = 0.f;
#pragma unroll
            for (int j = 0; j < 4; ++j) { const f32x4 w = *(const LAS f32x4*)(WT + o * D + 256 * j + 4 * lane); p += (h[j].x * w.x + h[j].y * w.y) + (h[j].z * w.z + h[j].w * w.w); }
            lg[o] = wave_sum(p);
            if ((o & 3) == 3) asm volatile("" ::: "memory"); }
        float gl[4];
#pragma unroll
        for (int o = 0; o < 4; ++o) gl[o] = lg[o] + a.in[18][o];
        int gi = 0; float gm = gl[0];
#pragma unroll
        for (int o = 1; o < 4; ++o) if (gl[o] > gm) { gm = gl[o]; gi = o; }
        float den = 0.f;
#pragma unroll
        for (int o = 0; o < 4; ++o) den += __expf(gl[o] - gm);
        const float ggate = 1.0f / den;
        float el[8];
#pragma unroll
        for (int j = 0; j < 8; ++j) { float v = lg[4 + j];
#pragma unroll
            for (int gg = 1; gg < 4; ++gg) v = (gi == gg) ? lg[4 + gg * 8 + j] : v;
            el[j] = v + a.in[20][gi * 8 + j]; }
        int i1 = 0; float v1 = el[0];
#pragma unroll
        for (int j = 1; j < 8; ++j) if (el[j] > v1) { v1 = el[j]; i1 = j; }
        int i2 = -1; float v2 = -INFINITY;
#pragma unroll
        for (int j = 0; j < 8; ++j) if (j != i1 && el[j] > v2) { v2 = el[j]; i2 = j; }
        if (i2 < 0) { i2 = (i1 + 1) & 7; v2 = v1; }
        const float e2 = __expf(v2 - v1), w1 = ggate / (1.0f + e2), w2 = ggate * e2 / (1.0f + e2);
        if (lane == 0) {
            const int e1 = gi * 8 + i1, e2i = gi * 8 + i2;
            const int r1 = (int)atomicAdd((unsigned*)(a.ws + WS_CTL) + CW_CNT + 64 * e1, 1u), r2 = (int)atomicAdd((unsigned*)(a.ws + WS_CTL) + CW_CNT + 64 * e2i, 1u);
            TOKE[2 * m] = e1; TOKE[2 * m + 1] = e2i; TOKR[2 * m] = r1; TOKR[2 * m + 1] = r2; TOKW[2 * m] = w1; TOKW[2 * m + 1] = w2;
        }
    }
    __syncthreads();
}
__device__ __forceinline__ int moe_tables(Frame& F, const Args& a, LAS int* off, LAS int* tile_e) {
    if (F.tid == 0) { int acc = 0;
        for (int e = 0; e < NE; ++e) { off[e] = acc; const int cnt = (int)__hip_atomic_load((unsigned*)(a.ws + WS_CTL) + CW_CNT + 64 * e, RLX_AGENT); const int nt = (cnt + 255) >> 8;
            for (int t = 0; t < nt; ++t) tile_e[(acc >> 8) + t] = e; acc += nt * 256; }
        off[NE] = acc; }
    __syncthreads();
    return off[NE] >> 8;
}
__device__ __forceinline__ void p11_scatter(Frame& F, const Args& a) {
    LAS int* off = (LAS int*)(F.lds + LDSX_OFF); LAS int* tile_e = off + 64;
    (void)moe_tables(F, a, off, tile_e);
    const int gw = F.vcu * NWAVES + F.wave, NGW = F.G * NWAVES, lane = F.lane;
    const bf16* H2 = (const bf16*)(a.ws + WS_H); bf16* XP = (bf16*)(a.ws + WS_XP);
    const int* TOKE = (const int*)(a.ws + WS_TOKE); const int* TOKR = (const int*)(a.ws + WS_TOKR); int* TOKS = (int*)(a.ws + WS_TOKS);
    for (int m = gw; m < T; m += NGW) {
        const v4u r0 = ((const GAS v4u*)(H2 + (size_t)m * D))[lane], r1 = ((const GAS v4u*)(H2 + (size_t)m * D))[64 + lane];
#pragma unroll
        for (int k = 0; k < 2; ++k) { const int e = TOKE[2 * m + k], slot = off[e] + TOKR[2 * m + k];
            GAS v4u* d = (GAS v4u*)(XP + (size_t)slot * D); d[lane] = r0; d[64 + lane] = r1;
            if (lane == 0) TOKS[2 * m + k] = slot; }
    }
    __syncthreads();
}
__device__ __forceinline__ void p14_final(Frame& F, const Args& a) {
    const int gw = F.vcu * NWAVES + F.wave, NGW = F.G * NWAVES, lane = F.lane;
    const float* MOD = (const float*)(a.ws + WS_MOD); const bf16* Y = (const bf16*)(a.ws + WS_Y);
    const int* TOKS = (const int*)(a.ws + WS_TOKS); const float* TOKW = (const float*)(a.ws + WS_TOKW);
    for (int m = gw; m < T; m += NGW) { const int b = m >> 11;
        const int s0 = TOKS[2 * m], s1 = TOKS[2 * m + 1]; const float w0 = TOKW[2 * m], w1 = TOKW[2 * m + 1];
        GAS f32x4* xr = (GAS f32x4*)(a.out + (size_t)m * D) + lane; f32x4 v[4]; float ss = 0.f;
#pragma unroll
        for (int j = 0; j < 4; ++j) {
            const v2u ya = ((const GAS v2u*)(Y + (size_t)s0 * D) + lane)[64 * j], yb = ((const GAS v2u*)(Y + (size_t)s1 * D) + lane)[64 * j];
            const f32x4 y0 = (f32x4){bf_lo(ya.x), bf_hi(ya.x), bf_lo(ya.y), bf_hi(ya.y)}, y1 = (f32x4){bf_lo(yb.x), bf_hi(yb.x), bf_lo(yb.y), bf_hi(yb.y)};
            const f32x4 g2 = ((const GAS f32x4*)(MOD + b * 6144 + 5120) + lane)[64 * j];
            v[j] = xr[64 * j] + (g2 + 1.0f) * (y0 * w0 + y1 * w1);
            ss += (v[j].x * v[j].x + v[j].y * v[j].y) + (v[j].z * v[j].z + v[j].w * v[j].w); }
        const float rstd = 1.0f / sqrtf(wave_sum(ss) * (1.0f / D) + EPS);
#pragma unroll
        for (int j = 0; j < 4; ++j) xr[64 * j] = v[j] * rstd * ((const GAS f32x4*)a.in[24] + lane)[64 * j];
    }
}

template <class Epi, class Sched> __device__ __forceinline__ void run_gemm(Frame& F, const pg8::Gemm& g, const Sched& S, const Epi& E) {
#if MK_SIMPLE_GEMM
    pg8::gemm_phase_simple<Epi, Sched>(g, S, E);
#else
    pg8::gemm_phase<Epi, Sched, true>(F.lds, g, S, E);
#endif
}

constexpr int NPHASES = 15;
__global__ void __launch_bounds__(NTHREADS, 2) mk_fwd(Args args) {
    extern __shared__ __attribute__((aligned(16))) unsigned char lds_raw[];
    Frame F;
    F.lds = (LAS unsigned char*)lds_raw; F.MISC = (volatile LAS unsigned*)(F.lds + MISC_OFF);
    F.tid = threadIdx.x; F.lane = F.tid & 63; F.wave = __builtin_amdgcn_readfirstlane(F.tid >> 6);
    F.G = gridDim.x; { const int bx = blockIdx.x; F.vcu = (F.G % 8 == 0) ? (bx % 8) * (F.G / 8) + bx / 8 : bx; }
    unsigned char* ws = args.ws; F.ctl = (gu32*)(ws + WS_CTL);
    if (F.tid < 64) F.MISC[F.tid] = 0u;
    __syncthreads();
    XcdBarrier bar; bar.bar = (unsigned*)(ws + WS_CTL) + CW_BAR; bar.x = 0; bar.st = nullptr;
    if (MK_N_LAUNCHES == 1) bar = xcd_barrier_post((unsigned*)(ws + WS_CTL) + CW_BAR, F.MISC + 8);
    const int lo = args.ph_lo, hi = args.ph_hi;
#ifndef PH_MASK
#define PH_MASK 0x7fff
#endif
#define IN(k) (((PH_MASK >> (k)) & 1) && lo <= (k) && (k) < hi)
#define SEAM(k) do { if (IN(k) && IN((k) + 1)) xcd_barrier(bar); } while (0)
#ifndef REP_MASK
#define REP_MASK 0
#endif
#define PHASE(k, ...) do { if (IN(k)) { __VA_ARGS__ if ((REP_MASK >> (k)) & 1) { __syncthreads(); __VA_ARGS__ } SEAM(k); } } while (0)
    const bf16* H = (const bf16*)(ws + WS_H);
    const bf16* WIN_T = (const bf16*)(ws + WS_WIN_T);

    PHASE(0, { p0_prologue(F, args);});
    PHASE(1, { p1_norm1(F, args);});
    PHASE(2, {
        pg8::Gemm g{H, WIN_T, T, 3 * AW, D, 0}; pg8::StaticOrder So; So.init(T, 3 * AW, F.G, (int)blockIdx.x);
        EpiQKV E{(bf16*)(ws + WS_QKV)}; run_gemm(F, g, So, E);});
    PHASE(3, { p3_attention(F, args);});
    PHASE(4, {
        pg8::Gemm g{H, WIN_T + (size_t)(3 * AW) * D, T, 2 * D, D, 0}; pg8::StaticOrder So; So.init(T, 2 * D, F.G, (int)blockIdx.x);
        EpiXY E{(bf16*)(ws + WS_XR), (bf16*)(ws + WS_YR)}; run_gemm(F, g, So, E);});
    PHASE(5, { p5_lru(F, args);});
    PHASE(6, {
        pg8::Gemm g{H, WIN_T + (size_t)(3 * AW + 2 * D) * D, T, 2 * D, D, 0}; pg8::StaticOrder So; So.init(T, 2 * D, F.G, (int)blockIdx.x);
        EpiGate E{(bf16*)(ws + WS_GA), (bf16*)(ws + WS_GL)}; run_gemm(F, g, So, E);});
    PHASE(7, {
        pg8::Gemm g{(const bf16*)args.out, (const bf16*)(ws + WS_WAO_T), T, D, AOW, 0}; pg8::StaticOrder So; So.init(T, D, F.G, (int)blockIdx.x);
        EpiP4a E{(bf16*)(ws + WS_GA)}; run_gemm(F, g, So, E);});
    PHASE(8, {
        pg8::Gemm g{(const bf16*)(ws + WS_LRU), (const bf16*)(ws + WS_WLO_T), T, D, D, 0}; pg8::StaticOrder So; So.init(T, D, F.G, (int)blockIdx.x);
        EpiP4b E{(const bf16*)(ws + WS_GA), (bf16*)(ws + WS_GL)}; run_gemm(F, g, So, E);});
    PHASE(9, {
        pg8::Gemm g{(const bf16*)(ws + WS_GL), (const bf16*)(ws + WS_WOUT_T), T, D, D, 0}; pg8::StaticOrder So; So.init(T, D, F.G, (int)blockIdx.x);
        EpiP5 E{args.in[0], (const float*)(ws + WS_MOD), args.out}; run_gemm(F, g, So, E);});
    PHASE(10, { p10_router(F, args);});
    PHASE(11, { p11_scatter(F, args);});
    PHASE(12, {
        LAS int* off = (LAS int*)(F.lds + LDSX_OFF); LAS int* tile_e = off + 64;
        const int ntiles = moe_tables(F, args, off, tile_e);
        pg8::Gemm g{(const bf16*)(ws + WS_XP), (const bf16*)(ws + WS_W13_T), ntiles * 256, D, D, (size_t)D * D * 2}; pg8::MoeOrder So{ntiles, F.G, F.vcu, tile_e};
        EpiMoeA E{(bf16*)(ws + WS_HB)}; run_gemm(F, g, So, E);});
    PHASE(13, {
        LAS int* off = (LAS int*)(F.lds + LDSX_OFF); LAS int* tile_e = off + 64;
        const int ntiles = moe_tables(F, args, off, tile_e);
        pg8::Gemm g{(const bf16*)(ws + WS_HB), (const bf16*)(ws + WS_W2_T), ntiles * 256, D, DE, (size_t)D * DE * 2}; pg8::MoeOrder So{ntiles, F.G, F.vcu, tile_e};
        EpiMoeB E{(bf16*)(ws + WS_Y)}; run_gemm(F, g, So, E);});
    if (IN(14)) { p14_final(F, args); }
#undef IN
#undef SEAM
}

extern "C" void kernel_launch(void* const* d_in, const int* in_sizes, int n_in, void* d_out, int out_size, void* d_ws, size_t ws_size, hipStream_t stream) {
    static int grid = 0;
    if (grid == 0) {
        if (n_in != 25 || out_size != T * D || ws_size < WS_END) { fprintf(stderr, "kernel_launch: unexpected shapes: n_in %d out %d ws %zu (need %zu)\n", n_in, out_size, ws_size, (size_t)WS_END); grid = -1; return; }
        int dev = 0, cus = 0, per_cu = 0;
        if (hipGetDevice(&dev) != hipSuccess || hipDeviceGetAttribute(&cus, hipDeviceAttributeMultiprocessorCount, dev) != hipSuccess) { grid = -1; return; }
        if (hipFuncSetAttribute((const void*)mk_fwd, hipFuncAttributeMaxDynamicSharedMemorySize, LDS_BYTES) != hipSuccess) { fprintf(stderr, "kernel_launch: hipFuncSetAttribute failed\n"); grid = -1; return; }
        if (hipOccupancyMaxActiveBlocksPerMultiprocessor(&per_cu, (const void*)mk_fwd, NTHREADS, LDS_BYTES) != hipSuccess || per_cu < 1) { fprintf(stderr, "kernel_launch: occupancy query says %d\n", per_cu); }
        (void)hipGetLastError();
        grid = cus;
    }
    if (grid < 0) return;
    if (hipMemsetAsync((char*)d_ws + WS_CTL, 0, CTL_ZERO_BYTES, stream) != hipSuccess) return;
    Args a{};
    for (int i = 0; i < 25; ++i) a.in[i] = (const float*)d_in[i];
    a.out = (float*)d_out; a.ws = (unsigned char*)d_ws;
    if (MK_N_LAUNCHES == 1) { a.ph_lo = 0; a.ph_hi = NPHASES; hipLaunchKernelGGL(mk_fwd, dim3(grid), dim3(NTHREADS), LDS_BYTES, stream, a); }
    else for (int p = 0; p < NPHASES; ++p) { a.ph_lo = p; a.ph_hi = p + 1; hipLaunchKernelGGL(mk_fwd, dim3(grid), dim3(NTHREADS), LDS_BYTES, stream, a); }
}
```

```cpp
#include <hip/hip_runtime.h>
#include <cstdio>
#include <cstdint>

#ifndef MK_N_LAUNCHES
#define MK_N_LAUNCHES 1
#endif
#ifndef MK_SIMPLE_GEMM
#define MK_SIMPLE_GEMM 0
#endif

#define GAS __attribute__((address_space(1)))
#define LAS __attribute__((address_space(3)))
typedef unsigned short bf16;
typedef unsigned v4u __attribute__((ext_vector_type(4)));
typedef unsigned v2u __attribute__((ext_vector_type(2)));
typedef float f32x4 __attribute__((ext_vector_type(4)));
typedef float f32x2 __attribute__((ext_vector_type(2)));
typedef short bf16x8 __attribute__((ext_vector_type(8)));
typedef GAS unsigned gu32;

constexpr int NB = 16, S = 2048, D = 1024, T = NB * S;
constexpr int HD = 64, NSLOT = 8, NHEAD = 24, AW = 1536, AOW = 512;
constexpr int IN_COLS = 8704, NE = 32, DE = 512, MAX_TILES = 288;
constexpr float EPS = 1e-6f, QSCALE = 0.125f * 1.4426950408889634f;
constexpr int NWAVES = 8, NTHREADS = 512;

constexpr size_t MiB = 1u << 20, KiB = 1u << 10;
constexpr size_t WS_CTL = 0, CTL_ZERO_BYTES = 1 * MiB;
constexpr size_t WS_MOD = 128 * KiB;
constexpr size_t WS_CPART_IN = 27 * MiB, WS_CPART_13 = 28 * MiB;
constexpr size_t WS_SB_IN = 29 * MiB, WS_SB_13 = 29 * MiB + 512 * KiB;
constexpr size_t WS_TOKE = 1 * MiB, WS_TOKR = WS_TOKE + 256 * KiB, WS_TOKW = WS_TOKR + 256 * KiB, WS_TOKS = WS_TOKW + 256 * KiB;
constexpr size_t WS_WIN_T = 2 * MiB;
constexpr size_t WS_WAO_T = 19 * MiB, WS_WLO_T = 20 * MiB, WS_WOUT_T = 22 * MiB;
constexpr size_t WS_LSE = 26 * MiB;
constexpr size_t WS_W13_T = 32 * MiB;
constexpr size_t WS_W2_T = 96 * MiB;
constexpr size_t WS_H = 128 * MiB;
constexpr size_t WS_SAH = WS_H + 32 * MiB;
constexpr size_t WS_SAXP = WS_H + 33 * MiB;
constexpr size_t WS_R = 192 * MiB;
constexpr size_t WS_QKV = WS_R;
constexpr size_t WS_XR = WS_R, WS_YR = WS_R + 64 * MiB, WS_GA = WS_R + 128 * MiB, WS_GL = WS_R + 192 * MiB, WS_LRU = WS_R + 256 * MiB;
constexpr size_t WS_XP = WS_R, WS_HB = WS_R + 144 * MiB, WS_Y = WS_R;
constexpr size_t WS_END = 512 * MiB;
constexpr int CW_TMO = 0, CW_CNT = 1024, CW_BAR = 4096;

constexpr int RING_BYTES = 131072;
constexpr int LDSX_OFF = RING_BYTES;
constexpr int LDS_BYTES = 155648;
constexpr int MISC_OFF = LDS_BYTES - 256;

#define LDS_WAIT() asm volatile("s_waitcnt lgkmcnt(0)" ::: "memory")
#define VM_WAIT() asm volatile("s_waitcnt vmcnt(0)" ::: "memory")
#define RLX_AGENT __ATOMIC_RELAXED, __HIP_MEMORY_SCOPE_AGENT

__device__ __forceinline__ unsigned f2bf(float f) { unsigned u = __builtin_bit_cast(unsigned, f); return (u + 0x7fffu + ((u >> 16) & 1u)) >> 16; }
__device__ __forceinline__ unsigned pk2(float lo, float hi) { unsigned r; asm("v_cvt_pk_bf16_f32 %0, %1, %2" : "=v"(r) : "v"(lo), "v"(hi)); return r; }
__device__ __forceinline__ float bf_lo(unsigned u) { return __builtin_bit_cast(float, u << 16); }
__device__ __forceinline__ float bf_hi(unsigned u) { return __builtin_bit_cast(float, u & 0xffff0000u); }
__device__ __forceinline__ float bf2f(bf16 b) { return __builtin_bit_cast(float, ((unsigned)b) << 16); }
__device__ __forceinline__ float fast_rcp(float x) { return __builtin_amdgcn_rcpf(x); }
__device__ __forceinline__ float sigmoid_f(float x) { return fast_rcp(1.0f + __expf(-x)); }
__device__ __forceinline__ float gelu_tanh_f(float v) { const float u = 0.7978845608028654f * (v + 0.044715f * v * v * v); return v * fast_rcp(1.0f + __expf(-2.0f * u)); }
__device__ __forceinline__ float wave_sum(float v) {
#pragma unroll
    for (int o = 1; o < 64; o <<= 1) v += __shfl_xor(v, o);
    return v;
}

namespace pg8 {
#define PG8_LAS __attribute__((address_space(3)))
typedef unsigned short bf16_t;
typedef unsigned u32x4 __attribute__((ext_vector_type(4)));
constexpr int BM = 256, BK = 64, HALF = 128, HTB = HALF * BK * 2, STAGE_BYTES = 8 * HTB, NXCD = 8, WGM = 8;

__host__ __device__ __forceinline__ int lds_byte(int r, int c) { const int st = (r >> 4) * 2 + (c >> 5), rr = r & 15, cc = c & 31, ob = rr * 64 + cc * 2; return st * 1024 + (ob ^ (((ob >> 9) & 1) << 5)); }
__host__ __device__ __forceinline__ void stage_rc(int b, int& R, int& C) { const int st = b / 1024, sb = b % 1024, swz = sb ^ (((sb >> 9) & 1) << 5); R = (st >> 1) * 16 + swz / 64; C = (st & 1) * 32 + (swz % 64) / 2; }
__host__ __device__ __forceinline__ int perm32(int rho) { const int n = rho >> 4, i = rho & 15; return 8 * (i >> 2) + 4 * n + (i & 3); }

struct Unit { int pm, pn, e; };
struct Gemm { const bf16_t* A; const bf16_t* Bt; int M, N, K; size_t estride; const float* sa; const float* sb; };
typedef int i32x4 __attribute__((ext_vector_type(4)));

struct StaticOrder {
    int nM, nN, nwg, G, c;
    __host__ __device__ void init(int M, int N, int G_, int c_) { nM = M / BM; nN = N / BM; nwg = nM * nN; G = G_; c = c_; }
    __host__ __device__ bool next(int i, Unit& u) const {
        const long L = (long)i * G + c; if (L >= nwg) return false;
        int wgid = (int)L; { const int q = nwg / NXCD, r = nwg % NXCD, xcd = wgid % NXCD, off = wgid / NXCD; wgid = (xcd < r ? xcd * (q + 1) : r * (q + 1) + (xcd - r) * q) + off; }
        const int nig = WGM * nN, gid = wgid / nig, fm = gid * WGM, gsz = (nM - fm) < WGM ? (nM - fm) : WGM;
        u.pm = fm + ((wgid % nig) % gsz); u.pn = (wgid % nig) / gsz; u.e = 0; return true;
    }
};
struct MoeOrder {
    int ntiles, G, vcu; const PG8_LAS int* tile_e;
    __device__ bool next(int i, Unit& u) const {
        const int L = i * G + vcu; if (L >= ntiles * 4) return false;
        u.pm = L >> 2; u.pn = L & 3; u.e = __builtin_amdgcn_readfirstlane(tile_e[u.pm]); return true;
    }
};

template <class Epi> __device__ __forceinline__ void run_epi(const Epi& E, const f32x4 (&acc)[2][2][4][2], const Unit& u, int wr, int wc, int fr, int fq, const Gemm&) {
    const int row0 = u.pm * BM + wr * 64 + fr, col0 = u.pn * BM + wc * 32 + 8 * fq;
#pragma unroll
    for (int ai = 0; ai < 2; ++ai)
#pragma unroll
        for (int m = 0; m < 4; ++m)
#pragma unroll
            for (int bj = 0; bj < 2; ++bj) E.store8(row0 + ai * HALF + m * 16, col0 + bj * HALF, acc[ai][bj][m][0], acc[ai][bj][m][1]);
}
template <class Epi> __device__ __forceinline__ void run_epi(const Epi& E, const i32x4 (&acc)[2][2][4][2], const Unit& u, int wr, int wc, int fr, int fq, const Gemm& g) {
    const int row0 = u.pm * BM + wr * 64 + fr, col0 = u.pn * BM + wc * 32 + 8 * fq;
    f32x4 cs[2][2];
#pragma unroll
    for (int bj = 0; bj < 2; ++bj)
#pragma unroll
        for (int n = 0; n < 2; ++n) cs[bj][n] = *(const __attribute__((address_space(1))) f32x4*)(g.sb + (size_t)u.e * g.N + col0 + bj * HALF + 4 * n);
#pragma unroll
    for (int ai = 0; ai < 2; ++ai)
#pragma unroll
        for (int m = 0; m < 4; ++m) { const int row = row0 + ai * HALF + m * 16; const float sr = g.sa[row];
#pragma unroll
            for (int bj = 0; bj < 2; ++bj) E.store8(row, col0 + bj * HALF, __builtin_convertvector(acc[ai][bj][m][0], f32x4) * (cs[bj][0] * sr), __builtin_convertvector(acc[ai][bj][m][1], f32x4) * (cs[bj][1] * sr)); }
}
__device__ __forceinline__ void mma16(f32x4& c, const bf16x8 b, const bf16x8 a) { c = __builtin_amdgcn_mfma_f32_16x16x32_bf16(b, a, c, 0, 0, 0); }
__device__ __forceinline__ void mma16(i32x4& c, const bf16x8 b, const bf16x8 a) { c = __builtin_amdgcn_mfma_i32_16x16x64_i8(__builtin_bit_cast(i32x4, b), __builtin_bit_cast(i32x4, a), c, 0, 0, 0); }
template <bool I8> struct AccT { typedef f32x4 type; };
template <> struct AccT<true> { typedef i32x4 type; };

template <class Epi, class Sched, bool ALIGN_EPI = true, bool I8 = false>
__device__ __forceinline__ void gemm_phase(PG8_LAS unsigned char* lds, const Gemm g, const Sched& S, const Epi& E) {
    int tid = threadIdx.x; asm volatile("" : "+v"(tid));
    const int wid = __builtin_amdgcn_readfirstlane(tid >> 6), lane = tid & 63, wr = wid >> 2, wc = wid & 3, fr = lane & 15, fq = lane >> 4;
    const int K = g.K, nt = K / BK;
    unsigned voffA[2], voffB[2];
#pragma unroll
    for (int i = 0; i < 2; ++i) { int R, C; stage_rc(tid * 16 + i * 8192, R, C); const int Rb = (R & ~31) + perm32(R & 31);
        voffA[i] = (unsigned)(R * K + C) * 2u; voffB[i] = (unsigned)(Rb * K + C) * 2u; }
    const size_t kstep = (size_t)(BK * 2);
    const size_t hstep = (size_t)HALF * K * 2;
    const size_t tstep = 2 * hstep;
    const unsigned ldsw = (unsigned)wid * 1024u;
    const int aoff = lds_byte(wr * 64 + fr, fq * 8), boff = lds_byte(wc * 32 + fr, fq * 8);
#define PG8_SA(b, h) (((b) * 2 + (h)) * HTB)
#define PG8_SB(b, h) ((4 + (b) * 2 + (h)) * HTB)
#define PG8_STAGE(bufoff, gbase, voff) do { _Pragma("unroll") for (int _i = 0; _i < 2; ++_i) \
        __builtin_amdgcn_global_load_lds((const unsigned*)((const char*)(gbase) + (voff)[_i]), (PG8_LAS unsigned*)(lds + (bufoff) + ldsw + _i * 8192), 16, 0, 0); } while (0)
#define PG8_LDA(dst, b, h) do { _Pragma("unroll") for (int m = 0; m < 4; ++m) _Pragma("unroll") for (int k = 0; k < 2; ++k) dst[m][k] = *(const PG8_LAS bf16x8*)(lds + PG8_SA(b, h) + aoff + m * 2048 + k * 1024); } while (0)
#define PG8_LDB(dst, b, h) do { _Pragma("unroll") for (int n = 0; n < 2; ++n) _Pragma("unroll") for (int k = 0; k < 2; ++k) dst[n][k] = *(const PG8_LAS bf16x8*)(lds + PG8_SB(b, h) + boff + n * 2048 + k * 1024); } while (0)
#define PG8_MMA(ai, bj, At, Bt) do { __builtin_amdgcn_s_setprio(1); _Pragma("unroll") for (int m = 0; m < 4; ++m) _Pragma("unroll") for (int n = 0; n < 2; ++n) _Pragma("unroll") for (int k = 0; k < 2; ++k) \
        mma16(acc[ai][bj][m][n], Bt[n][k], At[m][k]); __builtin_amdgcn_s_setprio(0); } while (0)
#define PG8_WAIT_V(n) asm volatile("s_waitcnt vmcnt(" #n ")" ::: "memory")
#define PG8_WAIT_L(n) asm volatile("s_waitcnt lgkmcnt(" #n ")" ::: "memory")
#define PG8_BAR __builtin_amdgcn_s_barrier()
#define PG8_SCHED __builtin_amdgcn_sched_barrier(0)
    Unit cur, nxt; int ui = 0;
    if (!S.next(0, cur)) return;
    typedef typename AccT<I8>::type acc_t;
    acc_t acc[2][2][4][2];
#pragma unroll
    for (int a = 0; a < 2; ++a)
#pragma unroll
        for (int b = 0; b < 2; ++b)
#pragma unroll
            for (int m = 0; m < 4; ++m)
#pragma unroll
                for (int n = 0; n < 2; ++n) acc[a][b][m][n] = (acc_t){0, 0, 0, 0};
    bf16x8 At[4][2], B0[2][2], B1[2][2];
    const char* cA = (const char*)g.A + (size_t)cur.pm * tstep; const char* cB = (const char*)g.Bt + (size_t)cur.e * g.estride + (size_t)cur.pn * tstep;
    PG8_STAGE(PG8_SB(0, 0), cB, voffB); PG8_STAGE(PG8_SB(0, 1), cB + hstep, voffB); PG8_STAGE(PG8_SA(0, 0), cA, voffA); PG8_STAGE(PG8_SA(0, 1), cA + hstep, voffA);
    if (wr == 1) PG8_BAR;
    PG8_WAIT_V(2); PG8_BAR;
    PG8_STAGE(PG8_SB(1, 0), cB + kstep, voffB); PG8_STAGE(PG8_SA(1, 0), cA + kstep, voffA); PG8_STAGE(PG8_SB(1, 1), cB + hstep + kstep, voffB);
    PG8_WAIT_V(6); PG8_BAR;
    for (;;) {
        const bool has_next = S.next(ui + 1, nxt);
        const char* nA = has_next ? (const char*)g.A + (size_t)nxt.pm * tstep : cA; const char* nB = has_next ? (const char*)g.Bt + (size_t)nxt.e * g.estride + (size_t)nxt.pn * tstep : cB;
        for (int t = 0; t < nt; t += 2) {
            const bool last = (t == nt - 2);
            const char* a1 = cA + (size_t)(t + 1) * kstep;
            const char* a2 = last ? nA : cA + (size_t)(t + 2) * kstep; const char* b2 = last ? nB : cB + (size_t)(t + 2) * kstep;
            const char* a3 = a2 + kstep; const char* b3 = b2 + kstep;
            PG8_LDB(B0, 0, 0); PG8_LDB(B1, 0, 1); PG8_SCHED; PG8_LDA(At, 0, 0); PG8_STAGE(PG8_SA(1, 1), a1 + hstep, voffA);
            PG8_WAIT_V(8); PG8_WAIT_L(0); PG8_BAR; PG8_MMA(0, 0, At, B0); PG8_MMA(0, 1, At, B1); PG8_BAR; PG8_SCHED;
            PG8_LDA(At, 0, 1); PG8_STAGE(PG8_SB(0, 0), b2, voffB); PG8_STAGE(PG8_SB(0, 1), b2 + hstep, voffB); PG8_STAGE(PG8_SA(0, 0), a2, voffA);
            PG8_WAIT_V(8); PG8_WAIT_L(0); PG8_BAR; PG8_MMA(1, 0, At, B0); PG8_MMA(1, 1, At, B1); PG8_BAR; PG8_SCHED;
            PG8_LDB(B0, 1, 0); PG8_LDB(B1, 1, 1); PG8_SCHED; PG8_LDA(At, 1, 0); PG8_STAGE(PG8_SA(0, 1), a2 + hstep, voffA);
            PG8_WAIT_V(8); PG8_WAIT_L(0); PG8_BAR; PG8_MMA(0, 0, At, B0); PG8_MMA(0, 1, At, B1); PG8_BAR; PG8_SCHED;
            PG8_LDA(At, 1, 1); PG8_STAGE(PG8_SB(1, 0), b3, voffB); PG8_STAGE(PG8_SB(1, 1), b3 + hstep, voffB); PG8_STAGE(PG8_SA(1, 0), a3, voffA);
            PG8_WAIT_V(8); PG8_WAIT_L(0); PG8_BAR; PG8_MMA(1, 0, At, B0); PG8_MMA(1, 1, At, B1); PG8_BAR; PG8_SCHED;
        }
        if constexpr (ALIGN_EPI) { if (wr == 0) PG8_BAR; }
        run_epi(E, acc, cur, wr, wc, fr, fq, g);
        if (!has_next) break;
#pragma unroll
        for (int a = 0; a < 2; ++a)
#pragma unroll
            for (int b = 0; b < 2; ++b)
#pragma unroll
                for (int m = 0; m < 4; ++m)
#pragma unroll
                    for (int n = 0; n < 2; ++n) acc[a][b][m][n] = (acc_t){0, 0, 0, 0};
        cur = nxt; cA = nA; cB = nB; ++ui;
        if constexpr (ALIGN_EPI) { if (wr == 1) PG8_BAR; }
    }
    PG8_WAIT_V(0);
    if constexpr (!ALIGN_EPI) { if (wr == 0) PG8_BAR; }
    PG8_BAR;
#undef PG8_SA
#undef PG8_SB
#undef PG8_STAGE
#undef PG8_LDA
#undef PG8_LDB
#undef PG8_MMA
#undef PG8_WAIT_V
#undef PG8_WAIT_L
#undef PG8_BAR
#undef PG8_SCHED
}

}

__device__ __forceinline__ v4u pack8(const f32x4 a, const f32x4 b) { v4u w; w.x = pk2(a[0], a[1]); w.y = pk2(a[2], a[3]); w.z = pk2(b[0], b[1]); w.w = pk2(b[2], b[3]); return w; }
__device__ __forceinline__ void unpack8(const v4u w, f32x4& a, f32x4& b) { a = (f32x4){bf_lo(w.x), bf_hi(w.x), bf_lo(w.y), bf_hi(w.y)}; b = (f32x4){bf_lo(w.z), bf_hi(w.z), bf_lo(w.w), bf_hi(w.w)}; }

struct EpiQKV { bf16* QKV;
    __device__ __forceinline__ void store8(int row, int col, f32x4 v0, f32x4 v1) const {
        const int which = col / AW, rem = col - which * AW, hh = rem >> 6, dim0 = rem & 63, sh = 2 * (hh >> 3);
        const int b = row >> 11, s = row & 2047, pos = ((s & ((1 << sh) - 1)) << (11 - sh)) | (s >> sh);
        if (which == 0) { v0 = v0 * QSCALE; v1 = v1 * QSCALE; }
        *(GAS v4u*)(QKV + ((((size_t)(which * NB + b) * NHEAD + hh) * S + pos) * HD + dim0)) = pack8(v0, v1);
    } };
struct EpiXYG { bf16* XR;
    __device__ __forceinline__ void store8(int row, int col, f32x4 v0, f32x4 v1) const {
        const int blk = col >> 10, c = col & 1023;
        if (blk == 1) {
#pragma unroll
            for (int j = 0; j < 4; ++j) { v0[j] = gelu_tanh_f(v0[j]); v1[j] = gelu_tanh_f(v1[j]); } }
        else if (blk >= 2) {
#pragma unroll
            for (int j = 0; j < 4; ++j) { v0[j] = sigmoid_f(v0[j]); v1[j] = sigmoid_f(v1[j]); } }
        bf16* dst = XR + (size_t)blk * ((size_t)T * D) + (size_t)row * D + c;
        *(GAS v4u*)dst = pack8(v0, v1);
    } };
struct EpiP4a { bf16* GA;
    __device__ __forceinline__ void store8(int row, int col, f32x4 v0, f32x4 v1) const {
        GAS v4u* p = (GAS v4u*)(GA + (size_t)row * D + col); f32x4 g0, g1; unpack8(*p, g0, g1);
        *p = pack8(g0 * v0, g1 * v1);
    } };
struct EpiP4b { const bf16* TMP; bf16* GL;
    __device__ __forceinline__ void store8(int row, int col, f32x4 v0, f32x4 v1) const {
        GAS v4u* p = (GAS v4u*)(GL + (size_t)row * D + col); f32x4 g0, g1, t0, t1; unpack8(*p, g0, g1); unpack8(*(const GAS v4u*)(TMP + (size_t)row * D + col), t0, t1);
        *p = pack8(t0 + g0 * v0, t1 + g1 * v1);
    } };
struct EpiP5 { const float* X; const float* MOD; float* X1;
    __device__ __forceinline__ void store8(int row, int col, f32x4 v0, f32x4 v1) const {
        const int b = row >> 11; const float* gp = MOD + b * 6144 + 2048 + col; const float* xp = X + (size_t)row * D + col;
        const f32x4 g0 = *(const GAS f32x4*)gp, g1 = *(const GAS f32x4*)(gp + 4), x0 = *(const GAS f32x4*)xp, x1 = *(const GAS f32x4*)(xp + 4);
        GAS f32x4* o = (GAS f32x4*)(X1 + (size_t)row * D + col);
        o[0] = x0 + (g0 + 1.0f) * v0; o[1] = x1 + (g1 + 1.0f) * v1;
    } };
struct EpiMoeA { bf16* HB;
    __device__ __forceinline__ void store8(int row, int col, f32x4 v0, f32x4 v1) const {
        f32x4 r;
#pragma unroll
        for (int j = 0; j < 4; ++j) r[j] = v0[j] * sigmoid_f(v0[j]) * v1[j];
        v2u w; w.x = pk2(r[0], r[1]); w.y = pk2(r[2], r[3]);
        *(GAS v2u*)(HB + (size_t)row * DE + (col >> 1)) = w;
    } };
struct EpiMoeB { bf16* Y;
    __device__ __forceinline__ void store8(int row, int col, f32x4 v0, f32x4 v1) const { *(GAS v4u*)(Y + (size_t)row * D + col) = pack8(v0, v1); } };

#define XB_TMO      128
#define XB_XCNT(j)  (256  + 64 * (j))
#define XB_XSUB(j)  (1280 + 64 * (j))
#define XB_XGEN(j)  (2304 + 64 * (j))
#define XB_TOP      3328
#define XB_TOPGEN   3392
#define XCD_BAR_WORDS 3456
#define XB_SPIN_CAP (1u << 20)
__device__ __forceinline__ unsigned xb_ld(unsigned* p)              { return __hip_atomic_load(p, __ATOMIC_RELAXED, __HIP_MEMORY_SCOPE_AGENT); }
__device__ __forceinline__ unsigned xb_add(unsigned* p, unsigned v) { return __hip_atomic_fetch_add(p, v, __ATOMIC_RELAXED, __HIP_MEMORY_SCOPE_AGENT); }
__device__ __forceinline__ unsigned xb_xcc_id() { return (unsigned)__builtin_amdgcn_s_getreg((3 << 11) | 20) & 0xFu; }
#define XB_SPIN(cond, bar) do { unsigned _sp = 0; while (cond) { __builtin_amdgcn_s_sleep(1); \
    if ((++_sp & 255u) == 0u) { if (xb_ld(&(bar)[XB_TMO])) break; if (_sp > XB_SPIN_CAP) { atomicAdd(&(bar)[XB_TMO], 1u); break; } } } } while (0)
struct XcdBarrier { unsigned* bar; unsigned x; volatile LAS unsigned* st; };
__device__ __forceinline__ XcdBarrier xcd_barrier_post(unsigned* bar, volatile LAS unsigned* st) {
    XcdBarrier b; b.bar = bar; b.x = xb_xcc_id(); b.st = st;
    if (threadIdx.x == 0) (void)xb_add(&bar[XB_XCNT(b.x)], 1u);
    return b;
}
__device__ __forceinline__ void xcd_barrier_complete(unsigned* bar, unsigned x, unsigned& nloc, unsigned& nx) {
    const unsigned G = gridDim.x * gridDim.y * gridDim.z;
    unsigned sum, cnt, mine, sp = 0u;
    for (;;) {
        sum = 0u; cnt = 0u; mine = 0u;
#pragma unroll
        for (unsigned j = 0; j < 16; ++j) { const unsigned c = xb_ld(&bar[XB_XCNT(j)]); sum += c; cnt += (c > 0u) ? 1u : 0u; mine = (j == x) ? c : mine; }
        if (sum == G) break;
        __builtin_amdgcn_s_sleep(1);
        if ((++sp & 255u) == 0u) { if (xb_ld(&bar[XB_TMO])) break; if (sp > XB_SPIN_CAP) { atomicAdd(&bar[XB_TMO], 1u); break; } }
    }
    nloc = mine > 0u ? mine : 1u; nx = cnt > 0u ? cnt : 1u;
}
__device__ __forceinline__ void xcd_barrier(const XcdBarrier& b) {
    asm volatile("s_waitcnt vmcnt(0)" ::: "memory");
    __syncthreads();
    if (threadIdx.x == 0) {
        unsigned* bar = b.bar;
        __builtin_amdgcn_s_waitcnt(0);
        unsigned nloc = b.st[0], nx = b.st[1];
        if (nloc == 0u) { xcd_barrier_complete(bar, b.x, nloc, nx); b.st[0] = nloc; b.st[1] = nx; }
        const unsigned old = xb_add(&bar[XB_XSUB(b.x)], 1u);
        const unsigned gen = old / nloc;
        if (old + 1u == (gen + 1u) * nloc) {
            __builtin_amdgcn_fence(__ATOMIC_RELEASE, "agent");
            asm volatile("s_waitcnt vmcnt(0)" ::: "memory");
            const unsigned og = xb_add(&bar[XB_TOP], 1u);
            const unsigned tg = og / nx;
            if (og + 1u == (tg + 1u) * nx) xb_add(&bar[XB_TOPGEN], 1u);
            else XB_SPIN(xb_ld(&bar[XB_TOPGEN]) == tg, bar);
            __builtin_amdgcn_fence(__ATOMIC_ACQUIRE, "agent");
            xb_add(&bar[XB_XGEN(b.x)], 1u);
            asm volatile("s_waitcnt vmcnt(0)" ::: "memory");
        } else {
            XB_SPIN(xb_ld(&bar[XB_XGEN(b.x)]) == gen, bar);
            __builtin_amdgcn_fence(__ATOMIC_ACQUIRE, "agent");
            asm volatile("s_waitcnt vmcnt(0)" ::: "memory");
        }
    }
    __syncthreads();
}

struct Args { const float* in[25]; float* out; unsigned char* ws; int ph_lo, ph_hi; };
struct Frame {
    LAS unsigned char* lds; volatile LAS unsigned* MISC; gu32* ctl;
    int tid, lane, wave, vcu, G;
};

__device__ __forceinline__ void p0_transpose_item(const float* W, int K, int N, bf16* WT, int row_off, int mode, LAS float* scr, int item, int lane) {
    const int nblk = N / 32, kb = item / nblk, nb = item % nblk, k0 = 64 * kb, n0 = 32 * nb;
#pragma unroll 8
    for (int i = 0; i < 32; ++i) { const int kk = 2 * i + (lane >> 5); scr[kk * 33 + (lane & 31)] = W[(size_t)(k0 + kk) * N + n0 + (lane & 31)]; }
    LDS_WAIT(); asm volatile("" ::: "memory");
    const int c = lane & 7;
#pragma unroll
    for (int j = 0; j < 4; ++j) { const int n = (lane >> 3) + 8 * j; const LAS float* s = scr + (8 * c) * 33 + n;
        v4u o; o.x = pk2(s[0 * 33], s[1 * 33]); o.y = pk2(s[2 * 33], s[3 * 33]); o.z = pk2(s[4 * 33], s[5 * 33]); o.w = pk2(s[6 * 33], s[7 * 33]);
        const int nn = n0 + n; const int r = mode == 0 ? row_off + nn : row_off + 8 * (nn >> 2) + (nn & 3) + (mode == 2 ? 4 : 0);
        *(GAS v4u*)(WT + (size_t)r * K + k0 + 8 * c) = o; }
    LDS_WAIT(); asm volatile("" ::: "memory");
}
__device__ __forceinline__ void p0_colmax_item(const float* W, int N, float* cpart, int ntot, int row_off, int mode, int item, int lane) {
    const int nblk = N / 32, kb = item / nblk, nb = item % nblk, k0 = 128 * kb, n0 = 32 * nb;
    float m = 0.f;
#pragma unroll 16
    for (int i = 0; i < 64; ++i) { const int kk = 2 * i + (lane >> 5); m = fmaxf(m, fabsf(W[(size_t)(k0 + kk) * N + n0 + (lane & 31)])); }
    m = fmaxf(m, __shfl_xor(m, 32));
    if (lane < 32) { const int nn = n0 + lane; const int r = mode == 0 ? row_off + nn : row_off + 8 * (nn >> 2) + (nn & 3) + (mode == 2 ? 4 : 0);
        cpart[(size_t)kb * ntot + r] = m; }
}
__device__ __forceinline__ unsigned q4(float a, float b, float c, float d) {
    const int ia = (int)__builtin_rintf(fminf(fmaxf(a, -127.f), 127.f)), ib = (int)__builtin_rintf(fminf(fmaxf(b, -127.f), 127.f)), ic = (int)__builtin_rintf(fminf(fmaxf(c, -127.f), 127.f)), id = (int)__builtin_rintf(fminf(fmaxf(d, -127.f), 127.f));
    return (unsigned)(ia & 255) | ((unsigned)(ib & 255) << 8) | ((unsigned)(ic & 255) << 16) | ((unsigned)id << 24);
}
__device__ __forceinline__ void p1_quant_item(const float* W, int K, int N, signed char* WT, const float* cpart, int ntot, float* sb, int row_off, int mode, LAS float* scr, int item, int lane) {
    const int nblk = N / 32, kb = item / nblk, nb = item % nblk, k0 = 128 * kb, n0 = 32 * nb;
#pragma unroll 16
    for (int i = 0; i < 64; ++i) { const int kk = 2 * i + (lane >> 5); scr[kk * 33 + (lane & 31)] = W[(size_t)(k0 + kk) * N + n0 + (lane & 31)]; }
    LDS_WAIT(); asm volatile("" ::: "memory");
    const int n = lane >> 1, kh = lane & 1, nn = n0 + n; const int r = mode == 0 ? row_off + nn : row_off + 8 * (nn >> 2) + (nn & 3) + (mode == 2 ? 4 : 0);
    float mx = 0.f;
#pragma unroll
    for (int q = 0; q < 8; ++q) mx = fmaxf(mx, cpart[(size_t)q * ntot + r]);
    const float inv = mx > 0.f ? 127.0f / mx : 0.f;
    if (kb == 0 && kh == 0) sb[r] = mx * (1.0f / 127.0f);
    const LAS float* sp = scr + (64 * kh) * 33 + n;
#pragma unroll
    for (int c = 0; c < 4; ++c) { v4u o;
        o.x = q4(sp[(16 * c + 0) * 33] * inv, sp[(16 * c + 1) * 33] * inv, sp[(16 * c + 2) * 33] * inv, sp[(16 * c + 3) * 33] * inv);
        o.y = q4(sp[(16 * c + 4) * 33] * inv, sp[(16 * c + 5) * 33] * inv, sp[(16 * c + 6) * 33] * inv, sp[(16 * c + 7) * 33] * inv);
        o.z = q4(sp[(16 * c + 8) * 33] * inv, sp[(16 * c + 9) * 33] * inv, sp[(16 * c + 10) * 33] * inv, sp[(16 * c + 11) * 33] * inv);
        o.w = q4(sp[(16 * c + 12) * 33] * inv, sp[(16 * c + 13) * 33] * inv, sp[(16 * c + 14) * 33] * inv, sp[(16 * c + 15) * 33] * inv);
        *(GAS v4u*)(WT + (size_t)r * K + k0 + 64 * kh + 16 * c) = o; }
    LDS_WAIT(); asm volatile("" ::: "memory");
}
constexpr int QI_IN = (D / 128) * (IN_COLS / 32), QI_E = (D / 128) * (DE / 32);
__device__ __forceinline__ void p0_prologue(Frame& F, const Args& a) {
    unsigned char* ws = a.ws;
    LAS float* scr = (LAS float*)(F.lds + F.wave * 16384);
    const int gw = F.vcu * NWAVES + F.wave, NGW = F.G * NWAVES;
    constexpr int I_AO = (AOW / 64) * (D / 32), I_LO = (D / 64) * (D / 32), I_OUT = I_LO, I_E = 256;
    constexpr int NDENSE = I_AO + I_LO + I_OUT, NITEMS = NDENSE + NE * I_E;
    for (int it = gw; it < NITEMS; it += NGW) {
        int r = it;
        if (r < I_AO) { p0_transpose_item(a.in[13], AOW, D, (bf16*)(ws + WS_WAO_T), 0, 0, scr, r, F.lane); continue; } r -= I_AO;
        if (r < I_LO) { p0_transpose_item(a.in[14], D, D, (bf16*)(ws + WS_WLO_T), 0, 0, scr, r, F.lane); continue; } r -= I_LO;
        if (r < I_OUT) { p0_transpose_item(a.in[15], D, D, (bf16*)(ws + WS_WOUT_T), 0, 0, scr, r, F.lane); continue; } r -= I_OUT;
        const int e = r / I_E, item = r % I_E;
        p0_transpose_item(a.in[23] + (size_t)e * DE * D, DE, D, (bf16*)(ws + WS_W2_T), e * 1024, 0, scr, item, F.lane);
    }
    for (int it = gw; it < QI_IN + 2 * NE * QI_E; it += NGW) {
        if (it < QI_IN) { p0_colmax_item(a.in[5], IN_COLS, (float*)(ws + WS_CPART_IN), IN_COLS, 0, 0, it, F.lane); continue; }
        const int r = it - QI_IN, mat = r / QI_E, item = r % QI_E, e = mat >> 1, which = mat & 1;
        p0_colmax_item(a.in[21 + which] + (size_t)e * D * DE, DE, (float*)(ws + WS_CPART_13), NE * 1024, e * 1024, 1 + which, item, F.lane);
    }
    if (F.vcu < 192) {
        __syncthreads();
        const float* c = a.in[1]; const float* wm = a.in[2]; const float* bm = a.in[3]; float* MOD = (float*)(ws + WS_MOD);
        LAS float* CA = (LAS float*)F.lds;
        LAS float* PART = (LAS float*)(F.lds + 65536);
        for (int i = F.tid; i < NB * D; i += NTHREADS) { const float v = c[i]; CA[i] = v * sigmoid_f(v); }
        __syncthreads();
        const int kq = F.tid >> 5, col = F.tid & 31, n = F.vcu * 32 + col;
        float acc[NB];
#pragma unroll
        for (int b = 0; b < NB; ++b) acc[b] = 0.f;
#pragma unroll 4
        for (int i = 0; i < 64; ++i) { const int k = kq + 16 * i; const float w = wm[(size_t)k * 6144 + n];
#pragma unroll
            for (int b = 0; b < NB; ++b) acc[b] += CA[b * D + k] * w; }
#pragma unroll
        for (int b = 0; b < NB; ++b) PART[(kq * NB + b) * 32 + col] = acc[b];
        __syncthreads();
        { const int b = F.tid >> 5; float sum = bm[n];
#pragma unroll
            for (int q = 0; q < 16; ++q) sum += PART[(q * NB + b) * 32 + col];
            MOD[b * 6144 + n] = sum; }
        __syncthreads();
    }
}
__device__ __forceinline__ void norm_mod_row(const float* xrow, const float* g, const float* shift, const float* scale, int lane, f32x4 (&h)[4]) {
    const GAS f32x4* xr = (const GAS f32x4*)xrow + lane; float ss = 0.f;
#pragma unroll
    for (int j = 0; j < 4; ++j) { h[j] = xr[64 * j]; ss += (h[j].x * h[j].x + h[j].y * h[j].y) + (h[j].z * h[j].z + h[j].w * h[j].w); }
    const float rstd = 1.0f / sqrtf(wave_sum(ss) * (1.0f / D) + EPS);
#pragma unroll
    for (int j = 0; j < 4; ++j) { const f32x4 gg = ((const GAS f32x4*)g + lane)[64 * j], sc = ((const GAS f32x4*)scale + lane)[64 * j], sf = ((const GAS f32x4*)shift + lane)[64 * j];
        h[j] = h[j] * rstd * gg * (sc + 1.0f) + sf; }
}
__device__ __forceinline__ void store_row_bf16(bf16* orow, int lane, const f32x4 (&h)[4]) {
    GAS v2u* o8 = (GAS v2u*)orow + lane;
#pragma unroll
    for (int j = 0; j < 4; ++j) { v2u w; w.x = pk2(h[j].x, h[j].y); w.y = pk2(h[j].z, h[j].w); o8[64 * j] = w; }
}
__device__ __forceinline__ float wave_max(float v) {
#pragma unroll
    for (int o = 1; o < 64; o <<= 1) v = fmaxf(v, __shfl_xor(v, o));
    return v;
}
__device__ __forceinline__ void store_row_i8(signed char* orow, float* sarow, int lane, const f32x4 (&h)[4]) {
    float mx = 0.f;
#pragma unroll
    for (int j = 0; j < 4; ++j) mx = fmaxf(fmaxf(mx, fmaxf(fabsf(h[j].x), fabsf(h[j].y))), fmaxf(fabsf(h[j].z), fabsf(h[j].w)));
    mx = wave_max(mx);
    const float inv = mx > 0.f ? 127.0f / mx : 0.f;
    GAS unsigned* o4 = (GAS unsigned*)orow + lane;
#pragma unroll
    for (int j = 0; j < 4; ++j) o4[64 * j] = q4(h[j].x * inv, h[j].y * inv, h[j].z * inv, h[j].w * inv);
    if (lane == 0) *sarow = mx * (1.0f / 127.0f);
}
__device__ __forceinline__ void p1_norm1(Frame& F, const Args& a) {
    unsigned char* ws = a.ws;
    const int gw = F.vcu * NWAVES + F.wave, NGW = F.G * NWAVES;
    LAS float* scr = (LAS float*)(F.lds + F.wave * 16896);
    for (int it = gw; it < QI_IN + 2 * NE * QI_E; it += NGW) {
        if (it < QI_IN) { p1_quant_item(a.in[5], D, IN_COLS, (signed char*)(ws + WS_WIN_T), (const float*)(ws + WS_CPART_IN), IN_COLS, (float*)(ws + WS_SB_IN), 0, 0, scr, it, F.lane); continue; }
        const int r = it - QI_IN, mat = r / QI_E, item = r % QI_E, e = mat >> 1, which = mat & 1;
        p1_quant_item(a.in[21 + which] + (size_t)e * D * DE, D, DE, (signed char*)(ws + WS_W13_T), (const float*)(ws + WS_CPART_13), NE * 1024, (float*)(ws + WS_SB_13), e * 1024, 1 + which, scr, item, F.lane);
    }
    const float* MOD = (const float*)(ws + WS_MOD); signed char* H = (signed char*)(ws + WS_H); float* SA = (float*)(ws + WS_SAH);
    for (int m = gw; m < T; m += NGW) { const int b = m >> 11; f32x4 h[4];
        norm_mod_row(a.in[0] + (size_t)m * D, a.in[4], MOD + b * 6144, MOD + b * 6144 + 1024, F.lane, h);
        store_row_i8(H + (size_t)m * D, SA + m, F.lane, h); }
}
typedef float f32x16 __attribute__((ext_vector_type(16)));
typedef short v4i16_t __attribute__((ext_vector_type(4)));
__device__ __forceinline__ void attn_tile(const bf16x8 (&Kf)[4], const bf16x8 (&Qf)[4], LAS unsigned char* vl, unsigned trbase, int r, int hi, bool causal, bool lower, f32x16 (&O)[2], float& m, float& l) {
    f32x16 sc;
#pragma unroll
    for (int i = 0; i < 16; ++i) sc[i] = 0.f;
#pragma unroll
    for (int kk = 0; kk < 4; ++kk) sc = __builtin_amdgcn_mfma_f32_32x32x16_bf16(Kf[kk], Qf[kk], sc, 0, 0, 0);
    if (causal) {
#pragma unroll
        for (int i = 0; i < 16; ++i) { const int key = 8 * (i >> 2) + 4 * hi + (i & 3); sc[i] = key > r ? -1e30f : sc[i]; } }
    if (lower) {
#pragma unroll
        for (int i = 0; i < 16; ++i) { const int key = 8 * (i >> 2) + 4 * hi + (i & 3); sc[i] = key < r ? -1e30f : sc[i]; } }
    float mx = sc[0];
#pragma unroll
    for (int i = 1; i < 16; ++i) mx = fmaxf(mx, sc[i]);
    mx = fmaxf(mx, __shfl_xor(mx, 32));
    const float mn = fmaxf(m, mx), al = __builtin_amdgcn_exp2f(m - mn); m = mn;
    float ps = 0.f;
#pragma unroll
    for (int i = 0; i < 16; ++i) { sc[i] = __builtin_amdgcn_exp2f(sc[i] - mn); ps += sc[i]; }
    l = l * al + ps;
#pragma unroll
    for (int dt = 0; dt < 2; ++dt)
#pragma unroll
        for (int i = 0; i < 16; ++i) O[dt][i] *= al;
    bf16x8 Pf[2];
#pragma unroll
    for (int st = 0; st < 2; ++st) { v4u w; w.x = pk2(sc[8 * st], sc[8 * st + 1]); w.y = pk2(sc[8 * st + 2], sc[8 * st + 3]); w.z = pk2(sc[8 * st + 4], sc[8 * st + 5]); w.w = pk2(sc[8 * st + 6], sc[8 * st + 7]);
        Pf[st] = __builtin_bit_cast(bf16x8, w); }
#pragma unroll
    for (int st = 0; st < 2; ++st)
#pragma unroll
        for (int dt = 0; dt < 2; ++dt) {
            const v4i16_t lo = __builtin_amdgcn_ds_read_tr16_b64_v4i16((LAS v4i16_t*)(vl + dt * 2048 + st * 1024 + trbase));
            const v4i16_t hh = __builtin_amdgcn_ds_read_tr16_b64_v4i16((LAS v4i16_t*)(vl + dt * 2048 + st * 1024 + 512 + trbase));
            bf16x8 Vf; Vf[0] = lo[0]; Vf[1] = lo[1]; Vf[2] = lo[2]; Vf[3] = lo[3]; Vf[4] = hh[0]; Vf[5] = hh[1]; Vf[6] = hh[2]; Vf[7] = hh[3];
            O[dt] = __builtin_amdgcn_mfma_f32_32x32x16_bf16(Vf, Pf[st], O[dt], 0, 0, 0); }
}
__device__ __forceinline__ void attn_q64(const bf16* Qs, const bf16* Ks, const bf16* Vs, int i0, LAS unsigned char* vl, int lane, f32x16 (&OA)[2], float& lseA, f32x16 (&OB)[2], float& lseB) {
    const int r = lane & 31, hi = lane >> 5;
    const int ktA = i0 >> 5, kt0 = ktA - 4 < 0 ? 0 : ktA - 4, ktl = ktA + 1;
    const int koff = r * HD + 8 * hi, voff = (lane >> 3) * HD + 8 * (lane & 7);
    const unsigned vlw = (unsigned)(((lane & 7) >> 2) * 2048 + (lane >> 3) * 64 + (lane & 3) * 16);
    v4u Kn[4], Vn[4];
#pragma unroll
    for (int kk = 0; kk < 4; ++kk) Kn[kk] = *(const GAS v4u*)(Ks + (size_t)(32 * kt0) * HD + koff + 16 * kk);
#pragma unroll
    for (int c4 = 0; c4 < 4; ++c4) Vn[c4] = *(const GAS v4u*)(Vs + (size_t)(32 * kt0 + 8 * c4) * HD + voff);
    bf16x8 QA[4], QB[4];
#pragma unroll
    for (int kk = 0; kk < 4; ++kk) { QA[kk] = __builtin_bit_cast(bf16x8, *(const GAS v4u*)(Qs + (size_t)(i0 + r) * HD + 16 * kk + 8 * hi));
        QB[kk] = __builtin_bit_cast(bf16x8, *(const GAS v4u*)(Qs + (size_t)(i0 + 32 + r) * HD + 16 * kk + 8 * hi)); }
#pragma unroll
    for (int dt = 0; dt < 2; ++dt)
#pragma unroll
        for (int i = 0; i < 16; ++i) { OA[dt][i] = 0.f; OB[dt][i] = 0.f; }
    float mA = -1e30f, lA = 0.f, mB = -1e30f, lB = 0.f;
    const unsigned trbase = (unsigned)((4 * hi + ((lane & 15) >> 2)) * 64 + (16 * ((lane >> 4) & 1) + 4 * (lane & 3)) * 2);
    for (int kt = kt0; kt <= ktl; ++kt) {
        bf16x8 Kf[4];
#pragma unroll
        for (int kk = 0; kk < 4; ++kk) Kf[kk] = __builtin_bit_cast(bf16x8, Kn[kk]);
#pragma unroll
        for (int c4 = 0; c4 < 4; ++c4) *(LAS v4u*)(vl + vlw + c4 * 512) = Vn[c4];
        if (kt < ktl) {
#pragma unroll
            for (int kk = 0; kk < 4; ++kk) Kn[kk] = *(const GAS v4u*)(Ks + (size_t)(32 * (kt + 1)) * HD + koff + 16 * kk);
#pragma unroll
            for (int c4 = 0; c4 < 4; ++c4) Vn[c4] = *(const GAS v4u*)(Vs + (size_t)(32 * (kt + 1) + 8 * c4) * HD + voff);
        }
        if (kt <= ktA) attn_tile(Kf, QA, vl, trbase, r, hi, kt == ktA, kt == ktA - 4, OA, mA, lA);
        if (kt >= ktA - 3) attn_tile(Kf, QB, vl, trbase, r, hi, kt == ktA + 1, kt == ktA - 3, OB, mB, lB);
    }
    { const float lt = lA + __shfl_xor(lA, 32), inv = fast_rcp(lt); lseA = mA + __builtin_amdgcn_logf(lt);
#pragma unroll
      for (int dt = 0; dt < 2; ++dt)
#pragma unroll
          for (int i = 0; i < 16; ++i) OA[dt][i] *= inv; }
    { const float lt = lB + __shfl_xor(lB, 32), inv = fast_rcp(lt); lseB = mB + __builtin_amdgcn_logf(lt);
#pragma unroll
      for (int dt = 0; dt < 2; ++dt)
#pragma unroll
          for (int i = 0; i < 16; ++i) OB[dt][i] *= inv; }
}
template <bool MERGE, bool LAST>
__device__ __forceinline__ void attn_store(bf16* ATT, float* LSE, int tok0, int tstride, int slot, int lane, LAS unsigned char* ost, f32x16 (&O)[2], float lse2) {
    const int r = lane & 31, hi = lane >> 5, rrow = lane >> 3, chunk = lane & 7;
    LAS unsigned char* mine = ost + r * 144 + 8 * hi;
    if (MERGE) {
#pragma unroll
        for (int it = 0; it < 4; ++it) { const int row = it * 8 + rrow;
            *(LAS v4u*)(ost + row * 144 + chunk * 16) = *(const GAS v4u*)(ATT + (size_t)(tok0 + row * tstride) * AOW + slot * HD + chunk * 8); }
        const float lp = LSE[(tok0 + r * tstride) * NSLOT + slot], M = fmaxf(lse2, lp), wa = __builtin_amdgcn_exp2f(lse2 - M), wb = __builtin_amdgcn_exp2f(lp - M), inv = fast_rcp(wa + wb), ca = wa * inv, cb = wb * inv;
        lse2 = M + __builtin_amdgcn_logf(wa + wb);
#pragma unroll
        for (int dt = 0; dt < 2; ++dt)
#pragma unroll
            for (int g = 0; g < 4; ++g) { const v2u w = *(const LAS v2u*)(mine + 64 * dt + 16 * g);
                O[dt][4 * g] = ca * O[dt][4 * g] + cb * bf_lo(w.x); O[dt][4 * g + 1] = ca * O[dt][4 * g + 1] + cb * bf_hi(w.x);
                O[dt][4 * g + 2] = ca * O[dt][4 * g + 2] + cb * bf_lo(w.y); O[dt][4 * g + 3] = ca * O[dt][4 * g + 3] + cb * bf_hi(w.y); }
    }
#pragma unroll
    for (int dt = 0; dt < 2; ++dt)
#pragma unroll
        for (int g = 0; g < 4; ++g) { v2u w; w.x = pk2(O[dt][4 * g], O[dt][4 * g + 1]); w.y = pk2(O[dt][4 * g + 2], O[dt][4 * g + 3]); *(LAS v2u*)(mine + 64 * dt + 16 * g) = w; }
#pragma unroll
    for (int it = 0; it < 4; ++it) { const int row = it * 8 + rrow;
        *(GAS v4u*)(ATT + (size_t)(tok0 + row * tstride) * AOW + slot * HD + chunk * 8) = *(const LAS v4u*)(ost + row * 144 + chunk * 16); }
    if (!LAST && hi == 0) LSE[(tok0 + r * tstride) * NSLOT + slot] = lse2;
}
__device__ __forceinline__ void p3_attention(Frame& F, const Args& a) {
    const bf16* QKV = (const bf16*)(a.ws + WS_QKV); bf16* ATT = (bf16*)a.out; float* LSE = (float*)(a.ws + WS_LSE);
    int lane = F.lane; asm volatile("" : "+v"(lane));
    const int w = F.wave;
    LAS unsigned char* vl = F.lds + w * 8960; LAS unsigned char* ost = vl + 4096;
    const size_t WSTR = (size_t)NB * NHEAD * S * HD;
    for (int item = F.vcu; item < NB * NSLOT * 2; item += F.G) {
        const int c = item & 1, slot = (item >> 1) & 7, b = item >> 4;
#pragma unroll 1
        for (int t = 0; t < 2; ++t) { int ln = lane; asm volatile("" : "+v"(ln) :: "memory"); const int ph = 2 * w + t, i0 = 64 * c; const bf16* Qs = QKV + (((size_t)b * NHEAD + 16 + slot) * S + ph * 128) * HD;
            f32x16 OA[2], OB[2]; float la, lb; attn_q64(Qs, Qs + WSTR, Qs + 2 * WSTR, i0, vl, ln, OA, la, OB, lb);
            attn_store<false, false>(ATT, LSE, b * S + i0 * 16 + ph, 16, slot, ln, ost, OA, la);
            attn_store<false, false>(ATT, LSE, b * S + (i0 + 32) * 16 + ph, 16, slot, ln, ost, OB, lb); }
        VM_WAIT(); __syncthreads(); __builtin_amdgcn_fence(__ATOMIC_ACQUIRE, "agent"); VM_WAIT();
#pragma unroll 1
        for (int t = 0; t < 2; ++t) { int ln = lane; asm volatile("" : "+v"(ln) :: "memory"); const int u = 2 * w + t, ph = u >> 2, i0 = 256 * c + 64 * (u & 3); const bf16* Qs = QKV + (((size_t)b * NHEAD + 8 + slot) * S + ph * 512) * HD;
            f32x16 OA[2], OB[2]; float la, lb; attn_q64(Qs, Qs + WSTR, Qs + 2 * WSTR, i0, vl, ln, OA, la, OB, lb);
            attn_store<true, false>(ATT, LSE, b * S + i0 * 4 + ph, 4, slot, ln, ost, OA, la);
            attn_store<true, false>(ATT, LSE, b * S + (i0 + 32) * 4 + ph, 4, slot, ln, ost, OB, lb); }
        VM_WAIT(); __syncthreads(); __builtin_amdgcn_fence(__ATOMIC_ACQUIRE, "agent"); VM_WAIT();
#pragma unroll 1
        for (int t = 0; t < 2; ++t) { int ln = lane; asm volatile("" : "+v"(ln) :: "memory"); const int i0 = 1024 * c + 64 * (2 * w + t); const bf16* Qs = QKV + (((size_t)b * NHEAD + slot) * S) * HD;
            f32x16 OA[2], OB[2]; float la, lb; attn_q64(Qs, Qs + WSTR, Qs + 2 * WSTR, i0, vl, ln, OA, la, OB, lb);
            attn_store<true, true>(ATT, LSE, b * S + i0, 1, slot, ln, ost, OA, la);
            attn_store<true, true>(ATT, LSE, b * S + i0 + 32, 1, slot, ln, ost, OB, lb); }
    }
    VM_WAIT(); __syncthreads();
}
__device__ __forceinline__ void p5_lru(Frame& F, const Args& a) {
    const bf16* XR = (const bf16*)(a.ws + WS_XR); const bf16* YR = (const bf16*)(a.ws + WS_YR); bf16* LRU = (bf16*)(a.ws + WS_LRU);
    LAS v4u* BF = (LAS v4u*)(F.lds);
    LAS float* CW = (LAS float*)(F.lds + 24576);
    LAS float* CARRY = (LAS float*)(F.lds + 24576 + 2048);
    volatile LAS int* FLAG = (volatile LAS int*)(F.lds + 24576 + 2048 + 65 * 256);
    int lane = F.lane; asm volatile("" : "+v"(lane));
    const int r = lane & 31, hi = lane >> 5, w = F.wave;
    const float LOG2E = 1.4426950408889634f;
    for (int item = F.vcu; item < NB * 16; item += F.G) {
        const int b = item >> 4, cb = item & 15;
        __syncthreads();
        for (int idx = F.tid; idx < 3 * 8 * 64; idx += NTHREADS) { const int l = idx & 63, f = idx >> 6, nt = f & 1, kk = (f >> 1) & 3, mat = f >> 3, rr = l & 31, hh = l >> 5, n = rr + 32 * nt;
            unsigned v[4];
#pragma unroll
            for (int jj = 0; jj < 4; ++jj) { float e[2];
#pragma unroll
                for (int q = 0; q < 2; ++q) { const int k = 16 * kk + 8 * hh + 2 * jj + q;
                    e[q] = mat == 0 ? a.in[8][(size_t)(cb * 64 + k) * 64 + n] : mat == 1 ? a.in[10][(size_t)(cb * 64 + k) * 64 + n] : (k == n ? 1.0f : 0.0f); }
                v[jj] = pk2(e[0], e[1]); }
            v4u o; o.x = v[0]; o.y = v[1]; o.z = v[2]; o.w = v[3]; BF[idx] = o; }
        for (int idx = F.tid; idx < 5 * 64; idx += NTHREADS) CW[idx] = idx < 256 ? a.in[6][(idx >> 6) * D + cb * 64 + (idx & 63)] : a.in[7][cb * 64 + (idx & 63)];
        if (F.tid < 65) FLAG[F.tid] = F.tid == 0 ? 1 : 0;
        if (F.tid < 64) CARRY[F.tid] = 0.f;
        __syncthreads();
        float bxv[2], bav[2], cav[2];
#pragma unroll
        for (int nt = 0; nt < 2; ++nt) { const int c = cb * 64 + r + 32 * nt; bxv[nt] = a.in[9][c]; bav[nt] = a.in[11][c]; cav[nt] = -8.0f * log1pf(__expf(-a.in[12][c])) * LOG2E; }
        for (int j = w; j < 64; j += 8) {
            const int t0 = 32 * j;
            bf16x8 Af[4];
#pragma unroll
            for (int kk = 0; kk < 4; ++kk) { const int c0 = 16 * kk + 8 * hi;
                f32x4 s0 = *(const LAS f32x4*)(CW + 256 + c0), s1 = *(const LAS f32x4*)(CW + 256 + c0 + 4);
#pragma unroll
                for (int d = 0; d < 4; ++d) { const int tok = t0 + r - d; const bool ok = tok >= 0;
                    const v4u x = *(const GAS v4u*)(XR + (size_t)(b * S + (ok ? tok : 0)) * D + cb * 64 + c0);
                    f32x4 x0, x1; unpack8(x, x0, x1); if (!ok) { x0 = x0 * 0.f; x1 = x1 * 0.f; }
                    const f32x4 w0 = *(const LAS f32x4*)(CW + (3 - d) * 64 + c0), w1 = *(const LAS f32x4*)(CW + (3 - d) * 64 + c0 + 4);
                    s0 = s0 + w0 * x0; s1 = s1 + w1 * x1; }
                Af[kk] = __builtin_bit_cast(bf16x8, pack8(s0, s1)); }
            f32x16 ci[2], cr[2], cx[2];
#pragma unroll
            for (int nt = 0; nt < 2; ++nt) {
#pragma unroll
                for (int i = 0; i < 16; ++i) { ci[nt][i] = 0.f; cr[nt][i] = 0.f; cx[nt][i] = 0.f; } }
#pragma unroll
            for (int kk = 0; kk < 4; ++kk)
#pragma unroll
                for (int nt = 0; nt < 2; ++nt) {
                    ci[nt] = __builtin_amdgcn_mfma_f32_32x32x16_bf16(Af[kk], __builtin_bit_cast(bf16x8, BF[((0 * 4 + kk) * 2 + nt) * 64 + lane]), ci[nt], 0, 0, 0);
                    cr[nt] = __builtin_amdgcn_mfma_f32_32x32x16_bf16(Af[kk], __builtin_bit_cast(bf16x8, BF[((1 * 4 + kk) * 2 + nt) * 64 + lane]), cr[nt], 0, 0, 0);
                    cx[nt] = __builtin_amdgcn_mfma_f32_32x32x16_bf16(Af[kk], __builtin_bit_cast(bf16x8, BF[((2 * 4 + kk) * 2 + nt) * 64 + lane]), cx[nt], 0, 0, 0); }
            unsigned short yv[2][16];
#pragma unroll
            for (int nt = 0; nt < 2; ++nt)
#pragma unroll
                for (int i = 0; i < 16; ++i) yv[nt][i] = YR[(size_t)(b * S + t0 + 8 * (i >> 2) + 4 * hi + (i & 3)) * D + cb * 64 + r + 32 * nt];
#pragma unroll
            for (int nt = 0; nt < 2; ++nt)
#pragma unroll
                for (int i = 0; i < 16; ++i) {
                    const float gi = fast_rcp(1.0f + __builtin_amdgcn_exp2f(-(ci[nt][i] + bxv[nt]) * LOG2E)), gr = fast_rcp(1.0f + __builtin_amdgcn_exp2f(-(cr[nt][i] + bav[nt]) * LOG2E));
                    const float av = __builtin_amdgcn_exp2f(cav[nt] * gr), mult = __builtin_amdgcn_sqrtf(fmaxf(0.f, 1.0f - av * av));
                    cr[nt][i] = av; ci[nt][i] = mult * gi * cx[nt][i]; }
            float A1[2][4], B1[2][4], A2[2][4], B2[2][4], SA[2], SB[2];
#pragma unroll
            for (int nt = 0; nt < 2; ++nt) { SA[nt] = 1.f; SB[nt] = 0.f;
#pragma unroll
                for (int g = 0; g < 4; ++g) { const int i0 = 4 * g;
                    const float ga = (cr[nt][i0] * cr[nt][i0 + 1]) * (cr[nt][i0 + 2] * cr[nt][i0 + 3]);
                    const float gb = ((ci[nt][i0] * cr[nt][i0 + 1] + ci[nt][i0 + 1]) * cr[nt][i0 + 2] + ci[nt][i0 + 2]) * cr[nt][i0 + 3] + ci[nt][i0 + 3];
                    const float pa = __shfl_xor(ga, 32), pb = __shfl_xor(gb, 32);
                    A1[nt][g] = hi ? pa : ga; B1[nt][g] = hi ? pb : gb; A2[nt][g] = hi ? ga : pa; B2[nt][g] = hi ? gb : pb;
                    SB[nt] = A1[nt][g] * SB[nt] + B1[nt][g]; SA[nt] = A1[nt][g] * SA[nt];
                    SB[nt] = A2[nt][g] * SB[nt] + B2[nt][g]; SA[nt] = A2[nt][g] * SA[nt]; } }
            if (j > 0) { while (FLAG[j] == 0) __builtin_amdgcn_s_sleep(1); }
            asm volatile("" ::: "memory");
            float h[2];
#pragma unroll
            for (int nt = 0; nt < 2; ++nt) { h[nt] = CARRY[j * 64 + r + 32 * nt]; if (hi == 0) CARRY[(j + 1) * 64 + r + 32 * nt] = SA[nt] * h[nt] + SB[nt]; }
            asm volatile("s_waitcnt lgkmcnt(0)" ::: "memory");
            if (lane == 0) FLAG[j + 1] = 1;
#pragma unroll
            for (int nt = 0; nt < 2; ++nt)
#pragma unroll
                for (int g = 0; g < 4; ++g) { const float h1 = A1[nt][g] * h[nt] + B1[nt][g]; float hh = hi ? h1 : h[nt]; h[nt] = A2[nt][g] * h1 + B2[nt][g];
#pragma unroll
                    for (int q = 0; q < 4; ++q) { const int i = 4 * g + q; hh = cr[nt][i] * hh + ci[nt][i];
                        LRU[(size_t)(b * S + t0 + 8 * g + 4 * hi + q) * D + cb * 64 + r + 32 * nt] = (bf16)f2bf(hh * bf2f(yv[nt][i])); } }
        }
    }
    __syncthreads();
}
__device__ __forceinline__ void p10_router(Frame& F, const Args& a) {
    LAS float* WT = (LAS float*)F.lds;
    for (int i = F.tid; i < 36 * D; i += NTHREADS) { const int o = i >> 10, k = i & 1023; WT[i] = o < 4 ? a.in[17][k * 4 + o] : a.in[19][k * 32 + (o - 4)]; }
    __syncthreads();
    const int gw = F.vcu * NWAVES + F.wave, NGW = F.G * NWAVES, lane = F.lane;
    const float* MOD = (const float*)(a.ws + WS_MOD); signed char* H2 = (signed char*)(a.ws + WS_H); float* SA = (float*)(a.ws + WS_SAH); const float* X1 = a.out;
    int* TOKE = (int*)(a.ws + WS_TOKE); int* TOKR = (int*)(a.ws + WS_TOKR); float* TOKW = (float*)(a.ws + WS_TOKW);
    for (int m = gw; m < T; m += NGW) { const int b = m >> 11; f32x4 h[4];
        norm_mod_row(X1 + (size_t)m * D, a.in[16], MOD + b * 6144 + 3072, MOD + b * 6144 + 4096, lane, h);
        store_row_i8(H2 + (size_t)m * D, SA + m, lane, h);
        float lg[36];
#pragma unroll
        for (int o = 0; o < 36; ++o) { float p = 0.f;
#pragma unroll
            for (int j = 0; j < 4; ++j) { const f32x4 w = *(const LAS f32x4*)(WT + o * D + 256 * j + 4 * lane); p += (h[j].x * w.x + h[j].y * w.y) + (h[j].z * w.z + h[j].w * w.w); }
            lg[o] = wave_sum(p);
            if ((o & 3) == 3) asm volatile("" ::: "memory"); }
        float gl[4];
#pragma unroll
        for (int o = 0; o < 4; ++o) gl[o] = lg[o] + a.in[18][o];
        int gi = 0; float gm = gl[0];
#pragma unroll
        for (int o = 1; o < 4; ++o) if (gl[o] > gm) { gm = gl[o]; gi = o; }
        float den = 0.f;
#pragma unroll
        for (int o = 0; o < 4; ++o) den += __expf(gl[o] - gm);
        const float ggate = 1.0f / den;
        float el[8];
#pragma unroll
        for (int j = 0; j < 8; ++j) { float v = lg[4 + j];
#pragma unroll
            for (int gg = 1; gg < 4; ++gg) v = (gi == gg) ? lg[4 + gg * 8 + j] : v;
            el[j] = v + a.in[20][gi * 8 + j]; }
        int i1 = 0; float v1 = el[0];
#pragma unroll
        for (int j = 1; j < 8; ++j) if (el[j] > v1) { v1 = el[j]; i1 = j; }
        int i2 = -1; float v2 = -INFINITY;
#pragma unroll
        for (int j = 0; j < 8; ++j) if (j != i1 && el[j] > v2) { v2 = el[j]; i2 = j; }
        if (i2 < 0) { i2 = (i1 + 1) & 7; v2 = v1; }
        const float e2 = __expf(v2 - v1), w1 = ggate / (1.0f + e2), w2 = ggate * e2 / (1.0f + e2);
        if (lane == 0) {
            const int e1 = gi * 8 + i1, e2i = gi * 8 + i2;
            const int r1 = (int)atomicAdd((unsigned*)(a.ws + WS_CTL) + CW_CNT + 64 * e1, 1u), r2 = (int)atomicAdd((unsigned*)(a.ws + WS_CTL) + CW_CNT + 64 * e2i, 1u);
            TOKE[2 * m] = e1; TOKE[2 * m + 1] = e2i; TOKR[2 * m] = r1; TOKR[2 * m + 1] = r2; TOKW[2 * m] = w1; TOKW[2 * m + 1] = w2;
        }
    }
    __syncthreads();
}
__device__ __forceinline__ int moe_tables(Frame& F, const Args& a, LAS int* off, LAS int* tile_e) {
    if (F.tid == 0) { int acc = 0;
        for (int e = 0; e < NE; ++e) { off[e] = acc; const int cnt = (int)__hip_atomic_load((unsigned*)(a.ws + WS_CTL) + CW_CNT + 64 * e, RLX_AGENT); const int nt = (cnt + 255) >> 8;
            for (int t = 0; t < nt; ++t) tile_e[(acc >> 8) + t] = e; acc += nt * 256; }
        off[NE] = acc; }
    __syncthreads();
    return off[NE] >> 8;
}
__device__ __forceinline__ void p11_scatter(Frame& F, const Args& a) {
    LAS int* off = (LAS int*)(F.lds + LDSX_OFF); LAS int* tile_e = off + 64;
    (void)moe_tables(F, a, off, tile_e);
    const int gw = F.vcu * NWAVES + F.wave, NGW = F.G * NWAVES, lane = F.lane;
    const signed char* H2 = (const signed char*)(a.ws + WS_H); signed char* XP = (signed char*)(a.ws + WS_XP); const float* SA = (const float*)(a.ws + WS_SAH); float* SAXP = (float*)(a.ws + WS_SAXP);
    const int* TOKE = (const int*)(a.ws + WS_TOKE); const int* TOKR = (const int*)(a.ws + WS_TOKR); int* TOKS = (int*)(a.ws + WS_TOKS);
    for (int m = gw; m < T; m += NGW) {
        const v4u r0 = ((const GAS v4u*)(H2 + (size_t)m * D))[lane]; const float sc = SA[m];
#pragma unroll
        for (int k = 0; k < 2; ++k) { const int e = TOKE[2 * m + k], slot = off[e] + TOKR[2 * m + k];
            ((GAS v4u*)(XP + (size_t)slot * D))[lane] = r0;
            if (lane == 0) { TOKS[2 * m + k] = slot; SAXP[slot] = sc; } }
    }
    __syncthreads();
}
__device__ __forceinline__ void p14_final(Frame& F, const Args& a) {
    const int gw = F.vcu * NWAVES + F.wave, NGW = F.G * NWAVES, lane = F.lane;
    const float* MOD = (const float*)(a.ws + WS_MOD); const bf16* Y = (const bf16*)(a.ws + WS_Y);
    const int* TOKS = (const int*)(a.ws + WS_TOKS); const float* TOKW = (const float*)(a.ws + WS_TOKW);
    for (int m = gw; m < T; m += NGW) { const int b = m >> 11;
        const int s0 = TOKS[2 * m], s1 = TOKS[2 * m + 1]; const float w0 = TOKW[2 * m], w1 = TOKW[2 * m + 1];
        GAS f32x4* xr = (GAS f32x4*)(a.out + (size_t)m * D) + lane; f32x4 v[4]; float ss = 0.f;
#pragma unroll
        for (int j = 0; j < 4; ++j) {
            const v2u ya = ((const GAS v2u*)(Y + (size_t)s0 * D) + lane)[64 * j], yb = ((const GAS v2u*)(Y + (size_t)s1 * D) + lane)[64 * j];
            const f32x4 y0 = (f32x4){bf_lo(ya.x), bf_hi(ya.x), bf_lo(ya.y), bf_hi(ya.y)}, y1 = (f32x4){bf_lo(yb.x), bf_hi(yb.x), bf_lo(yb.y), bf_hi(yb.y)};
            const f32x4 g2 = ((const GAS f32x4*)(MOD + b * 6144 + 5120) + lane)[64 * j];
            v[j] = xr[64 * j] + (g2 + 1.0f) * (y0 * w0 + y1 * w1);
            ss += (v[j].x * v[j].x + v[j].y * v[j].y) + (v[j].z * v[j].z + v[j].w * v[j].w); }
        const float rstd = 1.0f / sqrtf(wave_sum(ss) * (1.0f / D) + EPS);
#pragma unroll
        for (int j = 0; j < 4; ++j) xr[64 * j] = v[j] * rstd * ((const GAS f32x4*)a.in[24] + lane)[64 * j];
    }
}

template <bool I8 = false, class Epi, class Sched> __device__ __forceinline__ void run_gemm(Frame& F, const pg8::Gemm& g, const Sched& S, const Epi& E) {
    pg8::gemm_phase<Epi, Sched, true, I8>(F.lds, g, S, E);
}

constexpr int NPHASES = 14;
__global__ void __launch_bounds__(NTHREADS, 2) mk_fwd(Args args) {
    extern __shared__ __attribute__((aligned(16))) unsigned char lds_raw[];
    Frame F;
    F.lds = (LAS unsigned char*)lds_raw; F.MISC = (volatile LAS unsigned*)(F.lds + MISC_OFF);
    F.tid = threadIdx.x; F.lane = F.tid & 63; F.wave = __builtin_amdgcn_readfirstlane(F.tid >> 6);
    F.G = gridDim.x; { const int bx = blockIdx.x; F.vcu = (F.G % 8 == 0) ? (bx % 8) * (F.G / 8) + bx / 8 : bx; }
    unsigned char* ws = args.ws; F.ctl = (gu32*)(ws + WS_CTL);
    if (F.tid < 64) F.MISC[F.tid] = 0u;
    __syncthreads();
    XcdBarrier bar; bar.bar = (unsigned*)(ws + WS_CTL) + CW_BAR; bar.x = 0; bar.st = nullptr;
    if (MK_N_LAUNCHES == 1) bar = xcd_barrier_post((unsigned*)(ws + WS_CTL) + CW_BAR, F.MISC + 8);
    const int lo = args.ph_lo, hi = args.ph_hi;
#ifndef PH_MASK
#define PH_MASK 0x7fff
#endif
#define IN(k) (((PH_MASK >> (k)) & 1) && lo <= (k) && (k) < hi)
#define SEAM(k) do { if (IN(k) && IN((k) + 1)) xcd_barrier(bar); } while (0)
#ifndef REP_MASK
#define REP_MASK 0
#endif
#define PHASE(k, ...) do { if (IN(k)) { __VA_ARGS__ if ((REP_MASK >> (k)) & 1) { __syncthreads(); __VA_ARGS__ } SEAM(k); } } while (0)

    PHASE(0, { p0_prologue(F, args);});
    PHASE(1, { p1_norm1(F, args);});
    PHASE(2, {
        pg8::Gemm g{(const bf16*)(ws + WS_H), (const bf16*)(ws + WS_WIN_T), T, 3 * AW, D / 2, 0, (const float*)(ws + WS_SAH), (const float*)(ws + WS_SB_IN)}; pg8::StaticOrder So; So.init(T, 3 * AW, F.G, (int)blockIdx.x);
        EpiQKV E{(bf16*)(ws + WS_QKV)}; run_gemm<true>(F, g, So, E);});
    PHASE(3, { p3_attention(F, args);});
    PHASE(4, {
        pg8::Gemm g{(const bf16*)(ws + WS_H), (const bf16*)(ws + WS_WIN_T + (size_t)(3 * AW) * D), T, 4 * D, D / 2, 0, (const float*)(ws + WS_SAH), (const float*)(ws + WS_SB_IN) + 3 * AW}; pg8::StaticOrder So; So.init(T, 4 * D, F.G, (int)blockIdx.x);
        EpiXYG E{(bf16*)(ws + WS_XR)}; run_gemm<true>(F, g, So, E);});
    PHASE(5, { p5_lru(F, args);});
    PHASE(6, {
        pg8::Gemm g{(const bf16*)args.out, (const bf16*)(ws + WS_WAO_T), T, D, AOW, 0, nullptr, nullptr}; pg8::StaticOrder So; So.init(T, D, F.G, (int)blockIdx.x);
        EpiP4a E{(bf16*)(ws + WS_GA)}; run_gemm(F, g, So, E);});
    PHASE(7, {
        pg8::Gemm g{(const bf16*)(ws + WS_LRU), (const bf16*)(ws + WS_WLO_T), T, D, D, 0, nullptr, nullptr}; pg8::StaticOrder So; So.init(T, D, F.G, (int)blockIdx.x);
        EpiP4b E{(const bf16*)(ws + WS_GA), (bf16*)(ws + WS_GL)}; run_gemm(F, g, So, E);});
    PHASE(8, {
        pg8::Gemm g{(const bf16*)(ws + WS_GL), (const bf16*)(ws + WS_WOUT_T), T, D, D, 0, nullptr, nullptr}; pg8::StaticOrder So; So.init(T, D, F.G, (int)blockIdx.x);
        EpiP5 E{args.in[0], (const float*)(ws + WS_MOD), args.out}; run_gemm(F, g, So, E);});
    PHASE(9, { p10_router(F, args);});
    PHASE(10, { p11_scatter(F, args);});
    PHASE(11, {
        LAS int* off = (LAS int*)(F.lds + LDSX_OFF); LAS int* tile_e = off + 64;
        const int ntiles = moe_tables(F, args, off, tile_e);
        pg8::Gemm g{(const bf16*)(ws + WS_XP), (const bf16*)(ws + WS_W13_T), ntiles * 256, D, D / 2, (size_t)D * D, (const float*)(ws + WS_SAXP), (const float*)(ws + WS_SB_13)}; pg8::MoeOrder So{ntiles, F.G, F.vcu, tile_e};
        EpiMoeA E{(bf16*)(ws + WS_HB)}; run_gemm<true>(F, g, So, E);});
    PHASE(12, {
        LAS int* off = (LAS int*)(F.lds + LDSX_OFF); LAS int* tile_e = off + 64;
        const int ntiles = moe_tables(F, args, off, tile_e);
        pg8::Gemm g{(const bf16*)(ws + WS_HB), (const bf16*)(ws + WS_W2_T), ntiles * 256, D, DE, (size_t)D * DE * 2, nullptr, nullptr}; pg8::MoeOrder So{ntiles, F.G, F.vcu, tile_e};
        EpiMoeB E{(bf16*)(ws + WS_Y)}; run_gemm(F, g, So, E);});
    if (IN(13)) { p14_final(F, args); }
#undef IN
#undef SEAM
}

extern "C" void kernel_launch(void* const* d_in, const int* in_sizes, int n_in, void* d_out, int out_size, void* d_ws, size_t ws_size, hipStream_t stream) {
    static int grid = 0;
    if (grid == 0) {
        if (n_in != 25 || out_size != T * D || ws_size < WS_END) { fprintf(stderr, "kernel_launch: unexpected shapes: n_in %d out %d ws %zu (need %zu)\n", n_in, out_size, ws_size, (size_t)WS_END); grid = -1; return; }
        int dev = 0, cus = 0, per_cu = 0;
        if (hipGetDevice(&dev) != hipSuccess || hipDeviceGetAttribute(&cus, hipDeviceAttributeMultiprocessorCount, dev) != hipSuccess) { grid = -1; return; }
        if (hipFuncSetAttribute((const void*)mk_fwd, hipFuncAttributeMaxDynamicSharedMemorySize, LDS_BYTES) != hipSuccess) { fprintf(stderr, "kernel_launch: hipFuncSetAttribute failed\n"); grid = -1; return; }
        if (hipOccupancyMaxActiveBlocksPerMultiprocessor(&per_cu, (const void*)mk_fwd, NTHREADS, LDS_BYTES) != hipSuccess || per_cu < 1) { fprintf(stderr, "kernel_launch: occupancy query says %d\n", per_cu); }
        (void)hipGetLastError();
        grid = cus;
    }
    if (grid < 0) return;
    if (hipMemsetAsync((char*)d_ws + WS_CTL, 0, CTL_ZERO_BYTES, stream) != hipSuccess) return;
    Args a{};
    for (int i = 0; i < 25; ++i) a.in[i] = (const float*)d_in[i];
    a.out = (float*)d_out; a.ws = (unsigned char*)d_ws;
    if (MK_N_LAUNCHES == 1) { a.ph_lo = 0; a.ph_hi = NPHASES; hipLaunchKernelGGL(mk_fwd, dim3(grid), dim3(NTHREADS), LDS_BYTES, stream, a); }
    else for (int p = 0; p < NPHASES; ++p) { a.ph_lo = p; a.ph_hi = p + 1; hipLaunchKernelGGL(mk_fwd, dim3(grid), dim3(NTHREADS), LDS_BYTES, stream, a); }
}
```

```cpp
#include <hip/hip_runtime.h>
#include <cstdio>
#include <cstdint>

#ifndef MK_N_LAUNCHES
#define MK_N_LAUNCHES 1
#endif
#ifndef MK_SIMPLE_GEMM
#define MK_SIMPLE_GEMM 0
#endif

#define GAS __attribute__((address_space(1)))
#define LAS __attribute__((address_space(3)))
typedef unsigned short bf16;
typedef unsigned v4u __attribute__((ext_vector_type(4)));
typedef unsigned v2u __attribute__((ext_vector_type(2)));
typedef float f32x4 __attribute__((ext_vector_type(4)));
typedef float f32x2 __attribute__((ext_vector_type(2)));
typedef short bf16x8 __attribute__((ext_vector_type(8)));
typedef GAS unsigned gu32;

constexpr int NB = 16, S = 2048, D = 1024, T = NB * S;
constexpr int HD = 64, NSLOT = 8, NHEAD = 24, AW = 1536, AOW = 512;
constexpr int IN_COLS = 8704, NE = 32, DE = 512, MAX_TILES = 288;
constexpr float EPS = 1e-6f, QSCALE = 0.125f * 1.4426950408889634f;
constexpr int NWAVES = 8, NTHREADS = 512;

constexpr size_t MiB = 1u << 20, KiB = 1u << 10;
constexpr size_t WS_CTL = 0, CTL_ZERO_BYTES = 1 * MiB;
constexpr size_t WS_MOD = 128 * KiB;
constexpr size_t WS_CPART_IN = 27 * MiB, WS_CPART_13 = 28 * MiB;
constexpr size_t WS_SB_IN = 29 * MiB, WS_SB_13 = 29 * MiB + 512 * KiB;
constexpr size_t WS_TOKE = 1 * MiB, WS_TOKR = WS_TOKE + 256 * KiB, WS_TOKW = WS_TOKR + 256 * KiB, WS_TOKS = WS_TOKW + 256 * KiB;
constexpr size_t WS_WIN_T = 2 * MiB;
constexpr size_t WS_WAO_T = 19 * MiB, WS_WLO_T = 20 * MiB, WS_WOUT_T = 22 * MiB;
constexpr size_t WS_LSE = 26 * MiB;
constexpr size_t WS_W13_T = 32 * MiB;
constexpr size_t WS_W2_T = 96 * MiB;
constexpr size_t WS_H = 128 * MiB;
constexpr size_t WS_SAH = WS_H + 32 * MiB;
constexpr size_t WS_SAXP = WS_H + 33 * MiB;
constexpr size_t WS_R = 192 * MiB;
constexpr size_t WS_QKV = WS_R;
constexpr size_t WS_XR = WS_R, WS_YR = WS_R + 64 * MiB, WS_GA = WS_R + 128 * MiB, WS_GL = WS_R + 192 * MiB, WS_LRU = WS_R + 256 * MiB;
constexpr size_t WS_XP = WS_R, WS_HB = WS_R + 144 * MiB, WS_Y = WS_R;
constexpr size_t WS_END = 512 * MiB;
constexpr int CW_TMO = 0, CW_CNT = 1024, CW_BAR = 4096;

constexpr int RING_BYTES = 131072;
constexpr int LDSX_OFF = RING_BYTES;
constexpr int LDS_BYTES = 155648;
constexpr int MISC_OFF = LDS_BYTES - 256;

#define LDS_WAIT() asm volatile("s_waitcnt lgkmcnt(0)" ::: "memory")
#define VM_WAIT() asm volatile("s_waitcnt vmcnt(0)" ::: "memory")
#define RLX_AGENT __ATOMIC_RELAXED, __HIP_MEMORY_SCOPE_AGENT

__device__ __forceinline__ unsigned f2bf(float f) { unsigned u = __builtin_bit_cast(unsigned, f); return (u + 0x7fffu + ((u >> 16) & 1u)) >> 16; }
__device__ __forceinline__ unsigned pk2(float lo, float hi) { unsigned r; asm("v_cvt_pk_bf16_f32 %0, %1, %2" : "=v"(r) : "v"(lo), "v"(hi)); return r; }
__device__ __forceinline__ float bf_lo(unsigned u) { return __builtin_bit_cast(float, u << 16); }
__device__ __forceinline__ float bf_hi(unsigned u) { return __builtin_bit_cast(float, u & 0xffff0000u); }
__device__ __forceinline__ float bf2f(bf16 b) { return __builtin_bit_cast(float, ((unsigned)b) << 16); }
__device__ __forceinline__ float fast_rcp(float x) { return __builtin_amdgcn_rcpf(x); }
__device__ __forceinline__ float sigmoid_f(float x) { return fast_rcp(1.0f + __expf(-x)); }
__device__ __forceinline__ float gelu_tanh_f(float v) { const float u = 0.7978845608028654f * (v + 0.044715f * v * v * v); return v * fast_rcp(1.0f + __expf(-2.0f * u)); }
__device__ __forceinline__ float wave_sum(float v) {
#pragma unroll
    for (int o = 1; o < 64; o <<= 1) v += __shfl_xor(v, o);
    return v;
}

namespace pg8 {
#define PG8_LAS __attribute__((address_space(3)))
typedef unsigned short bf16_t;
typedef unsigned u32x4 __attribute__((ext_vector_type(4)));
constexpr int BM = 256, BK = 64, HALF = 128, HTB = HALF * BK * 2, STAGE_BYTES = 8 * HTB, NXCD = 8, WGM = 8;

__host__ __device__ __forceinline__ int lds_byte(int r, int c) { const int st = (r >> 4) * 2 + (c >> 5), rr = r & 15, cc = c & 31, ob = rr * 64 + cc * 2; return st * 1024 + (ob ^ (((ob >> 9) & 1) << 5)); }
__host__ __device__ __forceinline__ void stage_rc(int b, int& R, int& C) { const int st = b / 1024, sb = b % 1024, swz = sb ^ (((sb >> 9) & 1) << 5); R = (st >> 1) * 16 + swz / 64; C = (st & 1) * 32 + (swz % 64) / 2; }
__host__ __device__ __forceinline__ int perm32(int rho) { const int n = rho >> 4, i = rho & 15; return 8 * (i >> 2) + 4 * n + (i & 3); }

struct Unit { int pm, pn, e; };
struct Gemm { const bf16_t* A; const bf16_t* Bt; int M, N, K; size_t estride; const float* sa; const float* sb; };
typedef int i32x4 __attribute__((ext_vector_type(4)));

struct StaticOrder {
    int nM, nN, nwg, G, c;
    __host__ __device__ void init(int M, int N, int G_, int c_) { nM = M / BM; nN = N / BM; nwg = nM * nN; G = G_; c = c_; }
    __host__ __device__ bool next(int i, Unit& u) const {
        const long L = (long)i * G + c; if (L >= nwg) return false;
        int wgid = (int)L; { const int q = nwg / NXCD, r = nwg % NXCD, xcd = wgid % NXCD, off = wgid / NXCD; wgid = (xcd < r ? xcd * (q + 1) : r * (q + 1) + (xcd - r) * q) + off; }
        const int nig = WGM * nN, gid = wgid / nig, fm = gid * WGM, gsz = (nM - fm) < WGM ? (nM - fm) : WGM;
        u.pm = fm + ((wgid % nig) % gsz); u.pn = (wgid % nig) / gsz; u.e = 0; return true;
    }
};
struct MoeOrder {
    int ntiles, G, vcu; const PG8_LAS int* tile_e;
    __device__ bool next(int i, Unit& u) const {
        const int L = i * G + vcu; if (L >= ntiles * 4) return false;
        u.pm = L >> 2; u.pn = L & 3; u.e = __builtin_amdgcn_readfirstlane(tile_e[u.pm]); return true;
    }
};

template <class Epi> __device__ __forceinline__ void run_epi(const Epi& E, const f32x4 (&acc)[2][2][4][2], const Unit& u, int wr, int wc, int fr, int fq, const Gemm&) {
    const int row0 = u.pm * BM + wr * 64 + fr, col0 = u.pn * BM + wc * 32 + 8 * fq;
#pragma unroll
    for (int ai = 0; ai < 2; ++ai)
#pragma unroll
        for (int m = 0; m < 4; ++m)
#pragma unroll
            for (int bj = 0; bj < 2; ++bj) E.store8(row0 + ai * HALF + m * 16, col0 + bj * HALF, acc[ai][bj][m][0], acc[ai][bj][m][1]);
}
template <class Epi> __device__ __forceinline__ void run_epi(const Epi& E, const i32x4 (&acc)[2][2][4][2], const Unit& u, int wr, int wc, int fr, int fq, const Gemm& g) {
    const int row0 = u.pm * BM + wr * 64 + fr, col0 = u.pn * BM + wc * 32 + 8 * fq;
    f32x4 cs[2][2];
#pragma unroll
    for (int bj = 0; bj < 2; ++bj)
#pragma unroll
        for (int n = 0; n < 2; ++n) cs[bj][n] = *(const __attribute__((address_space(1))) f32x4*)(g.sb + (size_t)u.e * g.N + col0 + bj * HALF + 4 * n);
#pragma unroll
    for (int ai = 0; ai < 2; ++ai)
#pragma unroll
        for (int m = 0; m < 4; ++m) { const int row = row0 + ai * HALF + m * 16; const float sr = g.sa[row];
#pragma unroll
            for (int bj = 0; bj < 2; ++bj) E.store8(row, col0 + bj * HALF, __builtin_convertvector(acc[ai][bj][m][0], f32x4) * (cs[bj][0] * sr), __builtin_convertvector(acc[ai][bj][m][1], f32x4) * (cs[bj][1] * sr)); }
}
__device__ __forceinline__ void mma16(f32x4& c, const bf16x8 b, const bf16x8 a) { c = __builtin_amdgcn_mfma_f32_16x16x32_bf16(b, a, c, 0, 0, 0); }
__device__ __forceinline__ void mma16(i32x4& c, const bf16x8 b, const bf16x8 a) { c = __builtin_amdgcn_mfma_i32_16x16x64_i8(__builtin_bit_cast(i32x4, b), __builtin_bit_cast(i32x4, a), c, 0, 0, 0); }
template <bool I8> struct AccT { typedef f32x4 type; };
template <> struct AccT<true> { typedef i32x4 type; };

template <class Epi, class Sched, bool ALIGN_EPI = true, bool I8 = false>
__device__ __forceinline__ void gemm_phase(PG8_LAS unsigned char* lds, const Gemm g, const Sched& S, const Epi& E) {
    int tid = threadIdx.x; asm volatile("" : "+v"(tid));
    const int wid = __builtin_amdgcn_readfirstlane(tid >> 6), lane = tid & 63, wr = wid >> 2, wc = wid & 3, fr = lane & 15, fq = lane >> 4;
    const int K = g.K, nt = K / BK;
    unsigned voffA[2], voffB[2];
#pragma unroll
    for (int i = 0; i < 2; ++i) { int R, C; stage_rc(tid * 16 + i * 8192, R, C); const int Rb = (R & ~31) + perm32(R & 31);
        voffA[i] = (unsigned)(R * K + C) * 2u; voffB[i] = (unsigned)(Rb * K + C) * 2u; }
    const size_t kstep = (size_t)(BK * 2);
    const size_t hstep = (size_t)HALF * K * 2;
    const size_t tstep = 2 * hstep;
    const unsigned ldsw = (unsigned)wid * 1024u;
    const int aoff = lds_byte(wr * 64 + fr, fq * 8), boff = lds_byte(wc * 32 + fr, fq * 8);
#define PG8_SA(b, h) (((b) * 2 + (h)) * HTB)
#define PG8_SB(b, h) ((4 + (b) * 2 + (h)) * HTB)
#define PG8_STAGE(bufoff, gbase, voff) do { _Pragma("unroll") for (int _i = 0; _i < 2; ++_i) \
        __builtin_amdgcn_global_load_lds((const unsigned*)((const char*)(gbase) + (voff)[_i]), (PG8_LAS unsigned*)(lds + (bufoff) + ldsw + _i * 8192), 16, 0, 0); } while (0)
#define PG8_LDA(dst, b, h) do { _Pragma("unroll") for (int m = 0; m < 4; ++m) _Pragma("unroll") for (int k = 0; k < 2; ++k) dst[m][k] = *(const PG8_LAS bf16x8*)(lds + PG8_SA(b, h) + aoff + m * 2048 + k * 1024); } while (0)
#define PG8_LDB(dst, b, h) do { _Pragma("unroll") for (int n = 0; n < 2; ++n) _Pragma("unroll") for (int k = 0; k < 2; ++k) dst[n][k] = *(const PG8_LAS bf16x8*)(lds + PG8_SB(b, h) + boff + n * 2048 + k * 1024); } while (0)
#define PG8_MMA(ai, bj, At, Bt) do { __builtin_amdgcn_s_setprio(1); _Pragma("unroll") for (int m = 0; m < 4; ++m) _Pragma("unroll") for (int n = 0; n < 2; ++n) _Pragma("unroll") for (int k = 0; k < 2; ++k) \
        mma16(acc[ai][bj][m][n], Bt[n][k], At[m][k]); __builtin_amdgcn_s_setprio(0); } while (0)
#define PG8_WAIT_V(n) asm volatile("s_waitcnt vmcnt(" #n ")" ::: "memory")
#define PG8_WAIT_L(n) asm volatile("s_waitcnt lgkmcnt(" #n ")" ::: "memory")
#define PG8_BAR __builtin_amdgcn_s_barrier()
#define PG8_SCHED __builtin_amdgcn_sched_barrier(0)
    Unit cur, nxt; int ui = 0;
    if (!S.next(0, cur)) return;
    typedef typename AccT<I8>::type acc_t;
    acc_t acc[2][2][4][2];
#pragma unroll
    for (int a = 0; a < 2; ++a)
#pragma unroll
        for (int b = 0; b < 2; ++b)
#pragma unroll
            for (int m = 0; m < 4; ++m)
#pragma unroll
                for (int n = 0; n < 2; ++n) acc[a][b][m][n] = (acc_t){0, 0, 0, 0};
    bf16x8 At[4][2], B0[2][2], B1[2][2];
    const char* cA = (const char*)g.A + (size_t)cur.pm * tstep; const char* cB = (const char*)g.Bt + (size_t)cur.e * g.estride + (size_t)cur.pn * tstep;
    PG8_STAGE(PG8_SB(0, 0), cB, voffB); PG8_STAGE(PG8_SB(0, 1), cB + hstep, voffB); PG8_STAGE(PG8_SA(0, 0), cA, voffA); PG8_STAGE(PG8_SA(0, 1), cA + hstep, voffA);
    if (wr == 1) PG8_BAR;
    PG8_WAIT_V(2); PG8_BAR;
    PG8_STAGE(PG8_SB(1, 0), cB + kstep, voffB); PG8_STAGE(PG8_SA(1, 0), cA + kstep, voffA); PG8_STAGE(PG8_SB(1, 1), cB + hstep + kstep, voffB);
    PG8_WAIT_V(6); PG8_BAR;
    for (;;) {
        const bool has_next = S.next(ui + 1, nxt);
        const char* nA = has_next ? (const char*)g.A + (size_t)nxt.pm * tstep : cA; const char* nB = has_next ? (const char*)g.Bt + (size_t)nxt.e * g.estride + (size_t)nxt.pn * tstep : cB;
        for (int t = 0; t < nt; t += 2) {
            const bool last = (t == nt - 2);
            const char* a1 = cA + (size_t)(t + 1) * kstep;
            const char* a2 = last ? nA : cA + (size_t)(t + 2) * kstep; const char* b2 = last ? nB : cB + (size_t)(t + 2) * kstep;
            const char* a3 = a2 + kstep; const char* b3 = b2 + kstep;
            PG8_LDB(B0, 0, 0); PG8_LDB(B1, 0, 1); PG8_SCHED; PG8_LDA(At, 0, 0); PG8_STAGE(PG8_SA(1, 1), a1 + hstep, voffA);
            PG8_WAIT_V(8); PG8_WAIT_L(0); PG8_BAR; PG8_MMA(0, 0, At, B0); PG8_MMA(0, 1, At, B1); PG8_BAR; PG8_SCHED;
            PG8_LDA(At, 0, 1); PG8_STAGE(PG8_SB(0, 0), b2, voffB); PG8_STAGE(PG8_SB(0, 1), b2 + hstep, voffB); PG8_STAGE(PG8_SA(0, 0), a2, voffA);
            PG8_WAIT_V(8); PG8_WAIT_L(0); PG8_BAR; PG8_MMA(1, 0, At, B0); PG8_MMA(1, 1, At, B1); PG8_BAR; PG8_SCHED;
            PG8_LDB(B0, 1, 0); PG8_LDB(B1, 1, 1); PG8_SCHED; PG8_LDA(At, 1, 0); PG8_STAGE(PG8_SA(0, 1), a2 + hstep, voffA);
            PG8_WAIT_V(8); PG8_WAIT_L(0); PG8_BAR; PG8_MMA(0, 0, At, B0); PG8_MMA(0, 1, At, B1); PG8_BAR; PG8_SCHED;
            PG8_LDA(At, 1, 1); PG8_STAGE(PG8_SB(1, 0), b3, voffB); PG8_STAGE(PG8_SB(1, 1), b3 + hstep, voffB); PG8_STAGE(PG8_SA(1, 0), a3, voffA);
            PG8_WAIT_V(8); PG8_WAIT_L(0); PG8_BAR; PG8_MMA(1, 0, At, B0); PG8_MMA(1, 1, At, B1); PG8_BAR; PG8_SCHED;
        }
        if constexpr (ALIGN_EPI) { if (wr == 0) PG8_BAR; }
        run_epi(E, acc, cur, wr, wc, fr, fq, g);
        if (!has_next) break;
#pragma unroll
        for (int a = 0; a < 2; ++a)
#pragma unroll
            for (int b = 0; b < 2; ++b)
#pragma unroll
                for (int m = 0; m < 4; ++m)
#pragma unroll
                    for (int n = 0; n < 2; ++n) acc[a][b][m][n] = (acc_t){0, 0, 0, 0};
        cur = nxt; cA = nA; cB = nB; ++ui;
        if constexpr (ALIGN_EPI) { if (wr == 1) PG8_BAR; }
    }
    PG8_WAIT_V(0);
    if constexpr (!ALIGN_EPI) { if (wr == 0) PG8_BAR; }
    PG8_BAR;
#undef PG8_SA
#undef PG8_SB
#undef PG8_STAGE
#undef PG8_LDA
#undef PG8_LDB
#undef PG8_MMA
#undef PG8_WAIT_V
#undef PG8_WAIT_L
#undef PG8_BAR
#undef PG8_SCHED
}

}

__device__ __forceinline__ v4u pack8(const f32x4 a, const f32x4 b) { v4u w; w.x = pk2(a[0], a[1]); w.y = pk2(a[2], a[3]); w.z = pk2(b[0], b[1]); w.w = pk2(b[2], b[3]); return w; }
__device__ __forceinline__ void unpack8(const v4u w, f32x4& a, f32x4& b) { a = (f32x4){bf_lo(w.x), bf_hi(w.x), bf_lo(w.y), bf_hi(w.y)}; b = (f32x4){bf_lo(w.z), bf_hi(w.z), bf_lo(w.w), bf_hi(w.w)}; }

struct EpiQKV { bf16* QKV;
    __device__ __forceinline__ void store8(int row, int col, f32x4 v0, f32x4 v1) const {
        const int which = col / AW, rem = col - which * AW, hh = rem >> 6, dim0 = rem & 63, sh = 2 * (hh >> 3);
        const int b = row >> 11, s = row & 2047, pos = ((s & ((1 << sh) - 1)) << (11 - sh)) | (s >> sh);
        if (which == 0) { v0 = v0 * QSCALE; v1 = v1 * QSCALE; }
        *(GAS v4u*)(QKV + ((((size_t)(which * NB + b) * NHEAD + hh) * S + pos) * HD + dim0)) = pack8(v0, v1);
    } };
struct EpiXYG { bf16* XR;
    __device__ __forceinline__ void store8(int row, int col, f32x4 v0, f32x4 v1) const {
        const int blk = col >> 10, c = col & 1023;
        if (blk == 1) {
#pragma unroll
            for (int j = 0; j < 4; ++j) { v0[j] = gelu_tanh_f(v0[j]); v1[j] = gelu_tanh_f(v1[j]); } }
        else if (blk >= 2) {
#pragma unroll
            for (int j = 0; j < 4; ++j) { v0[j] = sigmoid_f(v0[j]); v1[j] = sigmoid_f(v1[j]); } }
        bf16* dst = XR + (size_t)blk * ((size_t)T * D) + (size_t)row * D + c;
        *(GAS v4u*)dst = pack8(v0, v1);
    } };
struct EpiP4a { bf16* GA;
    __device__ __forceinline__ void store8(int row, int col, f32x4 v0, f32x4 v1) const {
        GAS v4u* p = (GAS v4u*)(GA + (size_t)row * D + col); f32x4 g0, g1; unpack8(*p, g0, g1);
        *p = pack8(g0 * v0, g1 * v1);
    } };
struct EpiP4b { const bf16* TMP; bf16* GL;
    __device__ __forceinline__ void store8(int row, int col, f32x4 v0, f32x4 v1) const {
        GAS v4u* p = (GAS v4u*)(GL + (size_t)row * D + col); f32x4 g0, g1, t0, t1; unpack8(*p, g0, g1); unpack8(*(const GAS v4u*)(TMP + (size_t)row * D + col), t0, t1);
        *p = pack8(t0 + g0 * v0, t1 + g1 * v1);
    } };
struct EpiP5 { const float* X; const float* MOD; float* X1;
    __device__ __forceinline__ void store8(int row, int col, f32x4 v0, f32x4 v1) const {
        const int b = row >> 11; const float* gp = MOD + b * 6144 + 2048 + col; const float* xp = X + (size_t)row * D + col;
        const f32x4 g0 = *(const GAS f32x4*)gp, g1 = *(const GAS f32x4*)(gp + 4), x0 = *(const GAS f32x4*)xp, x1 = *(const GAS f32x4*)(xp + 4);
        GAS f32x4* o = (GAS f32x4*)(X1 + (size_t)row * D + col);
        o[0] = x0 + (g0 + 1.0f) * v0; o[1] = x1 + (g1 + 1.0f) * v1;
    } };
struct EpiMoeA { bf16* HB;
    __device__ __forceinline__ void store8(int row, int col, f32x4 v0, f32x4 v1) const {
        f32x4 r;
#pragma unroll
        for (int j = 0; j < 4; ++j) r[j] = v0[j] * sigmoid_f(v0[j]) * v1[j];
        v2u w; w.x = pk2(r[0], r[1]); w.y = pk2(r[2], r[3]);
        *(GAS v2u*)(HB + (size_t)row * DE + (col >> 1)) = w;
    } };
struct EpiMoeB { bf16* Y;
    __device__ __forceinline__ void store8(int row, int col, f32x4 v0, f32x4 v1) const { *(GAS v4u*)(Y + (size_t)row * D + col) = pack8(v0, v1); } };

#define XB_TMO      128
#define XB_XCNT(j)  (256  + 64 * (j))
#define XB_XSUB(j)  (1280 + 64 * (j))
#define XB_XGEN(j)  (2304 + 64 * (j))
#define XB_TOP      3328
#define XB_TOPGEN   3392
#define XCD_BAR_WORDS 3456
#define XB_SPIN_CAP (1u << 20)
__device__ __forceinline__ unsigned xb_ld(unsigned* p)              { return __hip_atomic_load(p, __ATOMIC_RELAXED, __HIP_MEMORY_SCOPE_AGENT); }
__device__ __forceinline__ unsigned xb_add(unsigned* p, unsigned v) { return __hip_atomic_fetch_add(p, v, __ATOMIC_RELAXED, __HIP_MEMORY_SCOPE_AGENT); }
__device__ __forceinline__ unsigned xb_xcc_id() { return (unsigned)__builtin_amdgcn_s_getreg((3 << 11) | 20) & 0xFu; }
#define XB_SPIN(cond, bar) do { unsigned _sp = 0; while (cond) { __builtin_amdgcn_s_sleep(1); \
    if ((++_sp & 255u) == 0u) { if (xb_ld(&(bar)[XB_TMO])) break; if (_sp > XB_SPIN_CAP) { atomicAdd(&(bar)[XB_TMO], 1u); break; } } } } while (0)
struct XcdBarrier { unsigned* bar; unsigned x; volatile LAS unsigned* st; };
__device__ __forceinline__ XcdBarrier xcd_barrier_post(unsigned* bar, volatile LAS unsigned* st) {
    XcdBarrier b; b.bar = bar; b.x = xb_xcc_id(); b.st = st;
    if (threadIdx.x == 0) (void)xb_add(&bar[XB_XCNT(b.x)], 1u);
    return b;
}
__device__ __forceinline__ void xcd_barrier_complete(unsigned* bar, unsigned x, unsigned& nloc, unsigned& nx) {
    const unsigned G = gridDim.x * gridDim.y * gridDim.z;
    unsigned sum, cnt, mine, sp = 0u;
    for (;;) {
        sum = 0u; cnt = 0u; mine = 0u;
#pragma unroll
        for (unsigned j = 0; j < 16; ++j) { const unsigned c = xb_ld(&bar[XB_XCNT(j)]); sum += c; cnt += (c > 0u) ? 1u : 0u; mine = (j == x) ? c : mine; }
        if (sum == G) break;
        __builtin_amdgcn_s_sleep(1);
        if ((++sp & 255u) == 0u) { if (xb_ld(&bar[XB_TMO])) break; if (sp > XB_SPIN_CAP) { atomicAdd(&bar[XB_TMO], 1u); break; } }
    }
    nloc = mine > 0u ? mine : 1u; nx = cnt > 0u ? cnt : 1u;
}
__device__ __forceinline__ void xcd_barrier(const XcdBarrier& b) {
    asm volatile("s_waitcnt vmcnt(0)" ::: "memory");
    __syncthreads();
    if (threadIdx.x == 0) {
        unsigned* bar = b.bar;
        __builtin_amdgcn_s_waitcnt(0);
        unsigned nloc = b.st[0], nx = b.st[1];
        if (nloc == 0u) { xcd_barrier_complete(bar, b.x, nloc, nx); b.st[0] = nloc; b.st[1] = nx; }
        const unsigned old = xb_add(&bar[XB_XSUB(b.x)], 1u);
        const unsigned gen = old / nloc;
        if (old + 1u == (gen + 1u) * nloc) {
            __builtin_amdgcn_fence(__ATOMIC_RELEASE, "agent");
            asm volatile("s_waitcnt vmcnt(0)" ::: "memory");
            const unsigned og = xb_add(&bar[XB_TOP], 1u);
            const unsigned tg = og / nx;
            if (og + 1u == (tg + 1u) * nx) xb_add(&bar[XB_TOPGEN], 1u);
            else XB_SPIN(xb_ld(&bar[XB_TOPGEN]) == tg, bar);
            __builtin_amdgcn_fence(__ATOMIC_ACQUIRE, "agent");
            xb_add(&bar[XB_XGEN(b.x)], 1u);
            asm volatile("s_waitcnt vmcnt(0)" ::: "memory");
        } else {
            XB_SPIN(xb_ld(&bar[XB_XGEN(b.x)]) == gen, bar);
            __builtin_amdgcn_fence(__ATOMIC_ACQUIRE, "agent");
            asm volatile("s_waitcnt vmcnt(0)" ::: "memory");
        }
    }
    __syncthreads();
}

struct Args { const float* in[25]; float* out; unsigned char* ws; int ph_lo, ph_hi; };
struct Frame {
    LAS unsigned char* lds; volatile LAS unsigned* MISC; gu32* ctl;
    int tid, lane, wave, vcu, G;
};

__device__ __forceinline__ void p0_transpose_item(const float* W, int K, int N, bf16* WT, int row_off, int mode, LAS float* scr, int item, int lane) {
    const int nblk = N / 32, kb = item / nblk, nb = item % nblk, k0 = 64 * kb, n0 = 32 * nb;
#pragma unroll 8
    for (int i = 0; i < 32; ++i) { const int kk = 2 * i + (lane >> 5); scr[kk * 33 + (lane & 31)] = W[(size_t)(k0 + kk) * N + n0 + (lane & 31)]; }
    LDS_WAIT(); asm volatile("" ::: "memory");
    const int c = lane & 7;
#pragma unroll
    for (int j = 0; j < 4; ++j) { const int n = (lane >> 3) + 8 * j; const LAS float* s = scr + (8 * c) * 33 + n;
        v4u o; o.x = pk2(s[0 * 33], s[1 * 33]); o.y = pk2(s[2 * 33], s[3 * 33]); o.z = pk2(s[4 * 33], s[5 * 33]); o.w = pk2(s[6 * 33], s[7 * 33]);
        const int nn = n0 + n; const int r = mode == 0 ? row_off + nn : row_off + 8 * (nn >> 2) + (nn & 3) + (mode == 2 ? 4 : 0);
        *(GAS v4u*)(WT + (size_t)r * K + k0 + 8 * c) = o; }
    LDS_WAIT(); asm volatile("" ::: "memory");
}
__device__ __forceinline__ unsigned q4(float a, float b, float c, float d) {
    const int ia = (int)__builtin_rintf(fminf(fmaxf(a, -127.f), 127.f)), ib = (int)__builtin_rintf(fminf(fmaxf(b, -127.f), 127.f)), ic = (int)__builtin_rintf(fminf(fmaxf(c, -127.f), 127.f)), id = (int)__builtin_rintf(fminf(fmaxf(d, -127.f), 127.f));
    return (unsigned)(ia & 255) | ((unsigned)(ib & 255) << 8) | ((unsigned)(ic & 255) << 16) | ((unsigned)id << 24);
}
template <int KROWS, bool QUANT>
__device__ __forceinline__ void p0_strip(const float* W, int N, int n0, void* WT, int rowbase, int mode, float* sb, LAS unsigned char* lds, int tid) {
    constexpr int RPT = KROWS / 64;
    const int c4 = tid & 7, rq = tid >> 3;
    f32x4 v[RPT];
#pragma unroll
    for (int i = 0; i < RPT; ++i) v[i] = *(const GAS f32x4*)(W + (size_t)(rq * RPT + i) * N + n0 + 4 * c4);
    int rr[4];
#pragma unroll
    for (int j = 0; j < 4; ++j) { const int n = n0 + 4 * c4 + j; rr[j] = mode == 0 ? rowbase + n : rowbase + 8 * (n >> 2) + (n & 3) + (mode == 2 ? 4 : 0); }
    if constexpr (QUANT) {
        f32x4 m = (f32x4){0.f, 0.f, 0.f, 0.f};
#pragma unroll
        for (int i = 0; i < RPT; ++i) { m.x = fmaxf(m.x, fabsf(v[i].x)); m.y = fmaxf(m.y, fabsf(v[i].y)); m.z = fmaxf(m.z, fabsf(v[i].z)); m.w = fmaxf(m.w, fabsf(v[i].w)); }
        LAS f32x4* cm = (LAS f32x4*)lds; LAS float* scl = (LAS float*)(lds + 8192);
        cm[rq * 8 + c4] = m;
        __syncthreads();
        if (tid < 32) { float mx = 0.f; const LAS float* cf = (const LAS float*)lds;
            for (int q = 0; q < 64; ++q) mx = fmaxf(mx, cf[q * 32 + tid]);
            scl[tid] = mx;
            const int n = n0 + tid; const int r = mode == 0 ? rowbase + n : rowbase + 8 * (n >> 2) + (n & 3) + (mode == 2 ? 4 : 0);
            sb[r] = mx * (1.0f / 127.0f); }
        __syncthreads();
#pragma unroll
        for (int j = 0; j < 4; ++j) { const float mx = scl[4 * c4 + j], inv = mx > 0.f ? 127.0f / mx : 0.f;
            static_assert(RPT == 16, "int8 strips are 1024 rows");
            v4u o; o.x = q4(v[0][j] * inv, v[1][j] * inv, v[2][j] * inv, v[3][j] * inv); o.y = q4(v[4][j] * inv, v[5][j] * inv, v[6][j] * inv, v[7][j] * inv);
            o.z = q4(v[8][j] * inv, v[9][j] * inv, v[10][j] * inv, v[11][j] * inv); o.w = q4(v[12][j] * inv, v[13][j] * inv, v[14][j] * inv, v[15][j] * inv);
            *(GAS v4u*)((signed char*)WT + (size_t)rr[j] * KROWS + rq * RPT) = o; }
        __syncthreads();
    } else {
#pragma unroll
        for (int j = 0; j < 4; ++j)
#pragma unroll
            for (int h = 0; h < RPT / 8; ++h) { v4u o; o.x = pk2(v[8 * h][j], v[8 * h + 1][j]); o.y = pk2(v[8 * h + 2][j], v[8 * h + 3][j]); o.z = pk2(v[8 * h + 4][j], v[8 * h + 5][j]); o.w = pk2(v[8 * h + 6][j], v[8 * h + 7][j]);
                *(GAS v4u*)((bf16*)WT + (size_t)rr[j] * KROWS + rq * RPT + 8 * h) = o; }
    }
}
__device__ __forceinline__ void p0_prologue(Frame& F, const Args& a) {
    unsigned char* ws = a.ws;
    constexpr int S_IN = IN_COLS / 32, S_E13 = DE / 32, S_E2 = D / 32, S_D = D / 32;
    constexpr int N_IN = S_IN, N_13 = 2 * NE * S_E13, N_2 = NE * S_E2, NITEMS = N_IN + N_13 + N_2 + 3 * S_D;
    for (int it = F.vcu; it < NITEMS; it += F.G) {
        int r = it;
        if (r < N_IN) { p0_strip<1024, true>(a.in[5], IN_COLS, 32 * r, ws + WS_WIN_T, 0, 0, (float*)(ws + WS_SB_IN), F.lds, F.tid); continue; } r -= N_IN;
        if (r < N_13) { const int mat = r / S_E13, st = r % S_E13, e = mat >> 1, which = mat & 1;
            p0_strip<1024, true>(a.in[21 + which] + (size_t)e * D * DE, DE, 32 * st, ws + WS_W13_T, e * 1024, 1 + which, (float*)(ws + WS_SB_13), F.lds, F.tid); continue; } r -= N_13;
        if (r < N_2) { const int e = r / S_E2, st = r % S_E2; p0_strip<512, false>(a.in[23] + (size_t)e * DE * D, D, 32 * st, ws + WS_W2_T, e * 1024, 0, nullptr, F.lds, F.tid); continue; } r -= N_2;
        if (r < S_D) { p0_strip<512, false>(a.in[13], D, 32 * r, ws + WS_WAO_T, 0, 0, nullptr, F.lds, F.tid); continue; } r -= S_D;
        if (r < S_D) { p0_strip<1024, false>(a.in[14], D, 32 * r, ws + WS_WLO_T, 0, 0, nullptr, F.lds, F.tid); continue; } r -= S_D;
        p0_strip<1024, false>(a.in[15], D, 32 * r, ws + WS_WOUT_T, 0, 0, nullptr, F.lds, F.tid);
    }
    if (F.vcu < 192) {
        __syncthreads();
        const float* c = a.in[1]; const float* wm = a.in[2]; const float* bm = a.in[3]; float* MOD = (float*)(ws + WS_MOD);
        LAS float* CA = (LAS float*)F.lds;
        LAS float* PART = (LAS float*)(F.lds + 65536);
        for (int i = F.tid; i < NB * D; i += NTHREADS) { const float v = c[i]; CA[i] = v * sigmoid_f(v); }
        __syncthreads();
        const int kq = F.tid >> 5, col = F.tid & 31, n = F.vcu * 32 + col;
        float acc[NB];
#pragma unroll
        for (int b = 0; b < NB; ++b) acc[b] = 0.f;
#pragma unroll 4
        for (int i = 0; i < 64; ++i) { const int k = kq + 16 * i; const float w = wm[(size_t)k * 6144 + n];
#pragma unroll
            for (int b = 0; b < NB; ++b) acc[b] += CA[b * D + k] * w; }
#pragma unroll
        for (int b = 0; b < NB; ++b) PART[(kq * NB + b) * 32 + col] = acc[b];
        __syncthreads();
        { const int b = F.tid >> 5; float sum = bm[n];
#pragma unroll
            for (int q = 0; q < 16; ++q) sum += PART[(q * NB + b) * 32 + col];
            MOD[b * 6144 + n] = sum; }
        __syncthreads();
    }
}
__device__ __forceinline__ void norm_mod_row(const float* xrow, const float* g, const float* shift, const float* scale, int lane, f32x4 (&h)[4]) {
    const GAS f32x4* xr = (const GAS f32x4*)xrow + lane; float ss = 0.f;
#pragma unroll
    for (int j = 0; j < 4; ++j) { h[j] = xr[64 * j]; ss += (h[j].x * h[j].x + h[j].y * h[j].y) + (h[j].z * h[j].z + h[j].w * h[j].w); }
    const float rstd = 1.0f / sqrtf(wave_sum(ss) * (1.0f / D) + EPS);
#pragma unroll
    for (int j = 0; j < 4; ++j) { const f32x4 gg = ((const GAS f32x4*)g + lane)[64 * j], sc = ((const GAS f32x4*)scale + lane)[64 * j], sf = ((const GAS f32x4*)shift + lane)[64 * j];
        h[j] = h[j] * rstd * gg * (sc + 1.0f) + sf; }
}
__device__ __forceinline__ void store_row_bf16(bf16* orow, int lane, const f32x4 (&h)[4]) {
    GAS v2u* o8 = (GAS v2u*)orow + lane;
#pragma unroll
    for (int j = 0; j < 4; ++j) { v2u w; w.x = pk2(h[j].x, h[j].y); w.y = pk2(h[j].z, h[j].w); o8[64 * j] = w; }
}
__device__ __forceinline__ float wave_max(float v) {
#pragma unroll
    for (int o = 1; o < 64; o <<= 1) v = fmaxf(v, __shfl_xor(v, o));
    return v;
}
__device__ __forceinline__ void store_row_i8(signed char* orow, float* sarow, int lane, const f32x4 (&h)[4]) {
    float mx = 0.f;
#pragma unroll
    for (int j = 0; j < 4; ++j) mx = fmaxf(fmaxf(mx, fmaxf(fabsf(h[j].x), fabsf(h[j].y))), fmaxf(fabsf(h[j].z), fabsf(h[j].w)));
    mx = wave_max(mx);
    const float inv = mx > 0.f ? 127.0f / mx : 0.f;
    GAS unsigned* o4 = (GAS unsigned*)orow + lane;
#pragma unroll
    for (int j = 0; j < 4; ++j) o4[64 * j] = q4(h[j].x * inv, h[j].y * inv, h[j].z * inv, h[j].w * inv);
    if (lane == 0) *sarow = mx * (1.0f / 127.0f);
}
__device__ __forceinline__ void p1_norm1(Frame& F, const Args& a) {
    unsigned char* ws = a.ws;
    const int gw = F.vcu * NWAVES + F.wave, NGW = F.G * NWAVES;
    const float* MOD = (const float*)(ws + WS_MOD); signed char* H = (signed char*)(ws + WS_H); float* SA = (float*)(ws + WS_SAH);
    for (int m = gw; m < T; m += NGW) { const int b = m >> 11; f32x4 h[4];
        norm_mod_row(a.in[0] + (size_t)m * D, a.in[4], MOD + b * 6144, MOD + b * 6144 + 1024, F.lane, h);
        store_row_i8(H + (size_t)m * D, SA + m, F.lane, h); }
}
typedef float f32x16 __attribute__((ext_vector_type(16)));
typedef short v4i16_t __attribute__((ext_vector_type(4)));
__device__ __forceinline__ void attn_tile(const bf16x8 (&Kf)[4], const bf16x8 (&Qf)[4], LAS unsigned char* vl, unsigned trbase, int r, int hi, bool causal, bool lower, f32x16 (&O)[2], float& m, float& l) {
    f32x16 sc;
#pragma unroll
    for (int i = 0; i < 16; ++i) sc[i] = 0.f;
#pragma unroll
    for (int kk = 0; kk < 4; ++kk) sc = __builtin_amdgcn_mfma_f32_32x32x16_bf16(Kf[kk], Qf[kk], sc, 0, 0, 0);
    if (causal) {
#pragma unroll
        for (int i = 0; i < 16; ++i) { const int key = 8 * (i >> 2) + 4 * hi + (i & 3); sc[i] = key > r ? -1e30f : sc[i]; } }
    if (lower) {
#pragma unroll
        for (int i = 0; i < 16; ++i) { const int key = 8 * (i >> 2) + 4 * hi + (i & 3); sc[i] = key < r ? -1e30f : sc[i]; } }
    float mx = sc[0];
#pragma unroll
    for (int i = 1; i < 16; ++i) mx = fmaxf(mx, sc[i]);
    mx = fmaxf(mx, __shfl_xor(mx, 32));
    const float mn = fmaxf(m, mx), al = __builtin_amdgcn_exp2f(m - mn); m = mn;
    float ps = 0.f;
#pragma unroll
    for (int i = 0; i < 16; ++i) { sc[i] = __builtin_amdgcn_exp2f(sc[i] - mn); ps += sc[i]; }
    l = l * al + ps;
#pragma unroll
    for (int dt = 0; dt < 2; ++dt)
#pragma unroll
        for (int i = 0; i < 16; ++i) O[dt][i] *= al;
    bf16x8 Pf[2];
#pragma unroll
    for (int st = 0; st < 2; ++st) { v4u w; w.x = pk2(sc[8 * st], sc[8 * st + 1]); w.y = pk2(sc[8 * st + 2], sc[8 * st + 3]); w.z = pk2(sc[8 * st + 4], sc[8 * st + 5]); w.w = pk2(sc[8 * st + 6], sc[8 * st + 7]);
        Pf[st] = __builtin_bit_cast(bf16x8, w); }
#pragma unroll
    for (int st = 0; st < 2; ++st)
#pragma unroll
        for (int dt = 0; dt < 2; ++dt) {
            const v4i16_t lo = __builtin_amdgcn_ds_read_tr16_b64_v4i16((LAS v4i16_t*)(vl + dt * 2048 + st * 1024 + trbase));
            const v4i16_t hh = __builtin_amdgcn_ds_read_tr16_b64_v4i16((LAS v4i16_t*)(vl + dt * 2048 + st * 1024 + 512 + trbase));
            bf16x8 Vf; Vf[0] = lo[0]; Vf[1] = lo[1]; Vf[2] = lo[2]; Vf[3] = lo[3]; Vf[4] = hh[0]; Vf[5] = hh[1]; Vf[6] = hh[2]; Vf[7] = hh[3];
            O[dt] = __builtin_amdgcn_mfma_f32_32x32x16_bf16(Vf, Pf[st], O[dt], 0, 0, 0); }
}
__device__ __forceinline__ void attn_q64(const bf16* Qs, const bf16* Ks, const bf16* Vs, int i0, LAS unsigned char* vl, int lane, f32x16 (&OA)[2], float& lseA, f32x16 (&OB)[2], float& lseB) {
    const int r = lane & 31, hi = lane >> 5;
    const int ktA = i0 >> 5, kt0 = ktA - 4 < 0 ? 0 : ktA - 4, ktl = ktA + 1;
    const int koff = r * HD + 8 * hi, voff = (lane >> 3) * HD + 8 * (lane & 7);
    const unsigned vlw = (unsigned)(((lane & 7) >> 2) * 2048 + (lane >> 3) * 64 + (lane & 3) * 16);
    v4u Kn[4], Vn[4];
#pragma unroll
    for (int kk = 0; kk < 4; ++kk) Kn[kk] = *(const GAS v4u*)(Ks + (size_t)(32 * kt0) * HD + koff + 16 * kk);
#pragma unroll
    for (int c4 = 0; c4 < 4; ++c4) Vn[c4] = *(const GAS v4u*)(Vs + (size_t)(32 * kt0 + 8 * c4) * HD + voff);
    bf16x8 QA[4], QB[4];
#pragma unroll
    for (int kk = 0; kk < 4; ++kk) { QA[kk] = __builtin_bit_cast(bf16x8, *(const GAS v4u*)(Qs + (size_t)(i0 + r) * HD + 16 * kk + 8 * hi));
        QB[kk] = __builtin_bit_cast(bf16x8, *(const GAS v4u*)(Qs + (size_t)(i0 + 32 + r) * HD + 16 * kk + 8 * hi)); }
#pragma unroll
    for (int dt = 0; dt < 2; ++dt)
#pragma unroll
        for (int i = 0; i < 16; ++i) { OA[dt][i] = 0.f; OB[dt][i] = 0.f; }
    float mA = -1e30f, lA = 0.f, mB = -1e30f, lB = 0.f;
    const unsigned trbase = (unsigned)((4 * hi + ((lane & 15) >> 2)) * 64 + (16 * ((lane >> 4) & 1) + 4 * (lane & 3)) * 2);
    for (int kt = kt0; kt <= ktl; ++kt) {
        bf16x8 Kf[4];
#pragma unroll
        for (int kk = 0; kk < 4; ++kk) Kf[kk] = __builtin_bit_cast(bf16x8, Kn[kk]);
#pragma unroll
        for (int c4 = 0; c4 < 4; ++c4) *(LAS v4u*)(vl + vlw + c4 * 512) = Vn[c4];
        if (kt < ktl) {
#pragma unroll
            for (int kk = 0; kk < 4; ++kk) Kn[kk] = *(const GAS v4u*)(Ks + (size_t)(32 * (kt + 1)) * HD + koff + 16 * kk);
#pragma unroll
            for (int c4 = 0; c4 < 4; ++c4) Vn[c4] = *(const GAS v4u*)(Vs + (size_t)(32 * (kt + 1) + 8 * c4) * HD + voff);
        }
        if (kt <= ktA) attn_tile(Kf, QA, vl, trbase, r, hi, kt == ktA, kt == ktA - 4, OA, mA, lA);
        if (kt >= ktA - 3) attn_tile(Kf, QB, vl, trbase, r, hi, kt == ktA + 1, kt == ktA - 3, OB, mB, lB);
    }
    { const float lt = lA + __shfl_xor(lA, 32), inv = fast_rcp(lt); lseA = mA + __builtin_amdgcn_logf(lt);
#pragma unroll
      for (int dt = 0; dt < 2; ++dt)
#pragma unroll
          for (int i = 0; i < 16; ++i) OA[dt][i] *= inv; }
    { const float lt = lB + __shfl_xor(lB, 32), inv = fast_rcp(lt); lseB = mB + __builtin_amdgcn_logf(lt);
#pragma unroll
      for (int dt = 0; dt < 2; ++dt)
#pragma unroll
          for (int i = 0; i < 16; ++i) OB[dt][i] *= inv; }
}
template <bool MERGE, bool LAST>
__device__ __forceinline__ void attn_store(bf16* ATT, float* LSE, int tok0, int tstride, int slot, int lane, LAS unsigned char* ost, f32x16 (&O)[2], float lse2) {
    const int r = lane & 31, hi = lane >> 5, rrow = lane >> 3, chunk = lane & 7;
    LAS unsigned char* mine = ost + r * 144 + 8 * hi;
    if (MERGE) {
#pragma unroll
        for (int it = 0; it < 4; ++it) { const int row = it * 8 + rrow;
            *(LAS v4u*)(ost + row * 144 + chunk * 16) = *(const GAS v4u*)(ATT + (size_t)(tok0 + row * tstride) * AOW + slot * HD + chunk * 8); }
        const float lp = LSE[(tok0 + r * tstride) * NSLOT + slot], M = fmaxf(lse2, lp), wa = __builtin_amdgcn_exp2f(lse2 - M), wb = __builtin_amdgcn_exp2f(lp - M), inv = fast_rcp(wa + wb), ca = wa * inv, cb = wb * inv;
        lse2 = M + __builtin_amdgcn_logf(wa + wb);
#pragma unroll
        for (int dt = 0; dt < 2; ++dt)
#pragma unroll
            for (int g = 0; g < 4; ++g) { const v2u w = *(const LAS v2u*)(mine + 64 * dt + 16 * g);
                O[dt][4 * g] = ca * O[dt][4 * g] + cb * bf_lo(w.x); O[dt][4 * g + 1] = ca * O[dt][4 * g + 1] + cb * bf_hi(w.x);
                O[dt][4 * g + 2] = ca * O[dt][4 * g + 2] + cb * bf_lo(w.y); O[dt][4 * g + 3] = ca * O[dt][4 * g + 3] + cb * bf_hi(w.y); }
    }
#pragma unroll
    for (int dt = 0; dt < 2; ++dt)
#pragma unroll
        for (int g = 0; g < 4; ++g) { v2u w; w.x = pk2(O[dt][4 * g], O[dt][4 * g + 1]); w.y = pk2(O[dt][4 * g + 2], O[dt][4 * g + 3]); *(LAS v2u*)(mine + 64 * dt + 16 * g) = w; }
#pragma unroll
    for (int it = 0; it < 4; ++it) { const int row = it * 8 + rrow;
        *(GAS v4u*)(ATT + (size_t)(tok0 + row * tstride) * AOW + slot * HD + chunk * 8) = *(const LAS v4u*)(ost + row * 144 + chunk * 16); }
    if (!LAST && hi == 0) LSE[(tok0 + r * tstride) * NSLOT + slot] = lse2;
}
__device__ __forceinline__ void p3_attention(Frame& F, const Args& a) {
    const bf16* QKV = (const bf16*)(a.ws + WS_QKV); bf16* ATT = (bf16*)a.out; float* LSE = (float*)(a.ws + WS_LSE);
    int lane = F.lane; asm volatile("" : "+v"(lane));
    const int w = F.wave;
    LAS unsigned char* vl = F.lds + w * 8960; LAS unsigned char* ost = vl + 4096;
    const size_t WSTR = (size_t)NB * NHEAD * S * HD;
    for (int item = F.vcu; item < NB * NSLOT * 2; item += F.G) {
        const int c = item & 1, slot = (item >> 1) & 7, b = item >> 4;
#pragma unroll 1
        for (int t = 0; t < 2; ++t) { int ln = lane; asm volatile("" : "+v"(ln) :: "memory"); const int ph = 2 * w + t, i0 = 64 * c; const bf16* Qs = QKV + (((size_t)b * NHEAD + 16 + slot) * S + ph * 128) * HD;
            f32x16 OA[2], OB[2]; float la, lb; attn_q64(Qs, Qs + WSTR, Qs + 2 * WSTR, i0, vl, ln, OA, la, OB, lb);
            attn_store<false, false>(ATT, LSE, b * S + i0 * 16 + ph, 16, slot, ln, ost, OA, la);
            attn_store<false, false>(ATT, LSE, b * S + (i0 + 32) * 16 + ph, 16, slot, ln, ost, OB, lb); }
        VM_WAIT(); __syncthreads(); __builtin_amdgcn_fence(__ATOMIC_ACQUIRE, "agent"); VM_WAIT();
#pragma unroll 1
        for (int t = 0; t < 2; ++t) { int ln = lane; asm volatile("" : "+v"(ln) :: "memory"); const int u = 2 * w + t, ph = u >> 2, i0 = 256 * c + 64 * (u & 3); const bf16* Qs = QKV + (((size_t)b * NHEAD + 8 + slot) * S + ph * 512) * HD;
            f32x16 OA[2], OB[2]; float la, lb; attn_q64(Qs, Qs + WSTR, Qs + 2 * WSTR, i0, vl, ln, OA, la, OB, lb);
            attn_store<true, false>(ATT, LSE, b * S + i0 * 4 + ph, 4, slot, ln, ost, OA, la);
            attn_store<true, false>(ATT, LSE, b * S + (i0 + 32) * 4 + ph, 4, slot, ln, ost, OB, lb); }
        VM_WAIT(); __syncthreads(); __builtin_amdgcn_fence(__ATOMIC_ACQUIRE, "agent"); VM_WAIT();
#pragma unroll 1
        for (int t = 0; t < 2; ++t) { int ln = lane; asm volatile("" : "+v"(ln) :: "memory"); const int i0 = 1024 * c + 64 * (2 * w + t); const bf16* Qs = QKV + (((size_t)b * NHEAD + slot) * S) * HD;
            f32x16 OA[2], OB[2]; float la, lb; attn_q64(Qs, Qs + WSTR, Qs + 2 * WSTR, i0, vl, ln, OA, la, OB, lb);
            attn_store<true, true>(ATT, LSE, b * S + i0, 1, slot, ln, ost, OA, la);
            attn_store<true, true>(ATT, LSE, b * S + i0 + 32, 1, slot, ln, ost, OB, lb); }
    }
    VM_WAIT(); __syncthreads();
}
__device__ __forceinline__ void p5_lru(Frame& F, const Args& a) {
    const bf16* XR = (const bf16*)(a.ws + WS_XR); const bf16* YR = (const bf16*)(a.ws + WS_YR); bf16* LRU = (bf16*)(a.ws + WS_LRU);
    LAS v4u* BF = (LAS v4u*)(F.lds);
    LAS float* CW = (LAS float*)(F.lds + 24576);
    LAS float* CARRY = (LAS float*)(F.lds + 24576 + 2048);
    volatile LAS int* FLAG = (volatile LAS int*)(F.lds + 24576 + 2048 + 65 * 256);
    int lane = F.lane; asm volatile("" : "+v"(lane));
    const int r = lane & 31, hi = lane >> 5, w = F.wave;
    const float LOG2E = 1.4426950408889634f;
    for (int item = F.vcu; item < NB * 16; item += F.G) {
        const int b = item >> 4, cb = item & 15;
        __syncthreads();
        for (int idx = F.tid; idx < 3 * 8 * 64; idx += NTHREADS) { const int l = idx & 63, f = idx >> 6, nt = f & 1, kk = (f >> 1) & 3, mat = f >> 3, rr = l & 31, hh = l >> 5, n = rr + 32 * nt;
            unsigned v[4];
#pragma unroll
            for (int jj = 0; jj < 4; ++jj) { float e[2];
#pragma unroll
                for (int q = 0; q < 2; ++q) { const int k = 16 * kk + 8 * hh + 2 * jj + q;
                    e[q] = mat == 0 ? a.in[8][(size_t)(cb * 64 + k) * 64 + n] : mat == 1 ? a.in[10][(size_t)(cb * 64 + k) * 64 + n] : (k == n ? 1.0f : 0.0f); }
                v[jj] = pk2(e[0], e[1]); }
            v4u o; o.x = v[0]; o.y = v[1]; o.z = v[2]; o.w = v[3]; BF[idx] = o; }
        for (int idx = F.tid; idx < 5 * 64; idx += NTHREADS) CW[idx] = idx < 256 ? a.in[6][(idx >> 6) * D + cb * 64 + (idx & 63)] : a.in[7][cb * 64 + (idx & 63)];
        if (F.tid < 65) FLAG[F.tid] = F.tid == 0 ? 1 : 0;
        if (F.tid < 64) CARRY[F.tid] = 0.f;
        __syncthreads();
        float bxv[2], bav[2], cav[2];
#pragma unroll
        for (int nt = 0; nt < 2; ++nt) { const int c = cb * 64 + r + 32 * nt; bxv[nt] = a.in[9][c]; bav[nt] = a.in[11][c]; cav[nt] = -8.0f * log1pf(__expf(-a.in[12][c])) * LOG2E; }
        for (int j = w; j < 64; j += 8) {
            const int t0 = 32 * j;
            bf16x8 Af[4];
#pragma unroll
            for (int kk = 0; kk < 4; ++kk) { const int c0 = 16 * kk + 8 * hi;
                f32x4 s0 = *(const LAS f32x4*)(CW + 256 + c0), s1 = *(const LAS f32x4*)(CW + 256 + c0 + 4);
#pragma unroll
                for (int d = 0; d < 4; ++d) { const int tok = t0 + r - d; const bool ok = tok >= 0;
                    const v4u x = *(const GAS v4u*)(XR + (size_t)(b * S + (ok ? tok : 0)) * D + cb * 64 + c0);
                    f32x4 x0, x1; unpack8(x, x0, x1); if (!ok) { x0 = x0 * 0.f; x1 = x1 * 0.f; }
                    const f32x4 w0 = *(const LAS f32x4*)(CW + (3 - d) * 64 + c0), w1 = *(const LAS f32x4*)(CW + (3 - d) * 64 + c0 + 4);
                    s0 = s0 + w0 * x0; s1 = s1 + w1 * x1; }
                Af[kk] = __builtin_bit_cast(bf16x8, pack8(s0, s1)); }
            f32x16 ci[2], cr[2], cx[2];
#pragma unroll
            for (int nt = 0; nt < 2; ++nt) {
#pragma unroll
                for (int i = 0; i < 16; ++i) { ci[nt][i] = 0.f; cr[nt][i] = 0.f; cx[nt][i] = 0.f; } }
#pragma unroll
            for (int kk = 0; kk < 4; ++kk)
#pragma unroll
                for (int nt = 0; nt < 2; ++nt) {
                    ci[nt] = __builtin_amdgcn_mfma_f32_32x32x16_bf16(Af[kk], __builtin_bit_cast(bf16x8, BF[((0 * 4 + kk) * 2 + nt) * 64 + lane]), ci[nt], 0, 0, 0);
                    cr[nt] = __builtin_amdgcn_mfma_f32_32x32x16_bf16(Af[kk], __builtin_bit_cast(bf16x8, BF[((1 * 4 + kk) * 2 + nt) * 64 + lane]), cr[nt], 0, 0, 0);
                    cx[nt] = __builtin_amdgcn_mfma_f32_32x32x16_bf16(Af[kk], __builtin_bit_cast(bf16x8, BF[((2 * 4 + kk) * 2 + nt) * 64 + lane]), cx[nt], 0, 0, 0); }
            unsigned short yv[2][16];
#pragma unroll
            for (int nt = 0; nt < 2; ++nt)
#pragma unroll
                for (int i = 0; i < 16; ++i) yv[nt][i] = YR[(size_t)(b * S + t0 + 8 * (i >> 2) + 4 * hi + (i & 3)) * D + cb * 64 + r + 32 * nt];
#pragma unroll
            for (int nt = 0; nt < 2; ++nt)
#pragma unroll
                for (int i = 0; i < 16; ++i) {
                    const float gi = fast_rcp(1.0f + __builtin_amdgcn_exp2f(-(ci[nt][i] + bxv[nt]) * LOG2E)), gr = fast_rcp(1.0f + __builtin_amdgcn_exp2f(-(cr[nt][i] + bav[nt]) * LOG2E));
                    const float av = __builtin_amdgcn_exp2f(cav[nt] * gr), mult = __builtin_amdgcn_sqrtf(fmaxf(0.f, 1.0f - av * av));
                    cr[nt][i] = av; ci[nt][i] = mult * gi * cx[nt][i]; }
            float A1[2][4], B1[2][4], A2[2][4], B2[2][4], SA[2], SB[2];
#pragma unroll
            for (int nt = 0; nt < 2; ++nt) { SA[nt] = 1.f; SB[nt] = 0.f;
#pragma unroll
                for (int g = 0; g < 4; ++g) { const int i0 = 4 * g;
                    const float ga = (cr[nt][i0] * cr[nt][i0 + 1]) * (cr[nt][i0 + 2] * cr[nt][i0 + 3]);
                    const float gb = ((ci[nt][i0] * cr[nt][i0 + 1] + ci[nt][i0 + 1]) * cr[nt][i0 + 2] + ci[nt][i0 + 2]) * cr[nt][i0 + 3] + ci[nt][i0 + 3];
                    const float pa = __shfl_xor(ga, 32), pb = __shfl_xor(gb, 32);
                    A1[nt][g] = hi ? pa : ga; B1[nt][g] = hi ? pb : gb; A2[nt][g] = hi ? ga : pa; B2[nt][g] = hi ? gb : pb;
                    SB[nt] = A1[nt][g] * SB[nt] + B1[nt][g]; SA[nt] = A1[nt][g] * SA[nt];
                    SB[nt] = A2[nt][g] * SB[nt] + B2[nt][g]; SA[nt] = A2[nt][g] * SA[nt]; } }
            if (j > 0) { while (FLAG[j] == 0) __builtin_amdgcn_s_sleep(1); }
            asm volatile("" ::: "memory");
            float h[2];
#pragma unroll
            for (int nt = 0; nt < 2; ++nt) { h[nt] = CARRY[j * 64 + r + 32 * nt]; if (hi == 0) CARRY[(j + 1) * 64 + r + 32 * nt] = SA[nt] * h[nt] + SB[nt]; }
            asm volatile("s_waitcnt lgkmcnt(0)" ::: "memory");
            if (lane == 0) FLAG[j + 1] = 1;
#pragma unroll
            for (int nt = 0; nt < 2; ++nt)
#pragma unroll
                for (int g = 0; g < 4; ++g) { const float h1 = A1[nt][g] * h[nt] + B1[nt][g]; float hh = hi ? h1 : h[nt]; h[nt] = A2[nt][g] * h1 + B2[nt][g];
#pragma unroll
                    for (int q = 0; q < 4; ++q) { const int i = 4 * g + q; hh = cr[nt][i] * hh + ci[nt][i];
                        LRU[(size_t)(b * S + t0 + 8 * g + 4 * hi + q) * D + cb * 64 + r + 32 * nt] = (bf16)f2bf(hh * bf2f(yv[nt][i])); } }
        }
    }
    __syncthreads();
}
__device__ __forceinline__ void p10_router(Frame& F, const Args& a) {
    LAS float* WT = (LAS float*)F.lds;
    for (int i = F.tid; i < 36 * D; i += NTHREADS) { const int o = i >> 10, k = i & 1023; WT[i] = o < 4 ? a.in[17][k * 4 + o] : a.in[19][k * 32 + (o - 4)]; }
    __syncthreads();
    const int gw = F.vcu * NWAVES + F.wave, NGW = F.G * NWAVES, lane = F.lane;
    const float* MOD = (const float*)(a.ws + WS_MOD); signed char* H2 = (signed char*)(a.ws + WS_H); float* SA = (float*)(a.ws + WS_SAH); const float* X1 = a.out;
    int* TOKE = (int*)(a.ws + WS_TOKE); int* TOKR = (int*)(a.ws + WS_TOKR); float* TOKW = (float*)(a.ws + WS_TOKW);
    for (int m = gw; m < T; m += NGW) { const int b = m >> 11; f32x4 h[4];
        norm_mod_row(X1 + (size_t)m * D, a.in[16], MOD + b * 6144 + 3072, MOD + b * 6144 + 4096, lane, h);
        store_row_i8(H2 + (size_t)m * D, SA + m, lane, h);
        float lg[36];
#pragma unroll
        for (int o = 0; o < 36; ++o) { float p = 0.f;
#pragma unroll
            for (int j = 0; j < 4; ++j) { const f32x4 w = *(const LAS f32x4*)(WT + o * D + 256 * j + 4 * lane); p += (h[j].x * w.x + h[j].y * w.y) + (h[j].z * w.z + h[j].w * w.w); }
            lg[o] = wave_sum(p);
            if ((o & 3) == 3) asm volatile("" ::: "memory"); }
        float gl[4];
#pragma unroll
        for (int o = 0; o < 4; ++o) gl[o] = lg[o] + a.in[18][o];
        int gi = 0; float gm = gl[0];
#pragma unroll
        for (int o = 1; o < 4; ++o) if (gl[o] > gm) { gm = gl[o]; gi = o; }
        float den = 0.f;
#pragma unroll
        for (int o = 0; o < 4; ++o) den += __expf(gl[o] - gm);
        const float ggate = 1.0f / den;
        float el[8];
#pragma unroll
        for (int j = 0; j < 8; ++j) { float v = lg[4 + j];
#pragma unroll
            for (int gg = 1; gg < 4; ++gg) v = (gi == gg) ? lg[4 + gg * 8 + j] : v;
            el[j] = v + a.in[20][gi * 8 + j]; }
        int i1 = 0; float v1 = el[0];
#pragma unroll
        for (int j = 1; j < 8; ++j) if (el[j] > v1) { v1 = el[j]; i1 = j; }
        int i2 = -1; float v2 = -INFINITY;
#pragma unroll
        for (int j = 0; j < 8; ++j) if (j != i1 && el[j] > v2) { v2 = el[j]; i2 = j; }
        if (i2 < 0) { i2 = (i1 + 1) & 7; v2 = v1; }
        const float e2 = __expf(v2 - v1), w1 = ggate / (1.0f + e2), w2 = ggate * e2 / (1.0f + e2);
        if (lane == 0) {
            const int e1 = gi * 8 + i1, e2i = gi * 8 + i2;
            const int r1 = (int)atomicAdd((unsigned*)(a.ws + WS_CTL) + CW_CNT + 64 * e1, 1u), r2 = (int)atomicAdd((unsigned*)(a.ws + WS_CTL) + CW_CNT + 64 * e2i, 1u);
            TOKE[2 * m] = e1; TOKE[2 * m + 1] = e2i; TOKR[2 * m] = r1; TOKR[2 * m + 1] = r2; TOKW[2 * m] = w1; TOKW[2 * m + 1] = w2;
        }
    }
    __syncthreads();
}
__device__ __forceinline__ int moe_tables(Frame& F, const Args& a, LAS int* off, LAS int* tile_e) {
    if (F.tid == 0) { int acc = 0;
        for (int e = 0; e < NE; ++e) { off[e] = acc; const int cnt = (int)__hip_atomic_load((unsigned*)(a.ws + WS_CTL) + CW_CNT + 64 * e, RLX_AGENT); const int nt = (cnt + 255) >> 8;
            for (int t = 0; t < nt; ++t) tile_e[(acc >> 8) + t] = e; acc += nt * 256; }
        off[NE] = acc; }
    __syncthreads();
    return off[NE] >> 8;
}
__device__ __forceinline__ void p11_scatter(Frame& F, const Args& a) {
    LAS int* off = (LAS int*)(F.lds + LDSX_OFF); LAS int* tile_e = off + 64;
    (void)moe_tables(F, a, off, tile_e);
    const int gw = F.vcu * NWAVES + F.wave, NGW = F.G * NWAVES, lane = F.lane;
    const signed char* H2 = (const signed char*)(a.ws + WS_H); signed char* XP = (signed char*)(a.ws + WS_XP); const float* SA = (const float*)(a.ws + WS_SAH); float* SAXP = (float*)(a.ws + WS_SAXP);
    const int* TOKE = (const int*)(a.ws + WS_TOKE); const int* TOKR = (const int*)(a.ws + WS_TOKR); int* TOKS = (int*)(a.ws + WS_TOKS);
    for (int m = gw; m < T; m += NGW) {
        const v4u r0 = ((const GAS v4u*)(H2 + (size_t)m * D))[lane]; const float sc = SA[m];
#pragma unroll
        for (int k = 0; k < 2; ++k) { const int e = TOKE[2 * m + k], slot = off[e] + TOKR[2 * m + k];
            ((GAS v4u*)(XP + (size_t)slot * D))[lane] = r0;
            if (lane == 0) { TOKS[2 * m + k] = slot; SAXP[slot] = sc; } }
    }
    __syncthreads();
}
__device__ __forceinline__ void p14_final(Frame& F, const Args& a) {
    const int gw = F.vcu * NWAVES + F.wave, NGW = F.G * NWAVES, lane = F.lane;
    const float* MOD = (const float*)(a.ws + WS_MOD); const bf16* Y = (const bf16*)(a.ws + WS_Y);
    const int* TOKS = (const int*)(a.ws + WS_TOKS); const float* TOKW = (const float*)(a.ws + WS_TOKW);
    for (int m = gw; m < T; m += NGW) { const int b = m >> 11;
        const int s0 = TOKS[2 * m], s1 = TOKS[2 * m + 1]; const float w0 = TOKW[2 * m], w1 = TOKW[2 * m + 1];
        GAS f32x4* xr = (GAS f32x4*)(a.out + (size_t)m * D) + lane; f32x4 v[4]; float ss = 0.f;
#pragma unroll
        for (int j = 0; j < 4; ++j) {
            const v2u ya = ((const GAS v2u*)(Y + (size_t)s0 * D) + lane)[64 * j], yb = ((const GAS v2u*)(Y + (size_t)s1 * D) + lane)[64 * j];
            const f32x4 y0 = (f32x4){bf_lo(ya.x), bf_hi(ya.x), bf_lo(ya.y), bf_hi(ya.y)}, y1 = (f32x4){bf_lo(yb.x), bf_hi(yb.x), bf_lo(yb.y), bf_hi(yb.y)};
            const f32x4 g2 = ((const GAS f32x4*)(MOD + b * 6144 + 5120) + lane)[64 * j];
            v[j] = xr[64 * j] + (g2 + 1.0f) * (y0 * w0 + y1 * w1);
            ss += (v[j].x * v[j].x + v[j].y * v[j].y) + (v[j].z * v[j].z + v[j].w * v[j].w); }
        const float rstd = 1.0f / sqrtf(wave_sum(ss) * (1.0f / D) + EPS);
#pragma unroll
        for (int j = 0; j < 4; ++j) xr[64 * j] = v[j] * rstd * ((const GAS f32x4*)a.in[24] + lane)[64 * j];
    }
}

template <bool I8 = false, class Epi, class Sched> __device__ __forceinline__ void run_gemm(Frame& F, const pg8::Gemm& g, const Sched& S, const Epi& E) {
    pg8::gemm_phase<Epi, Sched, true, I8>(F.lds, g, S, E);
}

constexpr int NPHASES = 14;
__global__ void __launch_bounds__(NTHREADS, 2) mk_fwd(Args args) {
    extern __shared__ __attribute__((aligned(16))) unsigned char lds_raw[];
    Frame F;
    F.lds = (LAS unsigned char*)lds_raw; F.MISC = (volatile LAS unsigned*)(F.lds + MISC_OFF);
    F.tid = threadIdx.x; F.lane = F.tid & 63; F.wave = __builtin_amdgcn_readfirstlane(F.tid >> 6);
    F.G = gridDim.x; { const int bx = blockIdx.x; F.vcu = (F.G % 8 == 0) ? (bx % 8) * (F.G / 8) + bx / 8 : bx; }
    unsigned char* ws = args.ws; F.ctl = (gu32*)(ws + WS_CTL);
    if (F.tid < 64) F.MISC[F.tid] = 0u;
    __syncthreads();
    XcdBarrier bar; bar.bar = (unsigned*)(ws + WS_CTL) + CW_BAR; bar.x = 0; bar.st = nullptr;
    if (MK_N_LAUNCHES == 1) bar = xcd_barrier_post((unsigned*)(ws + WS_CTL) + CW_BAR, F.MISC + 8);
    const int lo = args.ph_lo, hi = args.ph_hi;
#ifndef PH_MASK
#define PH_MASK 0x7fff
#endif
#define IN(k) (((PH_MASK >> (k)) & 1) && lo <= (k) && (k) < hi)
#define SEAM(k) do { if (IN(k) && IN((k) + 1)) xcd_barrier(bar); } while (0)
#ifndef REP_MASK
#define REP_MASK 0
#endif
#define PHASE(k, ...) do { if (IN(k)) { __VA_ARGS__ if ((REP_MASK >> (k)) & 1) { __syncthreads(); __VA_ARGS__ } SEAM(k); } } while (0)

    PHASE(0, { p0_prologue(F, args);});
    PHASE(1, { p1_norm1(F, args);});
    PHASE(2, {
        pg8::Gemm g{(const bf16*)(ws + WS_H), (const bf16*)(ws + WS_WIN_T), T, 3 * AW, D / 2, 0, (const float*)(ws + WS_SAH), (const float*)(ws + WS_SB_IN)}; pg8::StaticOrder So; So.init(T, 3 * AW, F.G, (int)blockIdx.x);
        EpiQKV E{(bf16*)(ws + WS_QKV)}; run_gemm<true>(F, g, So, E);});
    PHASE(3, { p3_attention(F, args);});
    PHASE(4, {
        pg8::Gemm g{(const bf16*)(ws + WS_H), (const bf16*)(ws + WS_WIN_T + (size_t)(3 * AW) * D), T, 4 * D, D / 2, 0, (const float*)(ws + WS_SAH), (const float*)(ws + WS_SB_IN) + 3 * AW}; pg8::StaticOrder So; So.init(T, 4 * D, F.G, (int)blockIdx.x);
        EpiXYG E{(bf16*)(ws + WS_XR)}; run_gemm<true>(F, g, So, E);});
    PHASE(5, { p5_lru(F, args);});
    PHASE(6, {
        pg8::Gemm g{(const bf16*)args.out, (const bf16*)(ws + WS_WAO_T), T, D, AOW, 0, nullptr, nullptr}; pg8::StaticOrder So; So.init(T, D, F.G, (int)blockIdx.x);
        EpiP4a E{(bf16*)(ws + WS_GA)}; run_gemm(F, g, So, E);});
    PHASE(7, {
        pg8::Gemm g{(const bf16*)(ws + WS_LRU), (const bf16*)(ws + WS_WLO_T), T, D, D, 0, nullptr, nullptr}; pg8::StaticOrder So; So.init(T, D, F.G, (int)blockIdx.x);
        EpiP4b E{(const bf16*)(ws + WS_GA), (bf16*)(ws + WS_GL)}; run_gemm(F, g, So, E);});
    PHASE(8, {
        pg8::Gemm g{(const bf16*)(ws + WS_GL), (const bf16*)(ws + WS_WOUT_T), T, D, D, 0, nullptr, nullptr}; pg8::StaticOrder So; So.init(T, D, F.G, (int)blockIdx.x);
        EpiP5 E{args.in[0], (const float*)(ws + WS_MOD), args.out}; run_gemm(F, g, So, E);});
    PHASE(9, { p10_router(F, args);});
    PHASE(10, { p11_scatter(F, args);});
    PHASE(11, {
        LAS int* off = (LAS int*)(F.lds + LDSX_OFF); LAS int* tile_e = off + 64;
        const int ntiles = moe_tables(F, args, off, tile_e);
        pg8::Gemm g{(const bf16*)(ws + WS_XP), (const bf16*)(ws + WS_W13_T), ntiles * 256, D, D / 2, (size_t)D * D, (const float*)(ws + WS_SAXP), (const float*)(ws + WS_SB_13)}; pg8::MoeOrder So{ntiles, F.G, F.vcu, tile_e};
        EpiMoeA E{(bf16*)(ws + WS_HB)}; run_gemm<true>(F, g, So, E);});
    PHASE(12, {
        LAS int* off = (LAS int*)(F.lds + LDSX_OFF); LAS int* tile_e = off + 64;
        const int ntiles = moe_tables(F, args, off, tile_e);
        pg8::Gemm g{(const bf16*)(ws + WS_HB), (const bf16*)(ws + WS_W2_T), ntiles * 256, D, DE, (size_t)D * DE * 2, nullptr, nullptr}; pg8::MoeOrder So{ntiles, F.G, F.vcu, tile_e};
        EpiMoeB E{(bf16*)(ws + WS_Y)}; run_gemm(F, g, So, E);});
    if (IN(13)) { p14_final(F, args); }
#undef IN
#undef SEAM
}

extern "C" void kernel_launch(void* const* d_in, const int* in_sizes, int n_in, void* d_out, int out_size, void* d_ws, size_t ws_size, hipStream_t stream) {
    static int grid = 0;
    if (grid == 0) {
        if (n_in != 25 || out_size != T * D || ws_size < WS_END) { fprintf(stderr, "kernel_launch: unexpected shapes: n_in %d out %d ws %zu (need %zu)\n", n_in, out_size, ws_size, (size_t)WS_END); grid = -1; return; }
        int dev = 0, cus = 0, per_cu = 0;
        if (hipGetDevice(&dev) != hipSuccess || hipDeviceGetAttribute(&cus, hipDeviceAttributeMultiprocessorCount, dev) != hipSuccess) { grid = -1; return; }
        if (hipFuncSetAttribute((const void*)mk_fwd, hipFuncAttributeMaxDynamicSharedMemorySize, LDS_BYTES) != hipSuccess) { fprintf(stderr, "kernel_launch: hipFuncSetAttribute failed\n"); grid = -1; return; }
        if (hipOccupancyMaxActiveBlocksPerMultiprocessor(&per_cu, (const void*)mk_fwd, NTHREADS, LDS_BYTES) != hipSuccess || per_cu < 1) { fprintf(stderr, "kernel_launch: occupancy query says %d\n", per_cu); }
        (void)hipGetLastError();
        grid = cus;
    }
    if (grid < 0) return;
    if (hipMemsetAsync((char*)d_ws + WS_CTL, 0, CTL_ZERO_BYTES, stream) != hipSuccess) return;
    Args a{};
    for (int i = 0; i < 25; ++i) a.in[i] = (const float*)d_in[i];
    a.out = (float*)d_out; a.ws = (unsigned char*)d_ws;
    if (MK_N_LAUNCHES == 1) { a.ph_lo = 0; a.ph_hi = NPHASES; hipLaunchKernelGGL(mk_fwd, dim3(grid), dim3(NTHREADS), LDS_BYTES, stream, a); }
    else for (int p = 0; p < NPHASES; ++p) { a.ph_lo = p; a.ph_hi = p + 1; hipLaunchKernelGGL(mk_fwd, dim3(grid), dim3(NTHREADS), LDS_BYTES, stream, a); }
}
```

```cpp
#include <hip/hip_runtime.h>
#include <cstdio>
#include <cstdint>

#ifndef MK_N_LAUNCHES
#define MK_N_LAUNCHES 1
#endif
#ifndef MK_SIMPLE_GEMM
#define MK_SIMPLE_GEMM 0
#endif

#define GAS __attribute__((address_space(1)))
#define LAS __attribute__((address_space(3)))
typedef unsigned short bf16;
typedef unsigned v4u __attribute__((ext_vector_type(4)));
typedef unsigned v2u __attribute__((ext_vector_type(2)));
typedef float f32x4 __attribute__((ext_vector_type(4)));
typedef float f32x2 __attribute__((ext_vector_type(2)));
typedef short bf16x8 __attribute__((ext_vector_type(8)));
typedef GAS unsigned gu32;

constexpr int NB = 16, S = 2048, D = 1024, T = NB * S;
constexpr int HD = 64, NSLOT = 8, NHEAD = 24, AW = 1536, AOW = 512;
constexpr int IN_COLS = 8704, NE = 32, DE = 512, MAX_TILES = 288;
constexpr float EPS = 1e-6f, QSCALE = 0.125f * 1.4426950408889634f;
constexpr int NWAVES = 8, NTHREADS = 512;

constexpr size_t MiB = 1u << 20, KiB = 1u << 10;
constexpr size_t WS_CTL = 0, CTL_ZERO_BYTES = 1 * MiB;
constexpr size_t WS_MOD = 128 * KiB;
constexpr size_t WS_CPART_IN = 27 * MiB, WS_CPART_13 = 28 * MiB;
constexpr size_t WS_SB_IN = 29 * MiB, WS_SB_13 = 29 * MiB + 512 * KiB;
constexpr size_t WS_TOKE = 1 * MiB, WS_TOKR = WS_TOKE + 256 * KiB, WS_TOKW = WS_TOKR + 256 * KiB, WS_TOKS = WS_TOKW + 256 * KiB;
constexpr size_t WS_WIN_T = 2 * MiB;
constexpr size_t WS_WAO_T = 19 * MiB, WS_WLO_T = 20 * MiB, WS_WOUT_T = 22 * MiB;
constexpr size_t WS_LSE = 26 * MiB;
constexpr size_t WS_W13_T = 32 * MiB;
constexpr size_t WS_W2_T = 96 * MiB;
constexpr size_t WS_H = 128 * MiB;
constexpr size_t WS_SAH = WS_H + 32 * MiB;
constexpr size_t WS_SAXP = WS_H + 33 * MiB;
constexpr size_t WS_R = 192 * MiB;
constexpr size_t WS_QKV = WS_R;
constexpr size_t WS_XR = WS_R, WS_YR = WS_R + 64 * MiB, WS_GA = WS_R + 128 * MiB, WS_GL = WS_R + 192 * MiB, WS_LRU = WS_R + 256 * MiB;
constexpr size_t WS_XP = WS_R, WS_HB = WS_R + 144 * MiB, WS_Y = WS_R;
constexpr size_t WS_D1 = WS_R + 256 * MiB;
constexpr size_t WS_END = 512 * MiB;
constexpr int CW_TMO = 0, CW_CNT = 1024, CW_BAR = 4096;

constexpr int RING_BYTES = 131072;
constexpr int LDSX_OFF = RING_BYTES;
constexpr int LDS_BYTES = 155648;
constexpr int MISC_OFF = LDS_BYTES - 256;

#define LDS_WAIT() asm volatile("s_waitcnt lgkmcnt(0)" ::: "memory")
#define VM_WAIT() asm volatile("s_waitcnt vmcnt(0)" ::: "memory")
#define RLX_AGENT __ATOMIC_RELAXED, __HIP_MEMORY_SCOPE_AGENT

__device__ __forceinline__ unsigned f2bf(float f) { unsigned u = __builtin_bit_cast(unsigned, f); return (u + 0x7fffu + ((u >> 16) & 1u)) >> 16; }
__device__ __forceinline__ unsigned pk2(float lo, float hi) { unsigned r; asm("v_cvt_pk_bf16_f32 %0, %1, %2" : "=v"(r) : "v"(lo), "v"(hi)); return r; }
__device__ __forceinline__ float bf_lo(unsigned u) { return __builtin_bit_cast(float, u << 16); }
__device__ __forceinline__ float bf_hi(unsigned u) { return __builtin_bit_cast(float, u & 0xffff0000u); }
__device__ __forceinline__ float bf2f(bf16 b) { return __builtin_bit_cast(float, ((unsigned)b) << 16); }
__device__ __forceinline__ float fast_rcp(float x) { return __builtin_amdgcn_rcpf(x); }
__device__ __forceinline__ float sigmoid_f(float x) { return fast_rcp(1.0f + __expf(-x)); }
__device__ __forceinline__ float gelu_tanh_f(float v) { const float u = 0.7978845608028654f * (v + 0.044715f * v * v * v); return v * fast_rcp(1.0f + __expf(-2.0f * u)); }
__device__ __forceinline__ float wave_sum(float v) {
#pragma unroll
    for (int o = 1; o < 64; o <<= 1) v += __shfl_xor(v, o);
    return v;
}

namespace pg8 {
#define PG8_LAS __attribute__((address_space(3)))
typedef unsigned short bf16_t;
typedef unsigned u32x4 __attribute__((ext_vector_type(4)));
constexpr int BM = 256, BK = 64, HALF = 128, HTB = HALF * BK * 2, STAGE_BYTES = 8 * HTB, NXCD = 8, WGM = 8;

__host__ __device__ __forceinline__ int lds_byte(int r, int c) { const int st = (r >> 4) * 2 + (c >> 5), rr = r & 15, cc = c & 31, ob = rr * 64 + cc * 2; return st * 1024 + (ob ^ (((ob >> 9) & 1) << 5)); }
__host__ __device__ __forceinline__ void stage_rc(int b, int& R, int& C) { const int st = b / 1024, sb = b % 1024, swz = sb ^ (((sb >> 9) & 1) << 5); R = (st >> 1) * 16 + swz / 64; C = (st & 1) * 32 + (swz % 64) / 2; }
__host__ __device__ __forceinline__ int perm32(int rho) { const int n = rho >> 4, i = rho & 15; return 8 * (i >> 2) + 4 * n + (i & 3); }

struct Unit { int pm, pn, e; };
struct Gemm { const bf16_t* A; const bf16_t* Bt; int M, N, K; size_t estride; const float* sa; const float* sb; };
typedef int i32x4 __attribute__((ext_vector_type(4)));

struct StaticOrder {
    int nM, nN, nwg, G, c;
    __host__ __device__ void init(int M, int N, int G_, int c_) { nM = M / BM; nN = N / BM; nwg = nM * nN; G = G_; c = c_; }
    __host__ __device__ bool next(int i, Unit& u) const {
        const long L = (long)i * G + c; if (L >= nwg) return false;
        int wgid = (int)L; { const int q = nwg / NXCD, r = nwg % NXCD, xcd = wgid % NXCD, off = wgid / NXCD; wgid = (xcd < r ? xcd * (q + 1) : r * (q + 1) + (xcd - r) * q) + off; }
        const int nig = WGM * nN, gid = wgid / nig, fm = gid * WGM, gsz = (nM - fm) < WGM ? (nM - fm) : WGM;
        u.pm = fm + ((wgid % nig) % gsz); u.pn = (wgid % nig) / gsz; u.e = 0; return true;
    }
};
struct MoeOrder {
    int ntiles, G, vcu; const PG8_LAS int* tile_e;
    __device__ bool next(int i, Unit& u) const {
        const int L = i * G + vcu; if (L >= ntiles * 4) return false;
        u.pm = L >> 2; u.pn = L & 3; u.e = __builtin_amdgcn_readfirstlane(tile_e[u.pm]); return true;
    }
};

template <class Epi> __device__ __forceinline__ void run_epi(const Epi& E, const f32x4 (&acc)[2][2][4][2], const Unit& u, int wr, int wc, int fr, int fq, const Gemm&) {
    const int row0 = u.pm * BM + wr * 64 + fr, col0 = u.pn * BM + wc * 32 + 8 * fq;
#pragma unroll
    for (int ai = 0; ai < 2; ++ai) {
        typename Epi::Pre P[4][2];
#pragma unroll
        for (int m = 0; m < 4; ++m)
#pragma unroll
            for (int bj = 0; bj < 2; ++bj) P[m][bj] = E.pre(row0 + ai * HALF + m * 16, col0 + bj * HALF);
#pragma unroll
        for (int m = 0; m < 4; ++m)
#pragma unroll
            for (int bj = 0; bj < 2; ++bj) E.store8(row0 + ai * HALF + m * 16, col0 + bj * HALF, acc[ai][bj][m][0], acc[ai][bj][m][1], P[m][bj]);
    }
}
template <class Epi> __device__ __forceinline__ void run_epi(const Epi& E, const i32x4 (&acc)[2][2][4][2], const Unit& u, int wr, int wc, int fr, int fq, const Gemm& g) {
    const int row0 = u.pm * BM + wr * 64 + fr, col0 = u.pn * BM + wc * 32 + 8 * fq;
    f32x4 cs[2][2];
#pragma unroll
    for (int bj = 0; bj < 2; ++bj)
#pragma unroll
        for (int n = 0; n < 2; ++n) cs[bj][n] = *(const __attribute__((address_space(1))) f32x4*)(g.sb + (size_t)u.e * g.N + col0 + bj * HALF + 4 * n);
#pragma unroll
    for (int ai = 0; ai < 2; ++ai)
#pragma unroll
        for (int m = 0; m < 4; ++m) { const int row = row0 + ai * HALF + m * 16; const float sr = g.sa[row];
#pragma unroll
            for (int bj = 0; bj < 2; ++bj) E.store8(row, col0 + bj * HALF, __builtin_convertvector(acc[ai][bj][m][0], f32x4) * (cs[bj][0] * sr), __builtin_convertvector(acc[ai][bj][m][1], f32x4) * (cs[bj][1] * sr), E.pre(row, col0 + bj * HALF)); }
}
__device__ __forceinline__ void mma16(f32x4& c, const bf16x8 b, const bf16x8 a) { c = __builtin_amdgcn_mfma_f32_16x16x32_bf16(b, a, c, 0, 0, 0); }
__device__ __forceinline__ void mma16(i32x4& c, const bf16x8 b, const bf16x8 a) { c = __builtin_amdgcn_mfma_i32_16x16x64_i8(__builtin_bit_cast(i32x4, b), __builtin_bit_cast(i32x4, a), c, 0, 0, 0); }
template <bool I8> struct AccT { typedef f32x4 type; };
template <> struct AccT<true> { typedef i32x4 type; };

template <class Epi, class Sched, bool ALIGN_EPI = true, bool I8 = false>
__device__ __forceinline__ void gemm_phase(PG8_LAS unsigned char* lds, const Gemm g, const Sched& S, const Epi& E) {
    int tid = threadIdx.x; asm volatile("" : "+v"(tid));
    const int wid = __builtin_amdgcn_readfirstlane(tid >> 6), lane = tid & 63, wr = wid >> 2, wc = wid & 3, fr = lane & 15, fq = lane >> 4;
    const int K = g.K, nt = K / BK;
    unsigned voffA[2], voffB[2];
#pragma unroll
    for (int i = 0; i < 2; ++i) { int R, C; stage_rc(tid * 16 + i * 8192, R, C); const int Rb = (R & ~31) + perm32(R & 31);
        voffA[i] = (unsigned)(R * K + C) * 2u; voffB[i] = (unsigned)(Rb * K + C) * 2u; }
    const size_t kstep = (size_t)(BK * 2);
    const size_t hstep = (size_t)HALF * K * 2;
    const size_t tstep = 2 * hstep;
    const unsigned ldsw = (unsigned)wid * 1024u;
    const int aoff = lds_byte(wr * 64 + fr, fq * 8), boff = lds_byte(wc * 32 + fr, fq * 8);
#define PG8_SA(b, h) (((b) * 2 + (h)) * HTB)
#define PG8_SB(b, h) ((4 + (b) * 2 + (h)) * HTB)
#define PG8_STAGE(bufoff, gbase, voff) do { _Pragma("unroll") for (int _i = 0; _i < 2; ++_i) \
        __builtin_amdgcn_global_load_lds((const unsigned*)((const char*)(gbase) + (voff)[_i]), (PG8_LAS unsigned*)(lds + (bufoff) + ldsw + _i * 8192), 16, 0, 0); } while (0)
#define PG8_LDA(dst, b, h) do { _Pragma("unroll") for (int m = 0; m < 4; ++m) _Pragma("unroll") for (int k = 0; k < 2; ++k) dst[m][k] = *(const PG8_LAS bf16x8*)(lds + PG8_SA(b, h) + aoff + m * 2048 + k * 1024); } while (0)
#define PG8_LDB(dst, b, h) do { _Pragma("unroll") for (int n = 0; n < 2; ++n) _Pragma("unroll") for (int k = 0; k < 2; ++k) dst[n][k] = *(const PG8_LAS bf16x8*)(lds + PG8_SB(b, h) + boff + n * 2048 + k * 1024); } while (0)
#define PG8_MMA(ai, bj, At, Bt) do { __builtin_amdgcn_s_setprio(1); _Pragma("unroll") for (int m = 0; m < 4; ++m) _Pragma("unroll") for (int n = 0; n < 2; ++n) _Pragma("unroll") for (int k = 0; k < 2; ++k) \
        mma16(acc[ai][bj][m][n], Bt[n][k], At[m][k]); __builtin_amdgcn_s_setprio(0); } while (0)
#define PG8_WAIT_V(n) asm volatile("s_waitcnt vmcnt(" #n ")" ::: "memory")
#define PG8_WAIT_L(n) asm volatile("s_waitcnt lgkmcnt(" #n ")" ::: "memory")
#define PG8_BAR __builtin_amdgcn_s_barrier()
#define PG8_SCHED __builtin_amdgcn_sched_barrier(0)
    Unit cur, nxt; int ui = 0;
    if (!S.next(0, cur)) return;
    typedef typename AccT<I8>::type acc_t;
    acc_t acc[2][2][4][2];
#pragma unroll
    for (int a = 0; a < 2; ++a)
#pragma unroll
        for (int b = 0; b < 2; ++b)
#pragma unroll
            for (int m = 0; m < 4; ++m)
#pragma unroll
                for (int n = 0; n < 2; ++n) acc[a][b][m][n] = (acc_t){0, 0, 0, 0};
    bf16x8 At[4][2], B0[2][2], B1[2][2];
    const char* cA = (const char*)g.A + (size_t)cur.pm * tstep; const char* cB = (const char*)g.Bt + (size_t)cur.e * g.estride + (size_t)cur.pn * tstep;
    PG8_STAGE(PG8_SB(0, 0), cB, voffB); PG8_STAGE(PG8_SB(0, 1), cB + hstep, voffB); PG8_STAGE(PG8_SA(0, 0), cA, voffA); PG8_STAGE(PG8_SA(0, 1), cA + hstep, voffA);
    if (wr == 1) PG8_BAR;
    PG8_WAIT_V(2); PG8_BAR;
    PG8_STAGE(PG8_SB(1, 0), cB + kstep, voffB); PG8_STAGE(PG8_SA(1, 0), cA + kstep, voffA); PG8_STAGE(PG8_SB(1, 1), cB + hstep + kstep, voffB);
    PG8_WAIT_V(6); PG8_BAR;
    for (;;) {
        const bool has_next = S.next(ui + 1, nxt);
        const char* nA = has_next ? (const char*)g.A + (size_t)nxt.pm * tstep : cA; const char* nB = has_next ? (const char*)g.Bt + (size_t)nxt.e * g.estride + (size_t)nxt.pn * tstep : cB;
        for (int t = 0; t < nt; t += 2) {
            const bool last = (t == nt - 2);
            const char* a1 = cA + (size_t)(t + 1) * kstep;
            const char* a2 = last ? nA : cA + (size_t)(t + 2) * kstep; const char* b2 = last ? nB : cB + (size_t)(t + 2) * kstep;
            const char* a3 = a2 + kstep; const char* b3 = b2 + kstep;
            PG8_LDB(B0, 0, 0); PG8_LDB(B1, 0, 1); PG8_SCHED; PG8_LDA(At, 0, 0); PG8_STAGE(PG8_SA(1, 1), a1 + hstep, voffA);
            PG8_WAIT_V(8); PG8_WAIT_L(0); PG8_BAR; PG8_MMA(0, 0, At, B0); PG8_MMA(0, 1, At, B1); PG8_BAR; PG8_SCHED;
            PG8_LDA(At, 0, 1); PG8_STAGE(PG8_SB(0, 0), b2, voffB); PG8_STAGE(PG8_SB(0, 1), b2 + hstep, voffB); PG8_STAGE(PG8_SA(0, 0), a2, voffA);
            PG8_WAIT_V(8); PG8_WAIT_L(0); PG8_BAR; PG8_MMA(1, 0, At, B0); PG8_MMA(1, 1, At, B1); PG8_BAR; PG8_SCHED;
            PG8_LDB(B0, 1, 0); PG8_LDB(B1, 1, 1); PG8_SCHED; PG8_LDA(At, 1, 0); PG8_STAGE(PG8_SA(0, 1), a2 + hstep, voffA);
            PG8_WAIT_V(8); PG8_WAIT_L(0); PG8_BAR; PG8_MMA(0, 0, At, B0); PG8_MMA(0, 1, At, B1); PG8_BAR; PG8_SCHED;
            PG8_LDA(At, 1, 1); PG8_STAGE(PG8_SB(1, 0), b3, voffB); PG8_STAGE(PG8_SB(1, 1), b3 + hstep, voffB); PG8_STAGE(PG8_SA(1, 0), a3, voffA);
            PG8_WAIT_V(8); PG8_WAIT_L(0); PG8_BAR; PG8_MMA(1, 0, At, B0); PG8_MMA(1, 1, At, B1); PG8_BAR; PG8_SCHED;
        }
        if constexpr (ALIGN_EPI) { if (wr == 0) PG8_BAR; }
        run_epi(E, acc, cur, wr, wc, fr, fq, g);
        if (!has_next) break;
#pragma unroll
        for (int a = 0; a < 2; ++a)
#pragma unroll
            for (int b = 0; b < 2; ++b)
#pragma unroll
                for (int m = 0; m < 4; ++m)
#pragma unroll
                    for (int n = 0; n < 2; ++n) acc[a][b][m][n] = (acc_t){0, 0, 0, 0};
        cur = nxt; cA = nA; cB = nB; ++ui;
        if constexpr (ALIGN_EPI) { if (wr == 1) PG8_BAR; }
    }
    PG8_WAIT_V(0);
    if constexpr (!ALIGN_EPI) { if (wr == 0) PG8_BAR; }
    PG8_BAR;
#undef PG8_SA
#undef PG8_SB
#undef PG8_STAGE
#undef PG8_LDA
#undef PG8_LDB
#undef PG8_MMA
#undef PG8_WAIT_V
#undef PG8_WAIT_L
#undef PG8_BAR
#undef PG8_SCHED
}

}

__device__ __forceinline__ v4u pack8(const f32x4 a, const f32x4 b) { v4u w; w.x = pk2(a[0], a[1]); w.y = pk2(a[2], a[3]); w.z = pk2(b[0], b[1]); w.w = pk2(b[2], b[3]); return w; }
__device__ __forceinline__ void unpack8(const v4u w, f32x4& a, f32x4& b) { a = (f32x4){bf_lo(w.x), bf_hi(w.x), bf_lo(w.y), bf_hi(w.y)}; b = (f32x4){bf_lo(w.z), bf_hi(w.z), bf_lo(w.w), bf_hi(w.w)}; }

struct EpiQKV { bf16* QKV;
    struct Pre {}; __device__ __forceinline__ Pre pre(int, int) const { return Pre{}; }
    __device__ __forceinline__ void store8(int row, int col, f32x4 v0, f32x4 v1, const Pre&) const {
        const int which = col / AW, rem = col - which * AW, hh = rem >> 6, dim0 = rem & 63, sh = 2 * (hh >> 3);
        const int b = row >> 11, s = row & 2047, pos = ((s & ((1 << sh) - 1)) << (11 - sh)) | (s >> sh);
        if (which == 0) { v0 = v0 * QSCALE; v1 = v1 * QSCALE; }
        *(GAS v4u*)(QKV + ((((size_t)(which * NB + b) * NHEAD + hh) * S + pos) * HD + dim0)) = pack8(v0, v1);
    } };
struct EpiXYG { bf16* XR;
    struct Pre {}; __device__ __forceinline__ Pre pre(int, int) const { return Pre{}; }
    __device__ __forceinline__ void store8(int row, int col, f32x4 v0, f32x4 v1, const Pre&) const {
        const int blk = col >> 10, c = col & 1023;
        if (blk == 1) {
#pragma unroll
            for (int j = 0; j < 4; ++j) { v0[j] = gelu_tanh_f(v0[j]); v1[j] = gelu_tanh_f(v1[j]); } }
        else if (blk >= 2) {
#pragma unroll
            for (int j = 0; j < 4; ++j) { v0[j] = sigmoid_f(v0[j]); v1[j] = sigmoid_f(v1[j]); } }
        bf16* dst = XR + (size_t)blk * ((size_t)T * D) + (size_t)row * D + c;
        *(GAS v4u*)dst = pack8(v0, v1);
    } };
struct EpiP4a { bf16* GA;
    struct Pre { v4u g; };
    __device__ __forceinline__ Pre pre(int row, int col) const { Pre p; p.g = *(const GAS v4u*)(GA + (size_t)row * D + col); return p; }
    __device__ __forceinline__ void store8(int row, int col, f32x4 v0, f32x4 v1, const Pre& p) const {
        f32x4 g0, g1; unpack8(p.g, g0, g1);
        *(GAS v4u*)(GA + (size_t)row * D + col) = pack8(g0 * v0, g1 * v1);
    } };
struct EpiP4b { const bf16* TMP; bf16* GL;
    struct Pre { v4u g, t; };
    __device__ __forceinline__ Pre pre(int row, int col) const { Pre p; p.g = *(const GAS v4u*)(GL + (size_t)row * D + col); p.t = *(const GAS v4u*)(TMP + (size_t)row * D + col); return p; }
    __device__ __forceinline__ void store8(int row, int col, f32x4 v0, f32x4 v1, const Pre& p) const {
        f32x4 g0, g1, t0, t1; unpack8(p.g, g0, g1); unpack8(p.t, t0, t1);
        *(GAS v4u*)(GL + (size_t)row * D + col) = pack8(t0 + g0 * v0, t1 + g1 * v1);
    } };
struct EpiP5 { const float* MOD; bf16* D1;
    struct Pre { f32x4 g0, g1; };
    __device__ __forceinline__ Pre pre(int row, int col) const { const int b = row >> 11; const float* gp = MOD + b * 6144 + 2048 + col; Pre p; p.g0 = *(const GAS f32x4*)gp; p.g1 = *(const GAS f32x4*)(gp + 4); return p; }
    __device__ __forceinline__ void store8(int row, int col, f32x4 v0, f32x4 v1, const Pre& p) const {
        *(GAS v4u*)(D1 + (size_t)row * D + col) = pack8((p.g0 + 1.0f) * v0, (p.g1 + 1.0f) * v1);
    } };
struct EpiMoeA { bf16* HB;
    struct Pre {}; __device__ __forceinline__ Pre pre(int, int) const { return Pre{}; }
    __device__ __forceinline__ void store8(int row, int col, f32x4 v0, f32x4 v1, const Pre&) const {
        f32x4 r;
#pragma unroll
        for (int j = 0; j < 4; ++j) r[j] = v0[j] * sigmoid_f(v0[j]) * v1[j];
        v2u w; w.x = pk2(r[0], r[1]); w.y = pk2(r[2], r[3]);
        *(GAS v2u*)(HB + (size_t)row * DE + (col >> 1)) = w;
    } };
struct EpiMoeB { bf16* Y;
    struct Pre {}; __device__ __forceinline__ Pre pre(int, int) const { return Pre{}; }
    __device__ __forceinline__ void store8(int row, int col, f32x4 v0, f32x4 v1, const Pre&) const { *(GAS v4u*)(Y + (size_t)row * D + col) = pack8(v0, v1); } };

#define XB_TMO      128
#define XB_XCNT(j)  (256  + 64 * (j))
#define XB_XSUB(j)  (1280 + 64 * (j))
#define XB_XGEN(j)  (2304 + 64 * (j))
#define XB_TOP      3328
#define XB_TOPGEN   3392
#define XCD_BAR_WORDS 3456
#define XB_SPIN_CAP (1u << 20)
__device__ __forceinline__ unsigned xb_ld(unsigned* p)              { return __hip_atomic_load(p, __ATOMIC_RELAXED, __HIP_MEMORY_SCOPE_AGENT); }
__device__ __forceinline__ unsigned xb_add(unsigned* p, unsigned v) { return __hip_atomic_fetch_add(p, v, __ATOMIC_RELAXED, __HIP_MEMORY_SCOPE_AGENT); }
__device__ __forceinline__ unsigned xb_xcc_id() { return (unsigned)__builtin_amdgcn_s_getreg((3 << 11) | 20) & 0xFu; }
#define XB_SPIN(cond, bar) do { unsigned _sp = 0; while (cond) { __builtin_amdgcn_s_sleep(1); \
    if ((++_sp & 255u) == 0u) { if (xb_ld(&(bar)[XB_TMO])) break; if (_sp > XB_SPIN_CAP) { atomicAdd(&(bar)[XB_TMO], 1u); break; } } } } while (0)
struct XcdBarrier { unsigned* bar; unsigned x; volatile LAS unsigned* st; };
__device__ __forceinline__ XcdBarrier xcd_barrier_post(unsigned* bar, volatile LAS unsigned* st) {
    XcdBarrier b; b.bar = bar; b.x = xb_xcc_id(); b.st = st;
    if (threadIdx.x == 0) (void)xb_add(&bar[XB_XCNT(b.x)], 1u);
    return b;
}
__device__ __forceinline__ void xcd_barrier_complete(unsigned* bar, unsigned x, unsigned& nloc, unsigned& nx) {
    const unsigned G = gridDim.x * gridDim.y * gridDim.z;
    unsigned sum, cnt, mine, sp = 0u;
    for (;;) {
        sum = 0u; cnt = 0u; mine = 0u;
#pragma unroll
        for (unsigned j = 0; j < 16; ++j) { const unsigned c = xb_ld(&bar[XB_XCNT(j)]); sum += c; cnt += (c > 0u) ? 1u : 0u; mine = (j == x) ? c : mine; }
        if (sum == G) break;
        __builtin_amdgcn_s_sleep(1);
        if ((++sp & 255u) == 0u) { if (xb_ld(&bar[XB_TMO])) break; if (sp > XB_SPIN_CAP) { atomicAdd(&bar[XB_TMO], 1u); break; } }
    }
    nloc = mine > 0u ? mine : 1u; nx = cnt > 0u ? cnt : 1u;
}
__device__ __forceinline__ void xcd_barrier(const XcdBarrier& b) {
    asm volatile("s_waitcnt vmcnt(0)" ::: "memory");
    __syncthreads();
    if (threadIdx.x == 0) {
        unsigned* bar = b.bar;
        __builtin_amdgcn_s_waitcnt(0);
        unsigned nloc = b.st[0], nx = b.st[1];
        if (nloc == 0u) { xcd_barrier_complete(bar, b.x, nloc, nx); b.st[0] = nloc; b.st[1] = nx; }
        const unsigned old = xb_add(&bar[XB_XSUB(b.x)], 1u);
        const unsigned gen = old / nloc;
        if (old + 1u == (gen + 1u) * nloc) {
            __builtin_amdgcn_fence(__ATOMIC_RELEASE, "agent");
            asm volatile("s_waitcnt vmcnt(0)" ::: "memory");
            const unsigned og = xb_add(&bar[XB_TOP], 1u);
            const unsigned tg = og / nx;
            if (og + 1u == (tg + 1u) * nx) xb_add(&bar[XB_TOPGEN], 1u);
            else XB_SPIN(xb_ld(&bar[XB_TOPGEN]) == tg, bar);
            __builtin_amdgcn_fence(__ATOMIC_ACQUIRE, "agent");
            xb_add(&bar[XB_XGEN(b.x)], 1u);
            asm volatile("s_waitcnt vmcnt(0)" ::: "memory");
        } else {
            XB_SPIN(xb_ld(&bar[XB_XGEN(b.x)]) == gen, bar);
            __builtin_amdgcn_fence(__ATOMIC_ACQUIRE, "agent");
            asm volatile("s_waitcnt vmcnt(0)" ::: "memory");
        }
    }
    __syncthreads();
}

struct Args { const float* in[25]; float* out; unsigned char* ws; int ph_lo, ph_hi; };
struct Frame {
    LAS unsigned char* lds; volatile LAS unsigned* MISC; gu32* ctl;
    int tid, lane, wave, vcu, G;
};

__device__ __forceinline__ void p0_transpose_item(const float* W, int K, int N, bf16* WT, int row_off, int mode, LAS float* scr, int item, int lane) {
    const int nblk = N / 32, kb = item / nblk, nb = item % nblk, k0 = 64 * kb, n0 = 32 * nb;
#pragma unroll 8
    for (int i = 0; i < 32; ++i) { const int kk = 2 * i + (lane >> 5); scr[kk * 33 + (lane & 31)] = W[(size_t)(k0 + kk) * N + n0 + (lane & 31)]; }
    LDS_WAIT(); asm volatile("" ::: "memory");
    const int c = lane & 7;
#pragma unroll
    for (int j = 0; j < 4; ++j) { const int n = (lane >> 3) + 8 * j; const LAS float* s = scr + (8 * c) * 33 + n;
        v4u o; o.x = pk2(s[0 * 33], s[1 * 33]); o.y = pk2(s[2 * 33], s[3 * 33]); o.z = pk2(s[4 * 33], s[5 * 33]); o.w = pk2(s[6 * 33], s[7 * 33]);
        const int nn = n0 + n; const int r = mode == 0 ? row_off + nn : row_off + 8 * (nn >> 2) + (nn & 3) + (mode == 2 ? 4 : 0);
        *(GAS v4u*)(WT + (size_t)r * K + k0 + 8 * c) = o; }
    LDS_WAIT(); asm volatile("" ::: "memory");
}
__device__ __forceinline__ unsigned q4(float a, float b, float c, float d) {
    const int ia = (int)__builtin_rintf(fminf(fmaxf(a, -127.f), 127.f)), ib = (int)__builtin_rintf(fminf(fmaxf(b, -127.f), 127.f)), ic = (int)__builtin_rintf(fminf(fmaxf(c, -127.f), 127.f)), id = (int)__builtin_rintf(fminf(fmaxf(d, -127.f), 127.f));
    return (unsigned)(ia & 255) | ((unsigned)(ib & 255) << 8) | ((unsigned)(ic & 255) << 16) | ((unsigned)id << 24);
}
template <int KROWS, bool QUANT>
__device__ __forceinline__ void p0_strip(const float* W, int N, int n0, void* WT, int rowbase, int mode, float* sb, LAS unsigned char* lds, int tid) {
    constexpr int RPT = KROWS / 64;
    const int c4 = tid & 7, rq = tid >> 3;
    f32x4 v[RPT];
#pragma unroll
    for (int i = 0; i < RPT; ++i) v[i] = *(const GAS f32x4*)(W + (size_t)(rq * RPT + i) * N + n0 + 4 * c4);
    int rr[4];
#pragma unroll
    for (int j = 0; j < 4; ++j) { const int n = n0 + 4 * c4 + j; rr[j] = mode == 0 ? rowbase + n : rowbase + 8 * (n >> 2) + (n & 3) + (mode == 2 ? 4 : 0); }
    if constexpr (QUANT) {
        f32x4 m = (f32x4){0.f, 0.f, 0.f, 0.f};
#pragma unroll
        for (int i = 0; i < RPT; ++i) { m.x = fmaxf(m.x, fabsf(v[i].x)); m.y = fmaxf(m.y, fabsf(v[i].y)); m.z = fmaxf(m.z, fabsf(v[i].z)); m.w = fmaxf(m.w, fabsf(v[i].w)); }
        LAS f32x4* cm = (LAS f32x4*)lds; LAS float* scl = (LAS float*)(lds + 8192);
        cm[rq * 8 + c4] = m;
        __syncthreads();
        if (tid < 32) { float mx = 0.f; const LAS float* cf = (const LAS float*)lds;
            for (int q = 0; q < 64; ++q) mx = fmaxf(mx, cf[q * 32 + tid]);
            scl[tid] = mx;
            const int n = n0 + tid; const int r = mode == 0 ? rowbase + n : rowbase + 8 * (n >> 2) + (n & 3) + (mode == 2 ? 4 : 0);
            sb[r] = mx * (1.0f / 127.0f); }
        __syncthreads();
#pragma unroll
        for (int j = 0; j < 4; ++j) { const float mx = scl[4 * c4 + j], inv = mx > 0.f ? 127.0f / mx : 0.f;
            static_assert(RPT == 16, "int8 strips are 1024 rows");
            v4u o; o.x = q4(v[0][j] * inv, v[1][j] * inv, v[2][j] * inv, v[3][j] * inv); o.y = q4(v[4][j] * inv, v[5][j] * inv, v[6][j] * inv, v[7][j] * inv);
            o.z = q4(v[8][j] * inv, v[9][j] * inv, v[10][j] * inv, v[11][j] * inv); o.w = q4(v[12][j] * inv, v[13][j] * inv, v[14][j] * inv, v[15][j] * inv);
            *(GAS v4u*)((signed char*)WT + (size_t)rr[j] * KROWS + rq * RPT) = o; }
        __syncthreads();
    } else {
#pragma unroll
        for (int j = 0; j < 4; ++j)
#pragma unroll
            for (int h = 0; h < RPT / 8; ++h) { v4u o; o.x = pk2(v[8 * h][j], v[8 * h + 1][j]); o.y = pk2(v[8 * h + 2][j], v[8 * h + 3][j]); o.z = pk2(v[8 * h + 4][j], v[8 * h + 5][j]); o.w = pk2(v[8 * h + 6][j], v[8 * h + 7][j]);
                *(GAS v4u*)((bf16*)WT + (size_t)rr[j] * KROWS + rq * RPT + 8 * h) = o; }
    }
}
__device__ __forceinline__ void p0_prologue(Frame& F, const Args& a) {
    unsigned char* ws = a.ws;
    constexpr int S_IN = IN_COLS / 32, S_E13 = DE / 32, S_E2 = D / 32, S_D = D / 32;
    constexpr int N_IN = S_IN, N_13 = 2 * NE * S_E13, N_2 = NE * S_E2, NITEMS = N_IN + N_13 + N_2 + 3 * S_D;
    for (int it = F.vcu; it < NITEMS; it += F.G) {
        int r = it;
        if (r < N_IN) { p0_strip<1024, true>(a.in[5], IN_COLS, 32 * r, ws + WS_WIN_T, 0, 0, (float*)(ws + WS_SB_IN), F.lds, F.tid); continue; } r -= N_IN;
        if (r < N_13) { const int mat = r / S_E13, st = r % S_E13, e = mat >> 1, which = mat & 1;
            p0_strip<1024, true>(a.in[21 + which] + (size_t)e * D * DE, DE, 32 * st, ws + WS_W13_T, e * 1024, 1 + which, (float*)(ws + WS_SB_13), F.lds, F.tid); continue; } r -= N_13;
        if (r < N_2) { const int e = r / S_E2, st = r % S_E2; p0_strip<512, false>(a.in[23] + (size_t)e * DE * D, D, 32 * st, ws + WS_W2_T, e * 1024, 0, nullptr, F.lds, F.tid); continue; } r -= N_2;
        if (r < S_D) { p0_strip<512, false>(a.in[13], D, 32 * r, ws + WS_WAO_T, 0, 0, nullptr, F.lds, F.tid); continue; } r -= S_D;
        if (r < S_D) { p0_strip<1024, false>(a.in[14], D, 32 * r, ws + WS_WLO_T, 0, 0, nullptr, F.lds, F.tid); continue; } r -= S_D;
        p0_strip<1024, false>(a.in[15], D, 32 * r, ws + WS_WOUT_T, 0, 0, nullptr, F.lds, F.tid);
    }
    if (F.vcu < 192) {
        __syncthreads();
        const float* c = a.in[1]; const float* wm = a.in[2]; const float* bm = a.in[3]; float* MOD = (float*)(ws + WS_MOD);
        LAS float* CA = (LAS float*)F.lds;
        LAS float* PART = (LAS float*)(F.lds + 65536);
        for (int i = F.tid; i < NB * D; i += NTHREADS) { const float v = c[i]; CA[i] = v * sigmoid_f(v); }
        __syncthreads();
        const int kq = F.tid >> 5, col = F.tid & 31, n = F.vcu * 32 + col;
        float acc[NB];
#pragma unroll
        for (int b = 0; b < NB; ++b) acc[b] = 0.f;
#pragma unroll 4
        for (int i = 0; i < 64; ++i) { const int k = kq + 16 * i; const float w = wm[(size_t)k * 6144 + n];
#pragma unroll
            for (int b = 0; b < NB; ++b) acc[b] += CA[b * D + k] * w; }
#pragma unroll
        for (int b = 0; b < NB; ++b) PART[(kq * NB + b) * 32 + col] = acc[b];
        __syncthreads();
        { const int b = F.tid >> 5; float sum = bm[n];
#pragma unroll
            for (int q = 0; q < 16; ++q) sum += PART[(q * NB + b) * 32 + col];
            MOD[b * 6144 + n] = sum; }
        __syncthreads();
    }
}
__device__ __forceinline__ void norm_mod_row(const float* xrow, const float* g, const float* shift, const float* scale, int lane, f32x4 (&h)[4], const bf16* drow = nullptr) {
    const GAS f32x4* xr = (const GAS f32x4*)xrow + lane; float ss = 0.f;
#pragma unroll
    for (int j = 0; j < 4; ++j) { h[j] = xr[64 * j];
        if (drow) { const v2u w = ((const GAS v2u*)drow + lane)[64 * j]; h[j] = h[j] + (f32x4){bf_lo(w.x), bf_hi(w.x), bf_lo(w.y), bf_hi(w.y)}; }
        ss += (h[j].x * h[j].x + h[j].y * h[j].y) + (h[j].z * h[j].z + h[j].w * h[j].w); }
    const float rstd = 1.0f / sqrtf(wave_sum(ss) * (1.0f / D) + EPS);
#pragma unroll
    for (int j = 0; j < 4; ++j) { const f32x4 gg = ((const GAS f32x4*)g + lane)[64 * j], sc = ((const GAS f32x4*)scale + lane)[64 * j], sf = ((const GAS f32x4*)shift + lane)[64 * j];
        h[j] = h[j] * rstd * gg * (sc + 1.0f) + sf; }
}
__device__ __forceinline__ void store_row_bf16(bf16* orow, int lane, const f32x4 (&h)[4]) {
    GAS v2u* o8 = (GAS v2u*)orow + lane;
#pragma unroll
    for (int j = 0; j < 4; ++j) { v2u w; w.x = pk2(h[j].x, h[j].y); w.y = pk2(h[j].z, h[j].w); o8[64 * j] = w; }
}
__device__ __forceinline__ float wave_max(float v) {
#pragma unroll
    for (int o = 1; o < 64; o <<= 1) v = fmaxf(v, __shfl_xor(v, o));
    return v;
}
__device__ __forceinline__ void store_row_i8(signed char* orow, float* sarow, int lane, const f32x4 (&h)[4]) {
    float mx = 0.f;
#pragma unroll
    for (int j = 0; j < 4; ++j) mx = fmaxf(fmaxf(mx, fmaxf(fabsf(h[j].x), fabsf(h[j].y))), fmaxf(fabsf(h[j].z), fabsf(h[j].w)));
    mx = wave_max(mx);
    const float inv = mx > 0.f ? 127.0f / mx : 0.f;
    GAS unsigned* o4 = (GAS unsigned*)orow + lane;
#pragma unroll
    for (int j = 0; j < 4; ++j) o4[64 * j] = q4(h[j].x * inv, h[j].y * inv, h[j].z * inv, h[j].w * inv);
    if (lane == 0) *sarow = mx * (1.0f / 127.0f);
}
__device__ __forceinline__ void p1_norm1(Frame& F, const Args& a) {
    unsigned char* ws = a.ws;
    const int gw = F.vcu * NWAVES + F.wave, NGW = F.G * NWAVES;
    const float* MOD = (const float*)(ws + WS_MOD); signed char* H = (signed char*)(ws + WS_H); float* SA = (float*)(ws + WS_SAH);
    for (int m = gw; m < T; m += NGW) { const int b = m >> 11; f32x4 h[4];
        norm_mod_row(a.in[0] + (size_t)m * D, a.in[4], MOD + b * 6144, MOD + b * 6144 + 1024, F.lane, h);
        store_row_i8(H + (size_t)m * D, SA + m, F.lane, h); }
}
typedef float f32x16 __attribute__((ext_vector_type(16)));
typedef short v4i16_t __attribute__((ext_vector_type(4)));
__device__ __forceinline__ void attn_tile(const bf16x8 (&Kf)[4], const bf16x8 (&Qf)[4], LAS unsigned char* vl, unsigned trbase, int r, int hi, bool causal, bool lower, f32x16 (&O)[2], float& m, float& l) {
    f32x16 sc;
#pragma unroll
    for (int i = 0; i < 16; ++i) sc[i] = 0.f;
#pragma unroll
    for (int kk = 0; kk < 4; ++kk) sc = __builtin_amdgcn_mfma_f32_32x32x16_bf16(Kf[kk], Qf[kk], sc, 0, 0, 0);
    if (causal) {
#pragma unroll
        for (int i = 0; i < 16; ++i) { const int key = 8 * (i >> 2) + 4 * hi + (i & 3); sc[i] = key > r ? -1e30f : sc[i]; } }
    if (lower) {
#pragma unroll
        for (int i = 0; i < 16; ++i) { const int key = 8 * (i >> 2) + 4 * hi + (i & 3); sc[i] = key < r ? -1e30f : sc[i]; } }
    float mx = sc[0];
#pragma unroll
    for (int i = 1; i < 16; ++i) mx = fmaxf(mx, sc[i]);
    mx = fmaxf(mx, __shfl_xor(mx, 32));
    const float mn = fmaxf(m, mx), al = __builtin_amdgcn_exp2f(m - mn); m = mn;
    float ps = 0.f;
#pragma unroll
    for (int i = 0; i < 16; ++i) { sc[i] = __builtin_amdgcn_exp2f(sc[i] - mn); ps += sc[i]; }
    l = l * al + ps;
#pragma unroll
    for (int dt = 0; dt < 2; ++dt)
#pragma unroll
        for (int i = 0; i < 16; ++i) O[dt][i] *= al;
    bf16x8 Pf[2];
#pragma unroll
    for (int st = 0; st < 2; ++st) { v4u w; w.x = pk2(sc[8 * st], sc[8 * st + 1]); w.y = pk2(sc[8 * st + 2], sc[8 * st + 3]); w.z = pk2(sc[8 * st + 4], sc[8 * st + 5]); w.w = pk2(sc[8 * st + 6], sc[8 * st + 7]);
        Pf[st] = __builtin_bit_cast(bf16x8, w); }
#pragma unroll
    for (int st = 0; st < 2; ++st)
#pragma unroll
        for (int dt = 0; dt < 2; ++dt) {
            const v4i16_t lo = __builtin_amdgcn_ds_read_tr16_b64_v4i16((LAS v4i16_t*)(vl + dt * 2048 + st * 1024 + trbase));
            const v4i16_t hh = __builtin_amdgcn_ds_read_tr16_b64_v4i16((LAS v4i16_t*)(vl + dt * 2048 + st * 1024 + 512 + trbase));
            bf16x8 Vf; Vf[0] = lo[0]; Vf[1] = lo[1]; Vf[2] = lo[2]; Vf[3] = lo[3]; Vf[4] = hh[0]; Vf[5] = hh[1]; Vf[6] = hh[2]; Vf[7] = hh[3];
            O[dt] = __builtin_amdgcn_mfma_f32_32x32x16_bf16(Vf, Pf[st], O[dt], 0, 0, 0); }
}
__device__ __forceinline__ void attn_q64(const bf16* Qs, const bf16* Ks, const bf16* Vs, int i0, LAS unsigned char* vl, int lane, f32x16 (&OA)[2], float& lseA, f32x16 (&OB)[2], float& lseB) {
    const int r = lane & 31, hi = lane >> 5;
    const int ktA = i0 >> 5, kt0 = ktA - 4 < 0 ? 0 : ktA - 4, ktl = ktA + 1;
    const int koff = r * HD + 8 * hi, voff = (lane >> 3) * HD + 8 * (lane & 7);
    const unsigned vlw = (unsigned)(((lane & 7) >> 2) * 2048 + (lane >> 3) * 64 + (lane & 3) * 16);
    v4u Kn[4], Vn[4];
#pragma unroll
    for (int kk = 0; kk < 4; ++kk) Kn[kk] = *(const GAS v4u*)(Ks + (size_t)(32 * kt0) * HD + koff + 16 * kk);
#pragma unroll
    for (int c4 = 0; c4 < 4; ++c4) Vn[c4] = *(const GAS v4u*)(Vs + (size_t)(32 * kt0 + 8 * c4) * HD + voff);
    bf16x8 QA[4], QB[4];
#pragma unroll
    for (int kk = 0; kk < 4; ++kk) { QA[kk] = __builtin_bit_cast(bf16x8, *(const GAS v4u*)(Qs + (size_t)(i0 + r) * HD + 16 * kk + 8 * hi));
        QB[kk] = __builtin_bit_cast(bf16x8, *(const GAS v4u*)(Qs + (size_t)(i0 + 32 + r) * HD + 16 * kk + 8 * hi)); }
#pragma unroll
    for (int dt = 0; dt < 2; ++dt)
#pragma unroll
        for (int i = 0; i < 16; ++i) { OA[dt][i] = 0.f; OB[dt][i] = 0.f; }
    float mA = -1e30f, lA = 0.f, mB = -1e30f, lB = 0.f;
    const unsigned trbase = (unsigned)((4 * hi + ((lane & 15) >> 2)) * 64 + (16 * ((lane >> 4) & 1) + 4 * (lane & 3)) * 2);
    for (int kt = kt0; kt <= ktl; ++kt) {
        bf16x8 Kf[4];
#pragma unroll
        for (int kk = 0; kk < 4; ++kk) Kf[kk] = __builtin_bit_cast(bf16x8, Kn[kk]);
#pragma unroll
        for (int c4 = 0; c4 < 4; ++c4) *(LAS v4u*)(vl + vlw + c4 * 512) = Vn[c4];
        if (kt < ktl) {
#pragma unroll
            for (int kk = 0; kk < 4; ++kk) Kn[kk] = *(const GAS v4u*)(Ks + (size_t)(32 * (kt + 1)) * HD + koff + 16 * kk);
#pragma unroll
            for (int c4 = 0; c4 < 4; ++c4) Vn[c4] = *(const GAS v4u*)(Vs + (size_t)(32 * (kt + 1) + 8 * c4) * HD + voff);
        }
        if (kt <= ktA) attn_tile(Kf, QA, vl, trbase, r, hi, kt == ktA, kt == ktA - 4, OA, mA, lA);
        if (kt >= ktA - 3) attn_tile(Kf, QB, vl, trbase, r, hi, kt == ktA + 1, kt == ktA - 3, OB, mB, lB);
    }
    { const float lt = lA + __shfl_xor(lA, 32), inv = fast_rcp(lt); lseA = mA + __builtin_amdgcn_logf(lt);
#pragma unroll
      for (int dt = 0; dt < 2; ++dt)
#pragma unroll
          for (int i = 0; i < 16; ++i) OA[dt][i] *= inv; }
    { const float lt = lB + __shfl_xor(lB, 32), inv = fast_rcp(lt); lseB = mB + __builtin_amdgcn_logf(lt);
#pragma unroll
      for (int dt = 0; dt < 2; ++dt)
#pragma unroll
          for (int i = 0; i < 16; ++i) OB[dt][i] *= inv; }
}
template <bool MERGE, bool LAST>
__device__ __forceinline__ void attn_store(bf16* ATT, float* LSE, int tok0, int tstride, int slot, int lane, LAS unsigned char* ost, f32x16 (&O)[2], float lse2) {
    const int r = lane & 31, hi = lane >> 5, rrow = lane >> 3, chunk = lane & 7;
    LAS unsigned char* mine = ost + r * 144 + 8 * hi;
    if (MERGE) {
#pragma unroll
        for (int it = 0; it < 4; ++it) { const int row = it * 8 + rrow;
            *(LAS v4u*)(ost + row * 144 + chunk * 16) = *(const GAS v4u*)(ATT + (size_t)(tok0 + row * tstride) * AOW + slot * HD + chunk * 8); }
        const float lp = LSE[(tok0 + r * tstride) * NSLOT + slot], M = fmaxf(lse2, lp), wa = __builtin_amdgcn_exp2f(lse2 - M), wb = __builtin_amdgcn_exp2f(lp - M), inv = fast_rcp(wa + wb), ca = wa * inv, cb = wb * inv;
        lse2 = M + __builtin_amdgcn_logf(wa + wb);
#pragma unroll
        for (int dt = 0; dt < 2; ++dt)
#pragma unroll
            for (int g = 0; g < 4; ++g) { const v2u w = *(const LAS v2u*)(mine + 64 * dt + 16 * g);
                O[dt][4 * g] = ca * O[dt][4 * g] + cb * bf_lo(w.x); O[dt][4 * g + 1] = ca * O[dt][4 * g + 1] + cb * bf_hi(w.x);
                O[dt][4 * g + 2] = ca * O[dt][4 * g + 2] + cb * bf_lo(w.y); O[dt][4 * g + 3] = ca * O[dt][4 * g + 3] + cb * bf_hi(w.y); }
    }
#pragma unroll
    for (int dt = 0; dt < 2; ++dt)
#pragma unroll
        for (int g = 0; g < 4; ++g) { v2u w; w.x = pk2(O[dt][4 * g], O[dt][4 * g + 1]); w.y = pk2(O[dt][4 * g + 2], O[dt][4 * g + 3]); *(LAS v2u*)(mine + 64 * dt + 16 * g) = w; }
#pragma unroll
    for (int it = 0; it < 4; ++it) { const int row = it * 8 + rrow;
        *(GAS v4u*)(ATT + (size_t)(tok0 + row * tstride) * AOW + slot * HD + chunk * 8) = *(const LAS v4u*)(ost + row * 144 + chunk * 16); }
    if (!LAST && hi == 0) LSE[(tok0 + r * tstride) * NSLOT + slot] = lse2;
}
__device__ __forceinline__ void p3_attention(Frame& F, const Args& a) {
    const bf16* QKV = (const bf16*)(a.ws + WS_QKV); bf16* ATT = (bf16*)a.out; float* LSE = (float*)(a.ws + WS_LSE);
    int lane = F.lane; asm volatile("" : "+v"(lane));
    const int w = F.wave;
    LAS unsigned char* vl = F.lds + w * 8960; LAS unsigned char* ost = vl + 4096;
    const size_t WSTR = (size_t)NB * NHEAD * S * HD;
    for (int item = F.vcu; item < NB * NSLOT * 2; item += F.G) {
        const int c = item & 1, slot = (item >> 1) & 7, b = item >> 4;
#pragma unroll 1
        for (int t = 0; t < 2; ++t) { int ln = lane; asm volatile("" : "+v"(ln) :: "memory"); const int ph = 2 * w + t, i0 = 64 * c; const bf16* Qs = QKV + (((size_t)b * NHEAD + 16 + slot) * S + ph * 128) * HD;
            f32x16 OA[2], OB[2]; float la, lb; attn_q64(Qs, Qs + WSTR, Qs + 2 * WSTR, i0, vl, ln, OA, la, OB, lb);
            attn_store<false, false>(ATT, LSE, b * S + i0 * 16 + ph, 16, slot, ln, ost, OA, la);
            attn_store<false, false>(ATT, LSE, b * S + (i0 + 32) * 16 + ph, 16, slot, ln, ost, OB, lb); }
        VM_WAIT(); __syncthreads(); __builtin_amdgcn_fence(__ATOMIC_ACQUIRE, "agent"); VM_WAIT();
#pragma unroll 1
        for (int t = 0; t < 2; ++t) { int ln = lane; asm volatile("" : "+v"(ln) :: "memory"); const int u = 2 * w + t, ph = u >> 2, i0 = 256 * c + 64 * (u & 3); const bf16* Qs = QKV + (((size_t)b * NHEAD + 8 + slot) * S + ph * 512) * HD;
            f32x16 OA[2], OB[2]; float la, lb; attn_q64(Qs, Qs + WSTR, Qs + 2 * WSTR, i0, vl, ln, OA, la, OB, lb);
            attn_store<true, false>(ATT, LSE, b * S + i0 * 4 + ph, 4, slot, ln, ost, OA, la);
            attn_store<true, false>(ATT, LSE, b * S + (i0 + 32) * 4 + ph, 4, slot, ln, ost, OB, lb); }
        VM_WAIT(); __syncthreads(); __builtin_amdgcn_fence(__ATOMIC_ACQUIRE, "agent"); VM_WAIT();
#pragma unroll 1
        for (int t = 0; t < 2; ++t) { int ln = lane; asm volatile("" : "+v"(ln) :: "memory"); const int i0 = 1024 * c + 64 * (2 * w + t); const bf16* Qs = QKV + (((size_t)b * NHEAD + slot) * S) * HD;
            f32x16 OA[2], OB[2]; float la, lb; attn_q64(Qs, Qs + WSTR, Qs + 2 * WSTR, i0, vl, ln, OA, la, OB, lb);
            attn_store<true, true>(ATT, LSE, b * S + i0, 1, slot, ln, ost, OA, la);
            attn_store<true, true>(ATT, LSE, b * S + i0 + 32, 1, slot, ln, ost, OB, lb); }
    }
    VM_WAIT(); __syncthreads();
}
__device__ __forceinline__ void p5_lru(Frame& F, const Args& a) {
    const bf16* XR = (const bf16*)(a.ws + WS_XR); const bf16* YR = (const bf16*)(a.ws + WS_YR); bf16* LRU = (bf16*)(a.ws + WS_LRU);
    LAS v4u* BF = (LAS v4u*)(F.lds);
    LAS float* CW = (LAS float*)(F.lds + 24576);
    LAS float* CARRY = (LAS float*)(F.lds + 24576 + 2048);
    volatile LAS int* FLAG = (volatile LAS int*)(F.lds + 24576 + 2048 + 65 * 256);
    int lane = F.lane; asm volatile("" : "+v"(lane));
    const int r = lane & 31, hi = lane >> 5, w = F.wave;
    const float LOG2E = 1.4426950408889634f;
    for (int item = F.vcu; item < NB * 16; item += F.G) {
        const int b = item >> 4, cb = item & 15;
        __syncthreads();
        for (int idx = F.tid; idx < 3 * 8 * 64; idx += NTHREADS) { const int l = idx & 63, f = idx >> 6, nt = f & 1, kk = (f >> 1) & 3, mat = f >> 3, rr = l & 31, hh = l >> 5, n = rr + 32 * nt;
            unsigned v[4];
#pragma unroll
            for (int jj = 0; jj < 4; ++jj) { float e[2];
#pragma unroll
                for (int q = 0; q < 2; ++q) { const int k = 16 * kk + 8 * hh + 2 * jj + q;
                    e[q] = mat == 0 ? a.in[8][(size_t)(cb * 64 + k) * 64 + n] : mat == 1 ? a.in[10][(size_t)(cb * 64 + k) * 64 + n] : (k == n ? 1.0f : 0.0f); }
                v[jj] = pk2(e[0], e[1]); }
            v4u o; o.x = v[0]; o.y = v[1]; o.z = v[2]; o.w = v[3]; BF[idx] = o; }
        for (int idx = F.tid; idx < 5 * 64; idx += NTHREADS) CW[idx] = idx < 256 ? a.in[6][(idx >> 6) * D + cb * 64 + (idx & 63)] : a.in[7][cb * 64 + (idx & 63)];
        if (F.tid < 65) FLAG[F.tid] = F.tid == 0 ? 1 : 0;
        if (F.tid < 64) CARRY[F.tid] = 0.f;
        __syncthreads();
        float bxv[2], bav[2], cav[2];
#pragma unroll
        for (int nt = 0; nt < 2; ++nt) { const int c = cb * 64 + r + 32 * nt; bxv[nt] = a.in[9][c]; bav[nt] = a.in[11][c]; cav[nt] = -8.0f * log1pf(__expf(-a.in[12][c])) * LOG2E; }
        for (int j = w; j < 64; j += 8) {
            const int t0 = 32 * j;
            bf16x8 Af[4];
#pragma unroll
            for (int kk = 0; kk < 4; ++kk) { const int c0 = 16 * kk + 8 * hi;
                f32x4 s0 = *(const LAS f32x4*)(CW + 256 + c0), s1 = *(const LAS f32x4*)(CW + 256 + c0 + 4);
#pragma unroll
                for (int d = 0; d < 4; ++d) { const int tok = t0 + r - d; const bool ok = tok >= 0;
                    const v4u x = *(const GAS v4u*)(XR + (size_t)(b * S + (ok ? tok : 0)) * D + cb * 64 + c0);
                    f32x4 x0, x1; unpack8(x, x0, x1); if (!ok) { x0 = x0 * 0.f; x1 = x1 * 0.f; }
                    const f32x4 w0 = *(const LAS f32x4*)(CW + (3 - d) * 64 + c0), w1 = *(const LAS f32x4*)(CW + (3 - d) * 64 + c0 + 4);
                    s0 = s0 + w0 * x0; s1 = s1 + w1 * x1; }
                Af[kk] = __builtin_bit_cast(bf16x8, pack8(s0, s1)); }
            f32x16 ci[2], cr[2], cx[2];
#pragma unroll
            for (int nt = 0; nt < 2; ++nt) {
#pragma unroll
                for (int i = 0; i < 16; ++i) { ci[nt][i] = 0.f; cr[nt][i] = 0.f; cx[nt][i] = 0.f; } }
#pragma unroll
            for (int kk = 0; kk < 4; ++kk)
#pragma unroll
                for (int nt = 0; nt < 2; ++nt) {
                    ci[nt] = __builtin_amdgcn_mfma_f32_32x32x16_bf16(Af[kk], __builtin_bit_cast(bf16x8, BF[((0 * 4 + kk) * 2 + nt) * 64 + lane]), ci[nt], 0, 0, 0);
                    cr[nt] = __builtin_amdgcn_mfma_f32_32x32x16_bf16(Af[kk], __builtin_bit_cast(bf16x8, BF[((1 * 4 + kk) * 2 + nt) * 64 + lane]), cr[nt], 0, 0, 0);
                    cx[nt] = __builtin_amdgcn_mfma_f32_32x32x16_bf16(Af[kk], __builtin_bit_cast(bf16x8, BF[((2 * 4 + kk) * 2 + nt) * 64 + lane]), cx[nt], 0, 0, 0); }
            unsigned short yv[2][16];
#pragma unroll
            for (int nt = 0; nt < 2; ++nt)
#pragma unroll
                for (int i = 0; i < 16; ++i) yv[nt][i] = YR[(size_t)(b * S + t0 + 8 * (i >> 2) + 4 * hi + (i & 3)) * D + cb * 64 + r + 32 * nt];
#pragma unroll
            for (int nt = 0; nt < 2; ++nt)
#pragma unroll
                for (int i = 0; i < 16; ++i) {
                    const float gi = fast_rcp(1.0f + __builtin_amdgcn_exp2f(-(ci[nt][i] + bxv[nt]) * LOG2E)), gr = fast_rcp(1.0f + __builtin_amdgcn_exp2f(-(cr[nt][i] + bav[nt]) * LOG2E));
                    const float av = __builtin_amdgcn_exp2f(cav[nt] * gr), mult = __builtin_amdgcn_sqrtf(fmaxf(0.f, 1.0f - av * av));
                    cr[nt][i] = av; ci[nt][i] = mult * gi * cx[nt][i]; }
            float A1[2][4], B1[2][4], A2[2][4], B2[2][4], SA[2], SB[2];
#pragma unroll
            for (int nt = 0; nt < 2; ++nt) { SA[nt] = 1.f; SB[nt] = 0.f;
#pragma unroll
                for (int g = 0; g < 4; ++g) { const int i0 = 4 * g;
                    const float ga = (cr[nt][i0] * cr[nt][i0 + 1]) * (cr[nt][i0 + 2] * cr[nt][i0 + 3]);
                    const float gb = ((ci[nt][i0] * cr[nt][i0 + 1] + ci[nt][i0 + 1]) * cr[nt][i0 + 2] + ci[nt][i0 + 2]) * cr[nt][i0 + 3] + ci[nt][i0 + 3];
                    const float pa = __shfl_xor(ga, 32), pb = __shfl_xor(gb, 32);
                    A1[nt][g] = hi ? pa : ga; B1[nt][g] = hi ? pb : gb; A2[nt][g] = hi ? ga : pa; B2[nt][g] = hi ? gb : pb;
                    SB[nt] = A1[nt][g] * SB[nt] + B1[nt][g]; SA[nt] = A1[nt][g] * SA[nt];
                    SB[nt] = A2[nt][g] * SB[nt] + B2[nt][g]; SA[nt] = A2[nt][g] * SA[nt]; } }
            if (j > 0) { while (FLAG[j] == 0) __builtin_amdgcn_s_sleep(1); }
            asm volatile("" ::: "memory");
            float h[2];
#pragma unroll
            for (int nt = 0; nt < 2; ++nt) { h[nt] = CARRY[j * 64 + r + 32 * nt]; if (hi == 0) CARRY[(j + 1) * 64 + r + 32 * nt] = SA[nt] * h[nt] + SB[nt]; }
            asm volatile("s_waitcnt lgkmcnt(0)" ::: "memory");
            if (lane == 0) FLAG[j + 1] = 1;
#pragma unroll
            for (int nt = 0; nt < 2; ++nt)
#pragma unroll
                for (int g = 0; g < 4; ++g) { const float h1 = A1[nt][g] * h[nt] + B1[nt][g]; float hh = hi ? h1 : h[nt]; h[nt] = A2[nt][g] * h1 + B2[nt][g];
#pragma unroll
                    for (int q = 0; q < 4; ++q) { const int i = 4 * g + q; hh = cr[nt][i] * hh + ci[nt][i];
                        LRU[(size_t)(b * S + t0 + 8 * g + 4 * hi + q) * D + cb * 64 + r + 32 * nt] = (bf16)f2bf(hh * bf2f(yv[nt][i])); } }
        }
    }
    __syncthreads();
}
__device__ __forceinline__ void route_row(const float (&lg)[36], int m, int lane, const Args& a) {
    float gl[4];
#pragma unroll
    for (int o = 0; o < 4; ++o) gl[o] = lg[o] + a.in[18][o];
    int gi = 0; float gm = gl[0];
#pragma unroll
    for (int o = 1; o < 4; ++o) if (gl[o] > gm) { gm = gl[o]; gi = o; }
    float den = 0.f;
#pragma unroll
    for (int o = 0; o < 4; ++o) den += __expf(gl[o] - gm);
    const float ggate = 1.0f / den;
    float el[8];
    const float s0 = gi == 0 ? 1.f : 0.f, s1 = gi == 1 ? 1.f : 0.f, s2 = gi == 2 ? 1.f : 0.f, s3 = gi == 3 ? 1.f : 0.f;
#pragma unroll
    for (int j = 0; j < 8; ++j) el[j] = ((s0 * lg[4 + j] + s1 * lg[12 + j]) + (s2 * lg[20 + j] + s3 * lg[28 + j])) + a.in[20][gi * 8 + j];
    int i1 = 0; float v1 = el[0];
#pragma unroll
    for (int j = 1; j < 8; ++j) if (el[j] > v1) { v1 = el[j]; i1 = j; }
    int i2 = -1; float v2 = -INFINITY;
#pragma unroll
    for (int j = 0; j < 8; ++j) if (j != i1 && el[j] > v2) { v2 = el[j]; i2 = j; }
    if (i2 < 0) { i2 = (i1 + 1) & 7; v2 = v1; }
    const float e2 = __expf(v2 - v1), w1 = ggate / (1.0f + e2), w2 = ggate * e2 / (1.0f + e2);
    if (lane == 0) {
        int* TOKE = (int*)(a.ws + WS_TOKE); int* TOKR = (int*)(a.ws + WS_TOKR); float* TOKW = (float*)(a.ws + WS_TOKW);
        const int e1 = gi * 8 + i1, e2i = gi * 8 + i2;
        const int r1 = (int)atomicAdd((unsigned*)(a.ws + WS_CTL) + CW_CNT + 64 * e1, 1u), r2 = (int)atomicAdd((unsigned*)(a.ws + WS_CTL) + CW_CNT + 64 * e2i, 1u);
        TOKE[2 * m] = e1; TOKE[2 * m + 1] = e2i; TOKR[2 * m] = r1; TOKR[2 * m + 1] = r2; TOKW[2 * m] = w1; TOKW[2 * m + 1] = w2;
    }
}
template <int N, int MASK> __device__ __forceinline__ void rs_step(float (&v)[72], int lane) {
    constexpr int C = (N + 1) / 2; const bool hi = (lane & MASK) != 0;
#pragma unroll
    for (int i = 0; i < C; ++i) { const float lo_v = v[i], hi_v = (C + i < N) ? v[C + i] : 0.f; const float send = hi ? lo_v : hi_v, keep = hi ? hi_v : lo_v; v[i] = keep + __shfl_xor(send, MASK); }
}
__device__ __forceinline__ void p10_router(Frame& F, const Args& a) {
    LAS float* WT = (LAS float*)F.lds;
    for (int i = F.tid; i < 36 * D; i += NTHREADS) { const int o = i >> 10, k = i & 1023; WT[i] = o < 4 ? a.in[17][k * 4 + o] : a.in[19][k * 32 + (o - 4)]; }
    __syncthreads();
    const int gw = F.vcu * NWAVES + F.wave, NGW = F.G * NWAVES; int lane = F.lane; asm volatile("" : "+v"(lane));
    const float* MOD = (const float*)(a.ws + WS_MOD); signed char* H2 = (signed char*)(a.ws + WS_H); float* SA = (float*)(a.ws + WS_SAH); const float* X = a.in[0]; const bf16* D1 = (const bf16*)(a.ws + WS_D1);
    for (int m = 2 * gw; m < T; m += 2 * NGW) { const int b = m >> 11; f32x4 h0[4], h1[4];
        norm_mod_row(X + (size_t)m * D, a.in[16], MOD + b * 6144 + 3072, MOD + b * 6144 + 4096, lane, h0, D1 + (size_t)m * D);
        norm_mod_row(X + (size_t)(m + 1) * D, a.in[16], MOD + b * 6144 + 3072, MOD + b * 6144 + 4096, lane, h1, D1 + (size_t)(m + 1) * D);
        store_row_i8(H2 + (size_t)m * D, SA + m, lane, h0);
        store_row_i8(H2 + (size_t)(m + 1) * D, SA + m + 1, lane, h1);
        float v[72];
#pragma unroll
        for (int o = 0; o < 36; ++o) { f32x2 acc = (f32x2){0.f, 0.f};
#pragma unroll
            for (int j = 0; j < 4; ++j) { const f32x4 w = *(const LAS f32x4*)(WT + o * D + 256 * j + 4 * lane);
                acc += (f32x2){h0[j].x, h1[j].x} * w.x; acc += (f32x2){h0[j].y, h1[j].y} * w.y; acc += (f32x2){h0[j].z, h1[j].z} * w.z; acc += (f32x2){h0[j].w, h1[j].w} * w.w; }
            v[o] = acc.x; v[36 + o] = acc.y;
            if ((o & 3) == 3) asm volatile("" ::: "memory"); }
        rs_step<72, 32>(v, lane); rs_step<36, 16>(v, lane); rs_step<18, 8>(v, lane); rs_step<9, 4>(v, lane); rs_step<5, 2>(v, lane); rs_step<3, 1>(v, lane);
        float lg[2][36];
        lg[0][0] = __builtin_bit_cast(float, __builtin_amdgcn_readlane(__builtin_bit_cast(int, v[0]), 0));
        lg[0][1] = __builtin_bit_cast(float, __builtin_amdgcn_readlane(__builtin_bit_cast(int, v[1]), 0));
        lg[0][2] = __builtin_bit_cast(float, __builtin_amdgcn_readlane(__builtin_bit_cast(int, v[0]), 1));
        lg[0][3] = __builtin_bit_cast(float, __builtin_amdgcn_readlane(__builtin_bit_cast(int, v[0]), 2));
        lg[0][4] = __builtin_bit_cast(float, __builtin_amdgcn_readlane(__builtin_bit_cast(int, v[1]), 2));
        lg[0][5] = __builtin_bit_cast(float, __builtin_amdgcn_readlane(__builtin_bit_cast(int, v[0]), 4));
        lg[0][6] = __builtin_bit_cast(float, __builtin_amdgcn_readlane(__builtin_bit_cast(int, v[1]), 4));
        lg[0][7] = __builtin_bit_cast(float, __builtin_amdgcn_readlane(__builtin_bit_cast(int, v[0]), 5));
        lg[0][8] = __builtin_bit_cast(float, __builtin_amdgcn_readlane(__builtin_bit_cast(int, v[0]), 6));
        lg[0][9] = __builtin_bit_cast(float, __builtin_amdgcn_readlane(__builtin_bit_cast(int, v[0]), 8));
        lg[0][10] = __builtin_bit_cast(float, __builtin_amdgcn_readlane(__builtin_bit_cast(int, v[1]), 8));
        lg[0][11] = __builtin_bit_cast(float, __builtin_amdgcn_readlane(__builtin_bit_cast(int, v[0]), 9));
        lg[0][12] = __builtin_bit_cast(float, __builtin_amdgcn_readlane(__builtin_bit_cast(int, v[0]), 10));
        lg[0][13] = __builtin_bit_cast(float, __builtin_amdgcn_readlane(__builtin_bit_cast(int, v[1]), 10));
        lg[0][14] = __builtin_bit_cast(float, __builtin_amdgcn_readlane(__builtin_bit_cast(int, v[0]), 12));
        lg[0][15] = __builtin_bit_cast(float, __builtin_amdgcn_readlane(__builtin_bit_cast(int, v[1]), 12));
        lg[0][16] = __builtin_bit_cast(float, __builtin_amdgcn_readlane(__builtin_bit_cast(int, v[0]), 13));
        lg[0][17] = __builtin_bit_cast(float, __builtin_amdgcn_readlane(__builtin_bit_cast(int, v[0]), 14));
        lg[0][18] = __builtin_bit_cast(float, __builtin_amdgcn_readlane(__builtin_bit_cast(int, v[0]), 16));
        lg[0][19] = __builtin_bit_cast(float, __builtin_amdgcn_readlane(__builtin_bit_cast(int, v[1]), 16));
        lg[0][20] = __builtin_bit_cast(float, __builtin_amdgcn_readlane(__builtin_bit_cast(int, v[0]), 17));
        lg[0][21] = __builtin_bit_cast(float, __builtin_amdgcn_readlane(__builtin_bit_cast(int, v[0]), 18));
        lg[0][22] = __builtin_bit_cast(float, __builtin_amdgcn_readlane(__builtin_bit_cast(int, v[1]), 18));
        lg[0][23] = __builtin_bit_cast(float, __builtin_amdgcn_readlane(__builtin_bit_cast(int, v[0]), 20));
        lg[0][24] = __builtin_bit_cast(float, __builtin_amdgcn_readlane(__builtin_bit_cast(int, v[1]), 20));
        lg[0][25] = __builtin_bit_cast(float, __builtin_amdgcn_readlane(__builtin_bit_cast(int, v[0]), 21));
        lg[0][26] = __builtin_bit_cast(float, __builtin_amdgcn_readlane(__builtin_bit_cast(int, v[0]), 22));
        lg[0][27] = __builtin_bit_cast(float, __builtin_amdgcn_readlane(__builtin_bit_cast(int, v[0]), 24));
        lg[0][28] = __builtin_bit_cast(float, __builtin_amdgcn_readlane(__builtin_bit_cast(int, v[1]), 24));
        lg[0][29] = __builtin_bit_cast(float, __builtin_amdgcn_readlane(__builtin_bit_cast(int, v[0]), 25));
        lg[0][30] = __builtin_bit_cast(float, __builtin_amdgcn_readlane(__builtin_bit_cast(int, v[0]), 26));
        lg[0][31] = __builtin_bit_cast(float, __builtin_amdgcn_readlane(__builtin_bit_cast(int, v[1]), 26));
        lg[0][32] = __builtin_bit_cast(float, __builtin_amdgcn_readlane(__builtin_bit_cast(int, v[0]), 28));
        lg[0][33] = __builtin_bit_cast(float, __builtin_amdgcn_readlane(__builtin_bit_cast(int, v[1]), 28));
        lg[0][34] = __builtin_bit_cast(float, __builtin_amdgcn_readlane(__builtin_bit_cast(int, v[0]), 29));
        lg[0][35] = __builtin_bit_cast(float, __builtin_amdgcn_readlane(__builtin_bit_cast(int, v[0]), 30));
        lg[1][0] = __builtin_bit_cast(float, __builtin_amdgcn_readlane(__builtin_bit_cast(int, v[0]), 32));
        lg[1][1] = __builtin_bit_cast(float, __builtin_amdgcn_readlane(__builtin_bit_cast(int, v[1]), 32));
        lg[1][2] = __builtin_bit_cast(float, __builtin_amdgcn_readlane(__builtin_bit_cast(int, v[0]), 33));
        lg[1][3] = __builtin_bit_cast(float, __builtin_amdgcn_readlane(__builtin_bit_cast(int, v[0]), 34));
        lg[1][4] = __builtin_bit_cast(float, __builtin_amdgcn_readlane(__builtin_bit_cast(int, v[1]), 34));
        lg[1][5] = __builtin_bit_cast(float, __builtin_amdgcn_readlane(__builtin_bit_cast(int, v[0]), 36));
        lg[1][6] = __builtin_bit_cast(float, __builtin_amdgcn_readlane(__builtin_bit_cast(int, v[1]), 36));
        lg[1][7] = __builtin_bit_cast(float, __builtin_amdgcn_readlane(__builtin_bit_cast(int, v[0]), 37));
        lg[1][8] = __builtin_bit_cast(float, __builtin_amdgcn_readlane(__builtin_bit_cast(int, v[0]), 38));
        lg[1][9] = __builtin_bit_cast(float, __builtin_amdgcn_readlane(__builtin_bit_cast(int, v[0]), 40));
        lg[1][10] = __builtin_bit_cast(float, __builtin_amdgcn_readlane(__builtin_bit_cast(int, v[1]), 40));
        lg[1][11] = __builtin_bit_cast(float, __builtin_amdgcn_readlane(__builtin_bit_cast(int, v[0]), 41));
        lg[1][12] = __builtin_bit_cast(float, __builtin_amdgcn_readlane(__builtin_bit_cast(int, v[0]), 42));
        lg[1][13] = __builtin_bit_cast(float, __builtin_amdgcn_readlane(__builtin_bit_cast(int, v[1]), 42));
        lg[1][14] = __builtin_bit_cast(float, __builtin_amdgcn_readlane(__builtin_bit_cast(int, v[0]), 44));
        lg[1][15] = __builtin_bit_cast(float, __builtin_amdgcn_readlane(__builtin_bit_cast(int, v[1]), 44));
        lg[1][16] = __builtin_bit_cast(float, __builtin_amdgcn_readlane(__builtin_bit_cast(int, v[0]), 45));
        lg[1][17] = __builtin_bit_cast(float, __builtin_amdgcn_readlane(__builtin_bit_cast(int, v[0]), 46));
        lg[1][18] = __builtin_bit_cast(float, __builtin_amdgcn_readlane(__builtin_bit_cast(int, v[0]), 48));
        lg[1][19] = __builtin_bit_cast(float, __builtin_amdgcn_readlane(__builtin_bit_cast(int, v[1]), 48));
        lg[1][20] = __builtin_bit_cast(float, __builtin_amdgcn_readlane(__builtin_bit_cast(int, v[0]), 49));
        lg[1][21] = __builtin_bit_cast(float, __builtin_amdgcn_readlane(__builtin_bit_cast(int, v[0]), 50));
        lg[1][22] = __builtin_bit_cast(float, __builtin_amdgcn_readlane(__builtin_bit_cast(int, v[1]), 50));
        lg[1][23] = __builtin_bit_cast(float, __builtin_amdgcn_readlane(__builtin_bit_cast(int, v[0]), 52));
        lg[1][24] = __builtin_bit_cast(float, __builtin_amdgcn_readlane(__builtin_bit_cast(int, v[1]), 52));
        lg[1][25] = __builtin_bit_cast(float, __builtin_amdgcn_readlane(__builtin_bit_cast(int, v[0]), 53));
        lg[1][26] = __builtin_bit_cast(float, __builtin_amdgcn_readlane(__builtin_bit_cast(int, v[0]), 54));
        lg[1][27] = __builtin_bit_cast(float, __builtin_amdgcn_readlane(__builtin_bit_cast(int, v[0]), 56));
        lg[1][28] = __builtin_bit_cast(float, __builtin_amdgcn_readlane(__builtin_bit_cast(int, v[1]), 56));
        lg[1][29] = __builtin_bit_cast(float, __builtin_amdgcn_readlane(__builtin_bit_cast(int, v[0]), 57));
        lg[1][30] = __builtin_bit_cast(float, __builtin_amdgcn_readlane(__builtin_bit_cast(int, v[0]), 58));
        lg[1][31] = __builtin_bit_cast(float, __builtin_amdgcn_readlane(__builtin_bit_cast(int, v[1]), 58));
        lg[1][32] = __builtin_bit_cast(float, __builtin_amdgcn_readlane(__builtin_bit_cast(int, v[0]), 60));
        lg[1][33] = __builtin_bit_cast(float, __builtin_amdgcn_readlane(__builtin_bit_cast(int, v[1]), 60));
        lg[1][34] = __builtin_bit_cast(float, __builtin_amdgcn_readlane(__builtin_bit_cast(int, v[0]), 61));
        lg[1][35] = __builtin_bit_cast(float, __builtin_amdgcn_readlane(__builtin_bit_cast(int, v[0]), 62));
        route_row(lg[0], m, lane, a);
        route_row(lg[1], m + 1, lane, a);
    }
    __syncthreads();
}
__device__ __forceinline__ int moe_tables(Frame& F, const Args& a, LAS int* off, LAS int* tile_e) {
    if (F.tid == 0) { int acc = 0;
        for (int e = 0; e < NE; ++e) { off[e] = acc; const int cnt = (int)__hip_atomic_load((unsigned*)(a.ws + WS_CTL) + CW_CNT + 64 * e, RLX_AGENT); const int nt = (cnt + 255) >> 8;
            for (int t = 0; t < nt; ++t) tile_e[(acc >> 8) + t] = e; acc += nt * 256; }
        off[NE] = acc; }
    __syncthreads();
    return off[NE] >> 8;
}
__device__ __forceinline__ void p11_scatter(Frame& F, const Args& a) {
    LAS int* off = (LAS int*)(F.lds + LDSX_OFF); LAS int* tile_e = off + 64;
    (void)moe_tables(F, a, off, tile_e);
    const int gw = F.vcu * NWAVES + F.wave, NGW = F.G * NWAVES, lane = F.lane;
    const signed char* H2 = (const signed char*)(a.ws + WS_H); signed char* XP = (signed char*)(a.ws + WS_XP); const float* SA = (const float*)(a.ws + WS_SAH); float* SAXP = (float*)(a.ws + WS_SAXP);
    const int* TOKE = (const int*)(a.ws + WS_TOKE); const int* TOKR = (const int*)(a.ws + WS_TOKR); int* TOKS = (int*)(a.ws + WS_TOKS);
    for (int m = gw; m < T; m += NGW) {
        const v4u r0 = ((const GAS v4u*)(H2 + (size_t)m * D))[lane]; const float sc = SA[m];
#pragma unroll
        for (int k = 0; k < 2; ++k) { const int e = TOKE[2 * m + k], slot = off[e] + TOKR[2 * m + k];
            ((GAS v4u*)(XP + (size_t)slot * D))[lane] = r0;
            if (lane == 0) { TOKS[2 * m + k] = slot; SAXP[slot] = sc; } }
    }
    __syncthreads();
}
__device__ __forceinline__ void p14_final(Frame& F, const Args& a) {
    const int gw = F.vcu * NWAVES + F.wave, NGW = F.G * NWAVES, lane = F.lane;
    const float* MOD = (const float*)(a.ws + WS_MOD); const bf16* Y = (const bf16*)(a.ws + WS_Y);
    const int* TOKS = (const int*)(a.ws + WS_TOKS); const float* TOKW = (const float*)(a.ws + WS_TOKW);
    for (int m = gw; m < T; m += NGW) { const int b = m >> 11;
        const int s0 = TOKS[2 * m], s1 = TOKS[2 * m + 1]; const float w0 = TOKW[2 * m], w1 = TOKW[2 * m + 1];
        GAS f32x4* xr = (GAS f32x4*)(a.out + (size_t)m * D) + lane; const GAS f32x4* xin = (const GAS f32x4*)(a.in[0] + (size_t)m * D) + lane; const GAS v2u* dr = (const GAS v2u*)((const bf16*)(a.ws + WS_D1) + (size_t)m * D) + lane; f32x4 v[4]; float ss = 0.f;
#pragma unroll
        for (int j = 0; j < 4; ++j) {
            const v2u ya = ((const GAS v2u*)(Y + (size_t)s0 * D) + lane)[64 * j], yb = ((const GAS v2u*)(Y + (size_t)s1 * D) + lane)[64 * j];
            const f32x4 y0 = (f32x4){bf_lo(ya.x), bf_hi(ya.x), bf_lo(ya.y), bf_hi(ya.y)}, y1 = (f32x4){bf_lo(yb.x), bf_hi(yb.x), bf_lo(yb.y), bf_hi(yb.y)};
            const f32x4 g2 = ((const GAS f32x4*)(MOD + b * 6144 + 5120) + lane)[64 * j];
            const v2u dw = dr[64 * j];
            v[j] = (xin[64 * j] + (f32x4){bf_lo(dw.x), bf_hi(dw.x), bf_lo(dw.y), bf_hi(dw.y)}) + (g2 + 1.0f) * (y0 * w0 + y1 * w1);
            ss += (v[j].x * v[j].x + v[j].y * v[j].y) + (v[j].z * v[j].z + v[j].w * v[j].w); }
        const float rstd = 1.0f / sqrtf(wave_sum(ss) * (1.0f / D) + EPS);
#pragma unroll
        for (int j = 0; j < 4; ++j) xr[64 * j] = v[j] * rstd * ((const GAS f32x4*)a.in[24] + lane)[64 * j];
    }
}

template <bool I8 = false, class Epi, class Sched> __device__ __forceinline__ void run_gemm(Frame& F, const pg8::Gemm& g, const Sched& S, const Epi& E) {
    pg8::gemm_phase<Epi, Sched, true, I8>(F.lds, g, S, E);
}

constexpr int NPHASES = 14;
__global__ void __launch_bounds__(NTHREADS, 2) mk_fwd(Args args) {
    extern __shared__ __attribute__((aligned(16))) unsigned char lds_raw[];
    Frame F;
    F.lds = (LAS unsigned char*)lds_raw; F.MISC = (volatile LAS unsigned*)(F.lds + MISC_OFF);
    F.tid = threadIdx.x; F.lane = F.tid & 63; F.wave = __builtin_amdgcn_readfirstlane(F.tid >> 6);
    F.G = gridDim.x; { const int bx = blockIdx.x; F.vcu = (F.G % 8 == 0) ? (bx % 8) * (F.G / 8) + bx / 8 : bx; }
    unsigned char* ws = args.ws; F.ctl = (gu32*)(ws + WS_CTL);
    if (F.tid < 64) F.MISC[F.tid] = 0u;
    __syncthreads();
    XcdBarrier bar; bar.bar = (unsigned*)(ws + WS_CTL) + CW_BAR; bar.x = 0; bar.st = nullptr;
    if (MK_N_LAUNCHES == 1) bar = xcd_barrier_post((unsigned*)(ws + WS_CTL) + CW_BAR, F.MISC + 8);
    const int lo = args.ph_lo, hi = args.ph_hi;
#ifndef PH_MASK
#define PH_MASK 0x7fff
#endif
#define IN(k) (((PH_MASK >> (k)) & 1) && lo <= (k) && (k) < hi)
#define SEAM(k) do { if (IN(k) && IN((k) + 1)) xcd_barrier(bar); } while (0)
#ifndef REP_MASK
#define REP_MASK 0
#endif
#define PHASE(k, ...) do { if (IN(k)) { __VA_ARGS__ if ((REP_MASK >> (k)) & 1) { __syncthreads(); __VA_ARGS__ } SEAM(k); } } while (0)

    PHASE(0, { p0_prologue(F, args);});
    PHASE(1, { p1_norm1(F, args);});
    PHASE(2, {
        pg8::Gemm g{(const bf16*)(ws + WS_H), (const bf16*)(ws + WS_WIN_T), T, 3 * AW, D / 2, 0, (const float*)(ws + WS_SAH), (const float*)(ws + WS_SB_IN)}; pg8::StaticOrder So; So.init(T, 3 * AW, F.G, (int)blockIdx.x);
        EpiQKV E{(bf16*)(ws + WS_QKV)}; run_gemm<true>(F, g, So, E);});
    PHASE(3, { p3_attention(F, args);});
    PHASE(4, {
        pg8::Gemm g{(const bf16*)(ws + WS_H), (const bf16*)(ws + WS_WIN_T + (size_t)(3 * AW) * D), T, 4 * D, D / 2, 0, (const float*)(ws + WS_SAH), (const float*)(ws + WS_SB_IN) + 3 * AW}; pg8::StaticOrder So; So.init(T, 4 * D, F.G, (int)blockIdx.x);
        EpiXYG E{(bf16*)(ws + WS_XR)}; run_gemm<true>(F, g, So, E);});
    PHASE(5, {
        p5_lru(F, args);
        pg8::Gemm g{(const bf16*)args.out, (const bf16*)(ws + WS_WAO_T), T, D, AOW, 0, nullptr, nullptr}; pg8::StaticOrder So; So.init(T, D, F.G, (int)blockIdx.x);
        EpiP4a E{(bf16*)(ws + WS_GA)}; run_gemm(F, g, So, E);});
    PHASE(7, {
        pg8::Gemm g{(const bf16*)(ws + WS_LRU), (const bf16*)(ws + WS_WLO_T), T, D, D, 0, nullptr, nullptr}; pg8::StaticOrder So; So.init(T, D, F.G, (int)blockIdx.x);
        EpiP4b E{(const bf16*)(ws + WS_GA), (bf16*)(ws + WS_GL)}; run_gemm(F, g, So, E);});
    PHASE(8, {
        pg8::Gemm g{(const bf16*)(ws + WS_GL), (const bf16*)(ws + WS_WOUT_T), T, D, D, 0, nullptr, nullptr}; pg8::StaticOrder So; So.init(T, D, F.G, (int)blockIdx.x);
        EpiP5 E{(const float*)(ws + WS_MOD), (bf16*)(ws + WS_D1)}; run_gemm(F, g, So, E);});
    PHASE(9, { p10_router(F, args);});
    PHASE(10, { p11_scatter(F, args);});
    PHASE(11, {
        LAS int* off = (LAS int*)(F.lds + LDSX_OFF); LAS int* tile_e = off + 64;
        const int ntiles = moe_tables(F, args, off, tile_e);
        pg8::Gemm g{(const bf16*)(ws + WS_XP), (const bf16*)(ws + WS_W13_T), ntiles * 256, D, D / 2, (size_t)D * D, (const float*)(ws + WS_SAXP), (const float*)(ws + WS_SB_13)}; pg8::MoeOrder So{ntiles, F.G, F.vcu, tile_e};
        EpiMoeA E{(bf16*)(ws + WS_HB)}; run_gemm<true>(F, g, So, E);});
    PHASE(12, {
        LAS int* off = (LAS int*)(F.lds + LDSX_OFF); LAS int* tile_e = off + 64;
        const int ntiles = moe_tables(F, args, off, tile_e);
        pg8::Gemm g{(const bf16*)(ws + WS_HB), (const bf16*)(ws + WS_W2_T), ntiles * 256, D, DE, (size_t)D * DE * 2, nullptr, nullptr}; pg8::MoeOrder So{ntiles, F.G, F.vcu, tile_e};
        EpiMoeB E{(bf16*)(ws + WS_Y)}; run_gemm(F, g, So, E);});
    if (IN(13)) { p14_final(F, args); }
#undef IN
#undef SEAM
}

extern "C" void kernel_launch(void* const* d_in, const int* in_sizes, int n_in, void* d_out, int out_size, void* d_ws, size_t ws_size, hipStream_t stream) {
    static int grid = 0;
    if (grid == 0) {
        if (n_in != 25 || out_size != T * D || ws_size < WS_END) { fprintf(stderr, "kernel_launch: unexpected shapes: n_in %d out %d ws %zu (need %zu)\n", n_in, out_size, ws_size, (size_t)WS_END); grid = -1; return; }
        int dev = 0, cus = 0, per_cu = 0;
        if (hipGetDevice(&dev) != hipSuccess || hipDeviceGetAttribute(&cus, hipDeviceAttributeMultiprocessorCount, dev) != hipSuccess) { grid = -1; return; }
        if (hipFuncSetAttribute((const void*)mk_fwd, hipFuncAttributeMaxDynamicSharedMemorySize, LDS_BYTES) != hipSuccess) { fprintf(stderr, "kernel_launch: hipFuncSetAttribute failed\n"); grid = -1; return; }
        if (hipOccupancyMaxActiveBlocksPerMultiprocessor(&per_cu, (const void*)mk_fwd, NTHREADS, LDS_BYTES) != hipSuccess || per_cu < 1) { fprintf(stderr, "kernel_launch: occupancy query says %d\n", per_cu); }
        (void)hipGetLastError();
        grid = cus;
    }
    if (grid < 0) return;
    if (hipMemsetAsync((char*)d_ws + WS_CTL, 0, CTL_ZERO_BYTES, stream) != hipSuccess) return;
    Args a{};
    for (int i = 0; i < 25; ++i) a.in[i] = (const float*)d_in[i];
    a.out = (float*)d_out; a.ws = (unsigned char*)d_ws;
    if (MK_N_LAUNCHES == 1) { a.ph_lo = 0; a.ph_hi = NPHASES; hipLaunchKernelGGL(mk_fwd, dim3(grid), dim3(NTHREADS), LDS_BYTES, stream, a); }
    else for (int p = 0; p < NPHASES; ++p) { a.ph_lo = p; a.ph_hi = p + 1; hipLaunchKernelGGL(mk_fwd, dim3(grid), dim3(NTHREADS), LDS_BYTES, stream, a); }
}
```
